# Optimizing an MI355X kernel written in HIP

```python
import jax, jax.numpy as jnp
from jax import lax
import numpy as np

D_MODEL = 1024
BATCH = 4
SEQ = 4096
DEPTH = 1

D_MIX = D_MODEL
SB_HEADS = 8
SB_HEAD_DIM = 64
SB_WIDTH = SB_HEADS * SB_HEAD_DIM
GLA_HEADS = 4
GLA_DK = 64
GLA_DV = 128
GLA_KW = GLA_HEADS * GLA_DK
GLA_VW = GLA_HEADS * GLA_DV
GLA_GATE_RANK = 16
GLA_GATE_TAU = 16.0
GLA_CHUNK = 64
Q_BLOCK = 128
D_IN = 3 * SB_WIDTH + 2 * GLA_KW + 2 * GLA_VW + GLA_GATE_RANK
N_GROUPS = 4
EXPERTS_PER_GROUP = 8
N_EXPERTS = N_GROUPS * EXPERTS_PER_GROUP
TOP_K = 2
D_FF_EXPERT = 512
MOE_BLOCK = 128
RMS_EPS = 1e-6

kernel_name = "hymba_stickbreak_gla_hiermoe"


def rmsnorm(x, g):
    xf = x.astype(jnp.float32)
    inv = lax.rsqrt(jnp.mean(xf * xf, axis=-1, keepdims=True) + RMS_EPS)
    return (xf * inv).astype(x.dtype) * g


def stick_breaking_attention(q, k, v):
    B, H, S, Dh = q.shape
    nb = S // Q_BLOCK
    scale = Dh ** -0.5
    key_pos = jnp.arange(S)
    qb = q.reshape(B, H, nb, Q_BLOCK, Dh).transpose(2, 0, 1, 3, 4)

    def block(args):
        i, q_i = args
        q_pos = i * Q_BLOCK + jnp.arange(Q_BLOCK)
        z = jnp.einsum('bhqd,bhkd->bhqk', q_i, k).astype(jnp.float32) * scale
        mask = key_pos[None, :] < q_pos[:, None]
        log_beta = jax.nn.log_sigmoid(z)
        log_one_minus = jnp.where(mask, jax.nn.log_sigmoid(-z), 0.0)
        later = lax.cumsum(log_one_minus, axis=3, reverse=True) - log_one_minus
        weights = jnp.where(mask, jnp.exp(log_beta + later), 0.0)
        return jnp.einsum('bhqk,bhkd->bhqd', weights.astype(v.dtype), v)

    out = lax.map(block, (jnp.arange(nb), qb))
    return out.transpose(1, 2, 0, 3, 4).reshape(B, H, S, Dh)


def gla_chunked(q, k, v, log_a):
    B, H, S, Dk = q.shape
    Dv = v.shape[-1]
    nc = S // GLA_CHUNK

    def to_chunks(t):
        return t.astype(jnp.float32).reshape(B, H, nc, GLA_CHUNK, t.shape[-1]).transpose(2, 0, 1, 3, 4)

    causal = jnp.tril(jnp.ones((GLA_CHUNK, GLA_CHUNK), dtype=bool))

    def step(state, inp):
        q_c, k_c, v_c, g_c = inp
        b = jnp.cumsum(g_c, axis=2)
        o_inter = jnp.einsum('bhtk,bhkv->bhtv', q_c * jnp.exp(b), state)
        diff = b[:, :, :, None, :] - b[:, :, None, :, :]
        decay = jnp.where(causal[:, :, None], jnp.exp(jnp.minimum(diff, 0.0)), 0.0)
        scores = jnp.einsum('bhtk,bhsk,bhtsk->bhts', q_c, k_c, decay)
        o_intra = jnp.einsum('bhts,bhsv->bhtv', scores, v_c)
        b_last = b[:, :, -1:, :]
        k_dec = k_c * jnp.exp(b_last - b)
        state = jnp.exp(b_last)[:, :, 0, :, None] * state + jnp.einsum('bhsk,bhsv->bhkv', k_dec, v_c)
        return state, o_inter + o_intra

    state0 = jnp.zeros((B, H, Dk, Dv), jnp.float32)
    _, out = lax.scan(step, state0, (to_chunks(q), to_chunks(k), to_chunks(v), to_chunks(log_a)))
    return out.transpose(1, 2, 0, 3, 4).reshape(B, H, S, Dv).astype(v.dtype)


def hybrid_mixer(h, w_in, gla_gate_w2, gla_gate_b, gla_norm_g, w_out):
    B, S, _ = h.shape
    proj = h @ w_in
    sizes = (SB_WIDTH, SB_WIDTH, SB_WIDTH, GLA_KW, GLA_KW, GLA_VW, GLA_VW, GLA_GATE_RANK)
    points = [int(p) for p in np.cumsum(sizes)[:-1]]
    sb_q, sb_k, sb_v, g_q, g_k, g_v, g_r, g_lr = jnp.split(proj, points, axis=-1)

    def heads(t, n):
        return t.reshape(B, S, n, -1).transpose(0, 2, 1, 3)

    o_sb = stick_breaking_attention(heads(sb_q, SB_HEADS), heads(sb_k, SB_HEADS), heads(sb_v, SB_HEADS))
    o_sb = o_sb.transpose(0, 2, 1, 3).reshape(B, S, SB_WIDTH)

    log_a = jax.nn.log_sigmoid((g_lr @ gla_gate_w2 + gla_gate_b).astype(jnp.float32)) / GLA_GATE_TAU
    o_gla = gla_chunked(heads(g_q * (GLA_DK ** -0.5), GLA_HEADS), heads(g_k, GLA_HEADS),
                        heads(g_v, GLA_HEADS), heads(log_a, GLA_HEADS))
    o_gla = rmsnorm(o_gla.transpose(0, 2, 1, 3), gla_norm_g.reshape(GLA_HEADS, GLA_DV))
    o_gla = o_gla.reshape(B, S, GLA_VW) * jax.nn.silu(g_r)

    return jnp.concatenate([o_sb, o_gla], axis=-1) @ w_out


def hierarchical_moe(h, w_group, b_group, w_expert, b_expert, exp_w_gate, exp_w_up, exp_w_down):
    B, S, D = h.shape
    T = B * S
    xt = h.reshape(T, D)
    tok = jnp.arange(T)
    group_logits = (xt @ w_group).astype(jnp.float32) + b_group
    group_prob = jax.nn.softmax(group_logits, axis=-1)
    g_idx = jnp.argmax(group_logits, axis=-1)
    g_p = group_prob[tok, g_idx][:, None]
    exp_logits = ((xt @ w_expert).astype(jnp.float32) + b_expert).reshape(T, N_GROUPS, EXPERTS_PER_GROUP)
    sel = exp_logits[tok, g_idx]
    top_w, top_i = lax.top_k(jax.nn.softmax(sel, axis=-1), TOP_K)
    top_w = top_w / jnp.sum(top_w, axis=-1, keepdims=True)
    gate = g_p * top_w
    expert_id = g_idx[:, None] * EXPERTS_PER_GROUP + top_i

    N = T * TOP_K
    e_flat = expert_id.reshape(N)
    tok_flat = jnp.repeat(jnp.arange(T, dtype=jnp.int32), TOP_K)
    gate_flat = gate.reshape(N)
    order = jnp.argsort(e_flat)
    e_sorted = e_flat[order]
    counts = jnp.bincount(e_flat, length=N_EXPERTS)
    starts = jnp.cumsum(counts) - counts
    padded = (counts + MOE_BLOCK - 1) // MOE_BLOCK * MOE_BLOCK
    padded_ends = jnp.cumsum(padded)
    padded_starts = padded_ends - padded
    dest = padded_starts[e_sorted] + (jnp.arange(N) - starts[e_sorted])
    n_slots = N + N_EXPERTS * MOE_BLOCK
    n_blocks = n_slots // MOE_BLOCK
    slot_tok = jnp.full((n_slots,), T, jnp.int32).at[dest].set(tok_flat[order])
    slot_gate = jnp.zeros((n_slots,), jnp.float32).at[dest].set(gate_flat[order])
    block_start = jnp.arange(n_blocks) * MOE_BLOCK
    block_expert = jnp.minimum(jnp.searchsorted(padded_ends, block_start, side='right'), N_EXPERTS - 1)

    x_pad = jnp.concatenate([xt, jnp.zeros((1, D), xt.dtype)], axis=0)
    xb = x_pad[slot_tok].reshape(n_blocks, MOE_BLOCK, D)

    def expert_block(args):
        e, x_blk = args
        hidden = jax.nn.silu(x_blk @ exp_w_gate[e]) * (x_blk @ exp_w_up[e])
        return hidden @ exp_w_down[e]

    yb = lax.map(expert_block, (block_expert, xb))
    y = yb.reshape(n_slots, D) * slot_gate[:, None].astype(yb.dtype)
    out = jnp.zeros((T + 1, D), y.dtype).at[slot_tok].add(y)[:T]
    return out.reshape(B, S, D)


def setup_inputs(seed: int = 0) -> dict:
    key = jax.random.key(seed)
    ks = jax.random.split(key, 16)
    f32 = jnp.float32
    nrm = lambda k, shape, s: jax.random.normal(k, shape, f32) * s
    return {
        "x": nrm(ks[0], (BATCH, SEQ, D_MODEL), 1.0),
        "ln1_g": 1.0 + nrm(ks[1], (DEPTH, D_MODEL), 0.02),
        "w_in": nrm(ks[2], (DEPTH, D_MODEL, D_IN), D_MODEL ** -0.5),
        "gla_gate_w2": nrm(ks[3], (DEPTH, GLA_GATE_RANK, GLA_KW), GLA_GATE_RANK ** -0.5),
        "gla_gate_b": nrm(ks[4], (DEPTH, GLA_KW), 0.1),
        "gla_norm_g": 1.0 + nrm(ks[5], (DEPTH, GLA_VW), 0.02),
        "w_out": nrm(ks[6], (DEPTH, D_MIX, D_MODEL), D_MIX ** -0.5),
        "ln2_g": 1.0 + nrm(ks[7], (DEPTH, D_MODEL), 0.02),
        "w_group": nrm(ks[8], (DEPTH, D_MODEL, N_GROUPS), D_MODEL ** -0.5),
        "b_group": nrm(ks[9], (DEPTH, N_GROUPS), 0.01),
        "w_expert": nrm(ks[10], (DEPTH, D_MODEL, N_EXPERTS), D_MODEL ** -0.5),
        "b_expert": nrm(ks[11], (DEPTH, N_EXPERTS), 0.01),
        "exp_w_gate": nrm(ks[12], (DEPTH, N_EXPERTS, D_MODEL, D_FF_EXPERT), D_MODEL ** -0.5),
        "exp_w_up": nrm(ks[13], (DEPTH, N_EXPERTS, D_MODEL, D_FF_EXPERT), D_MODEL ** -0.5),
        "exp_w_down": nrm(ks[14], (DEPTH, N_EXPERTS, D_FF_EXPERT, D_MODEL), D_FF_EXPERT ** -0.5),
        "ln_f_g": 1.0 + nrm(ks[15], (D_MODEL,), 0.02),
    }


def reference(x, ln1_g, w_in, gla_gate_w2, gla_gate_b, gla_norm_g, w_out, ln2_g,
              w_group, b_group, w_expert, b_expert, exp_w_gate, exp_w_up, exp_w_down, ln_f_g):
    for l in range(DEPTH):
        h = rmsnorm(x, ln1_g[l])
        x = x + hybrid_mixer(h, w_in[l], gla_gate_w2[l], gla_gate_b[l], gla_norm_g[l], w_out[l])
        h = rmsnorm(x, ln2_g[l])
        x = x + hierarchical_moe(h, w_group[l], b_group[l], w_expert[l], b_expert[l],
                                 exp_w_gate[l], exp_w_up[l], exp_w_down[l])
    return rmsnorm(x, ln_f_g)
```

```cpp
#include <hip/hip_runtime.h>
#include <cstdio>
#include <cstdint>

#define GAS __attribute__((address_space(1)))
#define LAS __attribute__((address_space(3)))
typedef unsigned short bf16;
typedef short bf16x8 __attribute__((ext_vector_type(8)));
typedef float f32x4 __attribute__((ext_vector_type(4)));
typedef float f32x16 __attribute__((ext_vector_type(16)));
typedef unsigned v4u __attribute__((ext_vector_type(4)));
typedef unsigned v2u __attribute__((ext_vector_type(2)));
typedef GAS unsigned gu32;
#define RLX_AGENT __ATOMIC_RELAXED, __HIP_MEMORY_SCOPE_AGENT
#define LDS_WAIT() asm volatile("s_waitcnt lgkmcnt(0)" ::: "memory")
#define VM_WAIT() asm volatile("s_waitcnt vmcnt(0)" ::: "memory")

constexpr int BATCH = 4, SEQ = 4096, T = BATCH * SEQ, D = 1024, DIN = 3088, NPROJ = 3072;
constexpr int SBH = 8, SBD = 64, GH = 4, GDK = 64, GDV = 128, GRANK = 16;
constexpr int NE = 32, EPG = 8, NGRP = 4, DFF = 512;
constexpr int COL_SBQ = 0, COL_SBK = 512, COL_SBV = 1024, COL_GQ = 1536, COL_GK = 1792, COL_GV = 2048, COL_GR = 2560, COL_GLR = 3072;
constexpr float RMS_EPS = 1e-6f;
constexpr float LOG2E = 1.4426950408889634f;
constexpr float SBQ_SCALE = 0.125f * LOG2E;
constexpr float GQ_SCALE = 0.125f;
constexpr int NWAVES = 8;
constexpr int CAP = T;

constexpr size_t MiB = 1u << 20;
constexpr size_t WS_CTL = 0, CTL_ZERO_BYTES = 1 * MiB;
constexpr size_t WS_TOKLIST = 1 * MiB;
constexpr size_t WS_GATELIST = 3 * MiB;
constexpr size_t WS_TOKINFO = 5 * MiB;
constexpr size_t WS_GLR = 6 * MiB;
constexpr size_t WS_WIN = 8 * MiB;
constexpr size_t WS_WOUT = 15 * MiB;
constexpr size_t WS_WD = 17 * MiB;
constexpr size_t WS_WGU = 49 * MiB;
constexpr size_t WS_R1 = 113 * MiB;
constexpr size_t WS_R2 = 153 * MiB;
constexpr size_t WS_Y = WS_WGU;
constexpr size_t WS_END = 249 * MiB;
constexpr size_t DO_LOGA = 0;
constexpr size_t DO_OG = 16 * MiB;
constexpr int CW_TMO = 0, CW_CODE = 1;
constexpr int CW_CNT = 1024;
constexpr int CW_BAR = 4096;

constexpr int RING_OFF = 0, RING_BYTES = 131072;
constexpr int LDSCTL_OFF = RING_BYTES, MISC_OFF = LDSCTL_OFF + 320;
constexpr int LDS_BYTES = 147456;

__device__ __forceinline__ unsigned f2bf(float f) { unsigned u = __builtin_bit_cast(unsigned, f); return (u + 0x7fffu + ((u >> 16) & 1u)) >> 16; }
__device__ __forceinline__ unsigned pk2(float lo, float hi) { return f2bf(lo) | (f2bf(hi) << 16); }
__device__ __forceinline__ float bf2f(unsigned b) { return __builtin_bit_cast(float, b << 16); }
__device__ __forceinline__ float bflo(unsigned w) { return __builtin_bit_cast(float, w << 16); }
__device__ __forceinline__ float bfhi(unsigned w) { return __builtin_bit_cast(float, w & 0xffff0000u); }
__device__ __forceinline__ int crow(int r, int hi) { return (r & 3) + 8 * (r >> 2) + 4 * hi; }
__device__ __forceinline__ float wave_sum(float v) {
#pragma unroll
    for (int o = 1; o < 64; o <<= 1) v += __shfl_xor(v, o);
    return v;
}

#define XB_TMO      128
#define XB_XCNT(j)  (256  + 64 * (j))
#define XB_XSUB(j)  (1280 + 64 * (j))
#define XB_XGEN(j)  (2304 + 64 * (j))
#define XB_TOP      3328
#define XB_TOPGEN   3392
#define XCD_BAR_WORDS 3456
#define XB_SPIN_CAP (1u << 18)
__device__ __forceinline__ unsigned xb_ld(unsigned* p)              { return __hip_atomic_load(p, __ATOMIC_RELAXED, __HIP_MEMORY_SCOPE_AGENT); }
__device__ __forceinline__ unsigned xb_add(unsigned* p, unsigned v) { return __hip_atomic_fetch_add(p, v, __ATOMIC_RELAXED, __HIP_MEMORY_SCOPE_AGENT); }
__device__ __forceinline__ unsigned xb_xcc_id() { return (unsigned)__builtin_amdgcn_s_getreg((3 << 11) | 20) & 0xFu; }
#define XB_SPIN(cond, bar) do { unsigned _sp = 0; while (cond) { __builtin_amdgcn_s_sleep(1); \
    if ((++_sp & 255u) == 0u) { if (xb_ld(&(bar)[XB_TMO])) break; if (_sp > XB_SPIN_CAP) { atomicAdd(&(bar)[XB_TMO], 1u); break; } } } } while (0)
struct XcdBarrier { unsigned* bar; unsigned x; volatile LAS unsigned* st; };
__device__ __forceinline__ XcdBarrier xcd_barrier_post(unsigned* bar, volatile LAS unsigned* st) {
    XcdBarrier b; b.bar = bar; b.x = xb_xcc_id(); b.st = st;
    if (threadIdx.x == 0) (void)xb_add(&bar[XB_XCNT(b.x)], 1u);
    return b;
}
__device__ __forceinline__ void xcd_barrier_complete(unsigned* bar, unsigned x, unsigned& nloc, unsigned& nx) {
    const unsigned G = gridDim.x * gridDim.y * gridDim.z;
    unsigned sum, cnt, mine, sp = 0u;
    for (;;) {
        sum = 0u; cnt = 0u; mine = 0u;
#pragma unroll
        for (unsigned j = 0; j < 16; ++j) { const unsigned c = xb_ld(&bar[XB_XCNT(j)]); sum += c; cnt += (c > 0u) ? 1u : 0u; mine = (j == x) ? c : mine; }
        if (sum == G) break;
        __builtin_amdgcn_s_sleep(1);
        if ((++sp & 255u) == 0u) { if (xb_ld(&bar[XB_TMO])) break; if (sp > XB_SPIN_CAP) { atomicAdd(&bar[XB_TMO], 1u); break; } }
    }
    nloc = mine > 0u ? mine : 1u; nx = cnt > 0u ? cnt : 1u;
}
__device__ __forceinline__ void xcd_barrier(const XcdBarrier& b) {
    asm volatile("s_waitcnt vmcnt(0)" ::: "memory");
    __syncthreads();
    if (threadIdx.x == 0) {
        unsigned* bar = b.bar;
        __builtin_amdgcn_s_waitcnt(0);
        unsigned nloc = b.st[0], nx = b.st[1];
        if (nloc == 0u) { xcd_barrier_complete(bar, b.x, nloc, nx); b.st[0] = nloc; b.st[1] = nx; }
        const unsigned old = xb_add(&bar[XB_XSUB(b.x)], 1u);
        const unsigned gen = old / nloc;
        if (old + 1u == (gen + 1u) * nloc) {
            __builtin_amdgcn_fence(__ATOMIC_RELEASE, "agent");
            asm volatile("s_waitcnt vmcnt(0)" ::: "memory");
            const unsigned og = xb_add(&bar[XB_TOP], 1u);
            const unsigned tg = og / nx;
            if (og + 1u == (tg + 1u) * nx) xb_add(&bar[XB_TOPGEN], 1u);
            else XB_SPIN(xb_ld(&bar[XB_TOPGEN]) == tg, bar);
            __builtin_amdgcn_fence(__ATOMIC_ACQUIRE, "agent");
            xb_add(&bar[XB_XGEN(b.x)], 1u);
            asm volatile("s_waitcnt vmcnt(0)" ::: "memory");
        } else {
            XB_SPIN(xb_ld(&bar[XB_XGEN(b.x)]) == gen, bar);
            __builtin_amdgcn_fence(__ATOMIC_ACQUIRE, "agent");
            asm volatile("s_waitcnt vmcnt(0)" ::: "memory");
        }
    }
    __syncthreads();
}

struct Frame {
    LAS unsigned char* lds;
    volatile LAS unsigned* MISC;
    gu32* ctl;
    int tid, lane, wave;
    int vcu, G;
    int gw, NGW;
    const float *x, *ln1_g, *w_in, *gate_w2, *gate_b, *gnorm_g, *w_out, *ln2_g, *w_group, *b_group, *w_expert, *b_expert, *ew_gate, *ew_up, *ew_down, *lnf_g;
    float* out;
    unsigned char* ws;
    bf16 *WinT, *WoutT, *WguT, *WdT, *XN, *OMIX, *H2, *HBUF, *PROJ, *Y;
    float *GLR, *LOGA, *OG, *X1;
    int* toklist; float* gatelist; int* tokinfo; unsigned* cnt;
};

__device__ __forceinline__ void p0_transpose_item(const float* W, int ldw, int K, int k0, int n0, bf16* WT, size_t dst_row0, LAS float* scr, int lane) {
#pragma unroll 8
    for (int i = 0; i < 32; ++i) { const int kk = 2 * i + (lane >> 5); scr[kk * 33 + (lane & 31)] = W[(size_t)(k0 + kk) * ldw + n0 + (lane & 31)]; }
    LDS_WAIT(); asm volatile("" ::: "memory");
    const int c = lane & 7;
#pragma unroll
    for (int j = 0; j < 4; ++j) { const int n = (lane >> 3) + 8 * j; const LAS float* s = scr + (8 * c) * 33 + n;
        v4u o; o.x = pk2(s[0 * 33], s[1 * 33]); o.y = pk2(s[2 * 33], s[3 * 33]); o.z = pk2(s[4 * 33], s[5 * 33]); o.w = pk2(s[6 * 33], s[7 * 33]);
        *(GAS v4u*)(WT + (dst_row0 + n) * K + k0 + 8 * c) = o; }
    LDS_WAIT(); asm volatile("" ::: "memory");
}
__device__ __forceinline__ void rms_row_to_bf16(int lane, const float* xrow, const float* g, bf16* orow) {
    const GAS f32x4* xr = (const GAS f32x4*)xrow + lane; const GAS f32x4* gr = (const GAS f32x4*)g + lane;
    f32x4 v[4]; float s = 0.f;
#pragma unroll
    for (int j = 0; j < 4; ++j) { v[j] = xr[64 * j]; s += (v[j].x * v[j].x + v[j].y * v[j].y) + (v[j].z * v[j].z + v[j].w * v[j].w); }
    const float inv = 1.0f / sqrtf(wave_sum(s) * (1.f / D) + RMS_EPS);
    GAS unsigned long long* o8 = (GAS unsigned long long*)orow + lane;
#pragma unroll
    for (int j = 0; j < 4; ++j) { const f32x4 gg = gr[64 * j];
        o8[64 * j] = (unsigned long long)pk2(v[j].x * inv * gg.x, v[j].y * inv * gg.y) | ((unsigned long long)pk2(v[j].z * inv * gg.z, v[j].w * inv * gg.w) << 32); }
}
__device__ __forceinline__ void p0_prologue(Frame& F) {
    LAS float* scr = (LAS float*)(F.lds + RING_OFF + F.wave * 16384);
    constexpr int I_IN = (D / 64) * (NPROJ / 32);
    constexpr int I_OUT = (D / 64) * (D / 32);
    constexpr int I_G1 = (D / 64) * (DFF / 32);
    constexpr int I_D1 = (DFF / 64) * (D / 32);
    constexpr int NITEMS = I_IN + I_OUT + NE * (2 * I_G1 + I_D1);
    for (int it = F.gw; it < NITEMS; it += F.NGW) {
        int r = it;
        if (r < I_IN) { const int kb = r / (NPROJ / 32), nb = r % (NPROJ / 32); p0_transpose_item(F.w_in, DIN, D, 64 * kb, 32 * nb, F.WinT, (size_t)32 * nb, scr, F.lane); continue; } r -= I_IN;
        if (r < I_OUT) { const int kb = r / (D / 32), nb = r % (D / 32); p0_transpose_item(F.w_out, D, D, 64 * kb, 32 * nb, F.WoutT, (size_t)32 * nb, scr, F.lane); continue; } r -= I_OUT;
        const int e = r / (2 * I_G1 + I_D1); r -= e * (2 * I_G1 + I_D1);
        if (r < 2 * I_G1) { const int up = r / I_G1; r -= up * I_G1; const int kb = r / (DFF / 32), nb = r % (DFF / 32); const int n0 = 32 * nb;
            const float* W = (up ? F.ew_up : F.ew_gate) + (size_t)e * D * DFF;
            const size_t drow = (size_t)e * 1024 + (size_t)(n0 / 128) * 256 + (n0 % 128) + (up ? 128 : 0);
            p0_transpose_item(W, DFF, D, 64 * kb, n0, F.WguT, drow, scr, F.lane); continue; }
        r -= 2 * I_G1;
        { const int kb = r / (D / 32), nb = r % (D / 32);
          p0_transpose_item(F.ew_down + (size_t)e * DFF * D, D, DFF, 64 * kb, 32 * nb, F.WdT, (size_t)e * 1024 + 32 * nb, scr, F.lane); }
    }
    { const int gt = F.gw * 64 + F.lane, NGT = F.NGW * 64;
      for (int i = gt; i < GRANK * D; i += NGT) { const int j = i / D, k = i % D; F.WinT[(size_t)(NPROJ + j) * D + k] = (bf16)f2bf(F.w_in[(size_t)k * DIN + NPROJ + j]); } }
    for (int m = F.gw; m < T; m += F.NGW) rms_row_to_bf16(F.lane, F.x + (size_t)m * D, F.ln1_g, F.XN + (size_t)m * D);
}

__device__ __forceinline__ f32x16 tile32(const bf16* pa, const bf16* pb, int K, int h) {
    f32x16 acc;
#pragma unroll
    for (int i = 0; i < 16; ++i) acc[i] = 0.f;
    const bf16x8* a8 = (const bf16x8*)(pa + 8 * h); const bf16x8* b8 = (const bf16x8*)(pb + 8 * h);
#pragma unroll 4
    for (int k = 0; k < K / 16; ++k) acc = __builtin_amdgcn_mfma_f32_32x32x16_bf16(a8[2 * k], b8[2 * k], acc, 0, 0, 0);
    return acc;
}

__device__ __forceinline__ void p1_proj_base(Frame& F) {
    const int r = F.lane & 31, h = F.lane >> 5;
    constexpr int NT = NPROJ / 32, MT = T / 32;
    for (int it = F.gw; it < MT * NT; it += F.NGW) {
        const int mt = it / NT, nt = it % NT;
        const f32x16 acc = tile32(F.XN + (size_t)(mt * 32 + r) * D, F.WinT + (size_t)(nt * 32 + r) * D, D, h);
        const int col = nt * 32 + r;
        const float sc = col < COL_SBK ? SBQ_SCALE : ((col >= COL_GQ && col < COL_GK) ? GQ_SCALE : 1.0f);
#pragma unroll
        for (int i = 0; i < 16; ++i) F.PROJ[(size_t)(mt * 32 + crow(i, h)) * NPROJ + col] = (bf16)f2bf(acc[i] * sc);
    }
}
__device__ __forceinline__ void p1_glr(Frame& F) {
    const int gt = F.gw * 64 + F.lane, NGT = F.NGW * 64;
    for (int i = gt; i < T * GRANK; i += NGT) { const int t = i / GRANK, j = i % GRANK;
        const v4u* a = (const v4u*)(F.XN + (size_t)t * D); const v4u* b = (const v4u*)(F.WinT + (size_t)(NPROJ + j) * D);
        float s = 0.f;
        for (int k = 0; k < D / 8; ++k) { const v4u av = a[k], bv = b[k];
            s += bflo(av.x) * bflo(bv.x) + bfhi(av.x) * bfhi(bv.x) + bflo(av.y) * bflo(bv.y) + bfhi(av.y) * bfhi(bv.y)
               + bflo(av.z) * bflo(bv.z) + bfhi(av.z) * bfhi(bv.z) + bflo(av.w) * bflo(bv.w) + bfhi(av.w) * bfhi(bv.w); }
        F.GLR[i] = s; }
}

__device__ __forceinline__ void p2_loga(Frame& F) {
    const int gt = F.gw * 64 + F.lane, NGT = F.NGW * 64;
    for (int i = gt; i < T * 256; i += NGT) { const int t = i >> 8, c = i & 255;
        float s = F.gate_b[c];
#pragma unroll
        for (int j = 0; j < GRANK; ++j) s += F.GLR[t * GRANK + j] * F.gate_w2[j * 256 + c];
        const float ls = fminf(s, 0.f) - log1pf(expf(-fabsf(s)));
        F.LOGA[i] = ls * (1.0f / 16.0f); }
}
__device__ __forceinline__ void p2_sb_base(Frame& F) {
    for (int it = F.gw; it < BATCH * SBH * (SEQ / 64); it += F.NGW) {
        const int qb = it % (SEQ / 64), h = (it / (SEQ / 64)) % SBH, b = it / ((SEQ / 64) * SBH);
        const int t = qb * 64 + F.lane; const size_t row = (size_t)b * SEQ + t;
        float q[64], o[64];
        { const v4u* qp = (const v4u*)(F.PROJ + row * NPROJ + COL_SBQ + h * 64);
#pragma unroll
          for (int j = 0; j < 8; ++j) { const v4u w = qp[j]; q[8 * j] = bflo(w.x); q[8 * j + 1] = bfhi(w.x); q[8 * j + 2] = bflo(w.y); q[8 * j + 3] = bfhi(w.y);
              q[8 * j + 4] = bflo(w.z); q[8 * j + 5] = bfhi(w.z); q[8 * j + 6] = bflo(w.w); q[8 * j + 7] = bfhi(w.w); } }
#pragma unroll
        for (int d = 0; d < 64; ++d) o[d] = 0.f;
        float R = 0.f;
        int zero = 0; asm volatile("" : "+v"(zero));
        for (int s = qb * 64 + 62; s >= 0; --s) {
            const bf16* kv = F.PROJ + ((size_t)b * SEQ + s) * NPROJ + h * 64 + zero;
            const v4u* kp = (const v4u*)(kv + COL_SBK); const v4u* vp = (const v4u*)(kv + COL_SBV);
            float z = 0.f;
#pragma unroll
            for (int j = 0; j < 8; ++j) { const v4u w = kp[j];
                z += q[8 * j] * bflo(w.x) + q[8 * j + 1] * bfhi(w.x) + q[8 * j + 2] * bflo(w.y) + q[8 * j + 3] * bfhi(w.y)
                   + q[8 * j + 4] * bflo(w.z) + q[8 * j + 5] * bfhi(w.z) + q[8 * j + 6] * bflo(w.w) + q[8 * j + 7] * bfhi(w.w); }
            const float lb = fminf(z, 0.f) - __log2f(1.0f + exp2f(-fabsf(z)));
            const float wgt = (s < t) ? exp2f(lb + R) : 0.f;
            if (s < t) R += lb - z;
#pragma unroll
            for (int j = 0; j < 8; ++j) { const v4u w = vp[j];
                o[8 * j] += wgt * bflo(w.x); o[8 * j + 1] += wgt * bfhi(w.x); o[8 * j + 2] += wgt * bflo(w.y); o[8 * j + 3] += wgt * bfhi(w.y);
                o[8 * j + 4] += wgt * bflo(w.z); o[8 * j + 5] += wgt * bfhi(w.z); o[8 * j + 6] += wgt * bflo(w.w); o[8 * j + 7] += wgt * bfhi(w.w); }
        }
        v4u* op = (v4u*)(F.OMIX + row * D + h * 64);
#pragma unroll
        for (int j = 0; j < 8; ++j) { v4u w; w.x = pk2(o[8 * j], o[8 * j + 1]); w.y = pk2(o[8 * j + 2], o[8 * j + 3]); w.z = pk2(o[8 * j + 4], o[8 * j + 5]); w.w = pk2(o[8 * j + 6], o[8 * j + 7]); op[j] = w; }
    }
}
__device__ __forceinline__ void p3_gla_base(Frame& F) {
    if (F.gw >= BATCH * GH * 2) return;
    const int b = F.gw / (GH * 2), h = (F.gw / 2) % GH, vc = (F.gw & 1) * 64 + F.lane;
    float S[64];
#pragma unroll
    for (int k = 0; k < 64; ++k) S[k] = 0.f;
    int zero = 0; asm volatile("" : "+v"(zero));
    for (int t = 0; t < SEQ; ++t) {
        const size_t row = (size_t)b * SEQ + t;
        const bf16* pr = F.PROJ + row * NPROJ + zero;
        const float vv = bf2f(pr[COL_GV + h * 128 + vc]);
        const v4u* kp = (const v4u*)(pr + COL_GK + h * 64); const v4u* qp = (const v4u*)(pr + COL_GQ + h * 64);
        const f32x4* lp = (const f32x4*)(F.LOGA + row * 256 + h * 64 + zero);
        float o = 0.f;
#pragma unroll
        for (int j = 0; j < 8; ++j) { const v4u kw = kp[j], qw = qp[j]; const f32x4 l0 = lp[2 * j], l1 = lp[2 * j + 1];
            const float kk[8] = {bflo(kw.x), bfhi(kw.x), bflo(kw.y), bfhi(kw.y), bflo(kw.z), bfhi(kw.z), bflo(kw.w), bfhi(kw.w)};
            const float qq[8] = {bflo(qw.x), bfhi(qw.x), bflo(qw.y), bfhi(qw.y), bflo(qw.z), bfhi(qw.z), bflo(qw.w), bfhi(qw.w)};
            const float ll[8] = {l0.x, l0.y, l0.z, l0.w, l1.x, l1.y, l1.z, l1.w};
#pragma unroll
            for (int i = 0; i < 8; ++i) { const float a = __expf(ll[i]); S[8 * j + i] = a * S[8 * j + i] + kk[i] * vv; o += qq[i] * S[8 * j + i]; } }
        F.OG[row * 512 + h * 128 + vc] = o;
    }
}
__device__ __forceinline__ void p4_gla_out(Frame& F) {
    for (int t = F.gw; t < T; t += F.NGW) {
        const int c0 = F.lane * 8;
        const f32x4* op = (const f32x4*)(F.OG + (size_t)t * 512 + c0); const f32x4 a = op[0], b = op[1];
        float ss = (a.x * a.x + a.y * a.y) + (a.z * a.z + a.w * a.w) + (b.x * b.x + b.y * b.y) + (b.z * b.z + b.w * b.w);
        ss += __shfl_xor(ss, 1); ss += __shfl_xor(ss, 2); ss += __shfl_xor(ss, 4); ss += __shfl_xor(ss, 8);
        const float inv = 1.0f / sqrtf(ss * (1.0f / GDV) + RMS_EPS);
        const f32x4* gp = (const f32x4*)(F.gnorm_g + c0); const f32x4 g0 = gp[0], g1 = gp[1];
        const v4u grw = *(const v4u*)(F.PROJ + (size_t)t * NPROJ + COL_GR + c0);
        const float gr[8] = {bflo(grw.x), bfhi(grw.x), bflo(grw.y), bfhi(grw.y), bflo(grw.z), bfhi(grw.z), bflo(grw.w), bfhi(grw.w)};
        const float ov[8] = {a.x, a.y, a.z, a.w, b.x, b.y, b.z, b.w}; const float gg[8] = {g0.x, g0.y, g0.z, g0.w, g1.x, g1.y, g1.z, g1.w};
        float r[8];
#pragma unroll
        for (int i = 0; i < 8; ++i) { const float sl = gr[i] / (1.0f + __expf(-gr[i])); r[i] = ov[i] * inv * gg[i] * sl; }
        v4u w; w.x = pk2(r[0], r[1]); w.y = pk2(r[2], r[3]); w.z = pk2(r[4], r[5]); w.w = pk2(r[6], r[7]);
        *(v4u*)(F.OMIX + (size_t)t * D + 512 + c0) = w;
    }
}
__device__ __forceinline__ void p5_outproj_base(Frame& F) {
    const int r = F.lane & 31, h = F.lane >> 5;
    constexpr int NT = D / 32, MT = T / 32;
    for (int it = F.gw; it < MT * NT; it += F.NGW) {
        const int mt = it / NT, nt = it % NT;
        const f32x16 acc = tile32(F.OMIX + (size_t)(mt * 32 + r) * D, F.WoutT + (size_t)(nt * 32 + r) * D, D, h);
#pragma unroll
        for (int i = 0; i < 16; ++i) { const size_t idx = (size_t)(mt * 32 + crow(i, h)) * D + nt * 32 + r; F.X1[idx] = F.x[idx] + acc[i]; }
    }
}
__device__ __forceinline__ void p6_route(Frame& F) {
    for (int t = F.gw; t < T; t += F.NGW) {
        const GAS f32x4* xr = (const GAS f32x4*)(F.X1 + (size_t)t * D) + F.lane; const GAS f32x4* gr = (const GAS f32x4*)F.ln2_g + F.lane;
        f32x4 v[4]; float s = 0.f;
#pragma unroll
        for (int j = 0; j < 4; ++j) { v[j] = xr[64 * j]; s += (v[j].x * v[j].x + v[j].y * v[j].y) + (v[j].z * v[j].z + v[j].w * v[j].w); }
        const float inv = 1.0f / sqrtf(wave_sum(s) * (1.f / D) + RMS_EPS);
        GAS unsigned long long* o8 = (GAS unsigned long long*)(F.H2 + (size_t)t * D) + F.lane;
#pragma unroll
        for (int j = 0; j < 4; ++j) { const f32x4 gg = gr[64 * j]; v[j].x = v[j].x * inv * gg.x; v[j].y = v[j].y * inv * gg.y; v[j].z = v[j].z * inv * gg.z; v[j].w = v[j].w * inv * gg.w;
            o8[64 * j] = (unsigned long long)pk2(v[j].x, v[j].y) | ((unsigned long long)pk2(v[j].z, v[j].w) << 32); }
        float lg[NGRP], le[NE];
#pragma unroll
        for (int c = 0; c < NGRP; ++c) lg[c] = 0.f;
#pragma unroll
        for (int c = 0; c < NE; ++c) le[c] = 0.f;
#pragma unroll 1
        for (int jq = 0; jq < 16; ++jq) { const int j = jq >> 2, q = jq & 3;
            const f32x4 vj = j == 0 ? v[0] : (j == 1 ? v[1] : (j == 2 ? v[2] : v[3]));
            const float hv = q == 0 ? vj.x : (q == 1 ? vj.y : (q == 2 ? vj.z : vj.w));
            const int k = 4 * (64 * j + F.lane) + q;
            const f32x4 wg = *(const f32x4*)(F.w_group + (size_t)k * NGRP);
            lg[0] += hv * wg.x; lg[1] += hv * wg.y; lg[2] += hv * wg.z; lg[3] += hv * wg.w;
            const f32x4* we = (const f32x4*)(F.w_expert + (size_t)k * NE);
#pragma unroll
            for (int c4 = 0; c4 < NE / 4; ++c4) { const f32x4 w = we[c4]; le[4 * c4] += hv * w.x; le[4 * c4 + 1] += hv * w.y; le[4 * c4 + 2] += hv * w.z; le[4 * c4 + 3] += hv * w.w; } }
#pragma unroll
        for (int c = 0; c < NGRP; ++c) lg[c] = wave_sum(lg[c]) + F.b_group[c];
#pragma unroll
        for (int c = 0; c < NE; ++c) le[c] = wave_sum(le[c]) + F.b_expert[c];
        int gi = 0; float gm = lg[0];
#pragma unroll
        for (int c = 1; c < NGRP; ++c) if (lg[c] > gm) { gm = lg[c]; gi = c; }
        float gs = 0.f;
#pragma unroll
        for (int c = 0; c < NGRP; ++c) gs += __expf(lg[c] - gm);
        const float gp = 1.0f / gs;
        float sel[EPG];
#pragma unroll
        for (int i = 0; i < EPG; ++i) { sel[i] = le[i];
#pragma unroll
            for (int g = 1; g < NGRP; ++g) sel[i] = (gi == g) ? le[g * EPG + i] : sel[i]; }
        int i1 = 0; float m1 = sel[0];
#pragma unroll
        for (int i = 1; i < EPG; ++i) if (sel[i] > m1) { m1 = sel[i]; i1 = i; }
        int i2 = -1; float m2 = -3.0e38f;
#pragma unroll
        for (int i = 0; i < EPG; ++i) if (i != i1 && sel[i] > m2) { m2 = sel[i]; i2 = i; }
        const float e21 = __expf(m2 - m1); const float w1 = 1.0f / (1.0f + e21), w2 = e21 * w1;
        if (F.lane == 0) {
            const int e1 = gi * EPG + i1, e2 = gi * EPG + i2;
            const int r1 = (int)__hip_atomic_fetch_add(F.cnt + e1, 1u, RLX_AGENT), r2 = (int)__hip_atomic_fetch_add(F.cnt + e2, 1u, RLX_AGENT);
            F.toklist[e1 * CAP + r1] = t; F.gatelist[e1 * CAP + r1] = gp * w1;
            F.toklist[e2 * CAP + r2] = t; F.gatelist[e2 * CAP + r2] = gp * w2;
            *(int4*)(F.tokinfo + 4 * t) = make_int4(e1, r1, e2, r2);
        }
    }
}
__device__ __forceinline__ void load_emap(Frame& F, int& cnt_l, int& pst_l, int& cend32_l) {
    const int e = F.lane & 31;
    cnt_l = (int)__hip_atomic_load(F.cnt + e, RLX_AGENT);
    int p = (cnt_l + 255) & ~255, c = (cnt_l + 31) >> 5;
#pragma unroll
    for (int o = 1; o < 32; o <<= 1) { const int pp = __shfl_up(p, o), cc = __shfl_up(c, o); if (e >= o) { p += pp; c += cc; } }
    pst_l = p - ((cnt_l + 255) & ~255); cend32_l = c;
}
__device__ __forceinline__ void p7_gateup_base(Frame& F) {
    const int r = F.lane & 31, h = F.lane >> 5;
    int cnt_l, pst_l, cend_l; load_emap(F, cnt_l, pst_l, cend_l);
    const int total = __shfl(cend_l, 31) * (DFF / 32);
    for (int it = F.gw; it < total; it += F.NGW) {
        const int g = it / (DFF / 32), nt = it % (DFF / 32);
        const int e = __popcll(__ballot(F.lane < 32 && cend_l <= g));
        const int base = e > 0 ? __shfl(cend_l, e - 1) : 0;
        const int mt = g - base; const int n_e = __shfl(cnt_l, e); const int ps = __shfl(pst_l, e);
        const int idx = mt * 32 + r; const int tok = idx < n_e ? F.toklist[e * CAP + idx] : 0;
        const int hc = nt * 32 + r; const size_t brow = (size_t)e * 1024 + (size_t)(hc / 128) * 256 + (hc % 128);
        const f32x16 ag = tile32(F.H2 + (size_t)tok * D, F.WguT + brow * D, D, h);
        const f32x16 au = tile32(F.H2 + (size_t)tok * D, F.WguT + (brow + 128) * D, D, h);
#pragma unroll
        for (int i = 0; i < 16; ++i) { const int rr = mt * 32 + crow(i, h);
            if (rr < n_e) { const float gv = ag[i]; const float hv = gv / (1.0f + __expf(-gv)) * au[i]; F.HBUF[(size_t)(ps + rr) * DFF + hc] = (bf16)f2bf(hv); } }
    }
}
__device__ __forceinline__ void p8_down_base(Frame& F) {
    const int r = F.lane & 31, h = F.lane >> 5;
    int cnt_l, pst_l, cend_l; load_emap(F, cnt_l, pst_l, cend_l);
    const int total = __shfl(cend_l, 31) * (D / 32);
    for (int it = F.gw; it < total; it += F.NGW) {
        const int g = it / (D / 32), nt = it % (D / 32);
        const int e = __popcll(__ballot(F.lane < 32 && cend_l <= g));
        const int base = e > 0 ? __shfl(cend_l, e - 1) : 0;
        const int mt = g - base; const int n_e = __shfl(cnt_l, e); const int ps = __shfl(pst_l, e);
        int idx = mt * 32 + r; if (idx >= n_e) idx = n_e - 1;
        const f32x16 acc = tile32(F.HBUF + (size_t)(ps + idx) * DFF, F.WdT + ((size_t)e * 1024 + nt * 32 + r) * DFF, DFF, h);
#pragma unroll
        for (int i = 0; i < 16; ++i) { const int rr = mt * 32 + crow(i, h);
            if (rr < n_e) F.Y[(size_t)(ps + rr) * D + nt * 32 + r] = (bf16)f2bf(acc[i] * F.gatelist[e * CAP + rr]); }
    }
}
__device__ __forceinline__ void p9_final(Frame& F) {
    int cnt_l, pst_l, cend_l; load_emap(F, cnt_l, pst_l, cend_l);
    for (int t = F.gw; t < T; t += F.NGW) {
        const int4 ti = *(const int4*)(F.tokinfo + 4 * t);
        const int s1 = __shfl(pst_l, ti.x) + ti.y, s2 = __shfl(pst_l, ti.z) + ti.w;
        GAS f32x4* xr = (GAS f32x4*)(F.X1 + (size_t)t * D) + F.lane; const GAS f32x4* gr = (const GAS f32x4*)F.lnf_g + F.lane;
        const GAS v2u* y1 = (const GAS v2u*)(F.Y + (size_t)s1 * D) + F.lane; const GAS v2u* y2 = (const GAS v2u*)(F.Y + (size_t)s2 * D) + F.lane;
        f32x4 v[4]; float s = 0.f;
#pragma unroll
        for (int j = 0; j < 4; ++j) { v[j] = xr[64 * j]; const v2u a = y1[64 * j], b = y2[64 * j];
            v[j].x += bflo(a.x) + bflo(b.x); v[j].y += bfhi(a.x) + bfhi(b.x); v[j].z += bflo(a.y) + bflo(b.y); v[j].w += bfhi(a.y) + bfhi(b.y);
            s += (v[j].x * v[j].x + v[j].y * v[j].y) + (v[j].z * v[j].z + v[j].w * v[j].w); }
        const float inv = 1.0f / sqrtf(wave_sum(s) * (1.f / D) + RMS_EPS);
#pragma unroll
        for (int j = 0; j < 4; ++j) { const f32x4 gg = gr[64 * j]; f32x4 o; o.x = v[j].x * inv * gg.x; o.y = v[j].y * inv * gg.y; o.z = v[j].z * inv * gg.z; o.w = v[j].w * inv * gg.w; xr[64 * j] = o; }
    }
}

constexpr int NPHASE = 10;
struct Args { const float* in[16]; float* out; unsigned char* ws; int ph_lo, ph_hi, li, pad; };
__global__ void __launch_bounds__(NWAVES * 64, 2) mk_fwd(Args args) {
    extern __shared__ __attribute__((aligned(16))) unsigned char lds[];
    Frame F;
    F.lds = (LAS unsigned char*)lds;
    F.MISC = (volatile LAS unsigned*)(F.lds + MISC_OFF);
    F.tid = threadIdx.x; F.lane = F.tid & 63; F.wave = __builtin_amdgcn_readfirstlane(F.tid >> 6);
    F.G = gridDim.x; { const int bx = blockIdx.x; F.vcu = (F.G % 8 == 0) ? (bx % 8) * (F.G / 8) + bx / 8 : bx; }
    F.gw = F.vcu * NWAVES + F.wave; F.NGW = F.G * NWAVES;
    unsigned char* ws = args.ws; F.ws = ws;
    F.ctl = (gu32*)(ws + WS_CTL);
    F.x = args.in[0]; F.ln1_g = args.in[1]; F.w_in = args.in[2]; F.gate_w2 = args.in[3]; F.gate_b = args.in[4]; F.gnorm_g = args.in[5]; F.w_out = args.in[6]; F.ln2_g = args.in[7];
    F.w_group = args.in[8]; F.b_group = args.in[9]; F.w_expert = args.in[10]; F.b_expert = args.in[11]; F.ew_gate = args.in[12]; F.ew_up = args.in[13]; F.ew_down = args.in[14]; F.lnf_g = args.in[15];
    F.out = args.out;
    F.WinT = (bf16*)(ws + WS_WIN); F.WoutT = (bf16*)(ws + WS_WOUT); F.WguT = (bf16*)(ws + WS_WGU); F.WdT = (bf16*)(ws + WS_WD);
    F.XN = (bf16*)(ws + WS_R1); F.OMIX = (bf16*)(ws + WS_R1); F.H2 = (bf16*)(ws + WS_R1);
    F.PROJ = (bf16*)(ws + WS_R2); F.HBUF = (bf16*)(ws + WS_R2); F.Y = (bf16*)(ws + WS_Y);
    F.GLR = (float*)(ws + WS_GLR); F.LOGA = (float*)((unsigned char*)args.out + DO_LOGA); F.OG = (float*)((unsigned char*)args.out + DO_OG); F.X1 = args.out;
    F.toklist = (int*)(ws + WS_TOKLIST); F.gatelist = (float*)(ws + WS_GATELIST); F.tokinfo = (int*)(ws + WS_TOKINFO); F.cnt = (unsigned*)(ws + WS_CTL) + CW_CNT;
    for (int u = F.tid; u < (LDS_BYTES - LDSCTL_OFF) / 4; u += NWAVES * 64) ((LAS unsigned*)(F.lds + LDSCTL_OFF))[u] = 0u;
    __syncthreads();
    XcdBarrier bar = xcd_barrier_post((unsigned*)(F.ctl + CW_BAR) + args.li * XCD_BAR_WORDS, F.MISC + 8);
    const int lo = args.ph_lo, hi = args.ph_hi;
#define IN(k) (lo <= (k) && (k) < hi)
#define SEAM(k) do { if (IN(k) && IN((k) + 1)) xcd_barrier(bar); } while (0)
    if (IN(0)) { p0_prologue(F); } SEAM(0);
    if (IN(1)) { p1_proj_base(F); p1_glr(F); } SEAM(1);
    if (IN(2)) { p2_loga(F); p2_sb_base(F); } SEAM(2);
    if (IN(3)) { p3_gla_base(F); } SEAM(3);
    if (IN(4)) { p4_gla_out(F); } SEAM(4);
    if (IN(5)) { p5_outproj_base(F); } SEAM(5);
    if (IN(6)) { p6_route(F); } SEAM(6);
    if (IN(7)) { p7_gateup_base(F); } SEAM(7);
    if (IN(8)) { p8_down_base(F); } SEAM(8);
    if (IN(9)) { p9_final(F); }
#undef IN
#undef SEAM
}

#ifndef MK_ONE_LAUNCH
#define MK_ONE_LAUNCH 0
#endif
extern "C" void kernel_launch(void* const* d_in, const int* in_sizes, int n_in, void* d_out, int out_size, void* d_ws, size_t ws_size, hipStream_t stream) {
    static int grid = 0;
    if (grid == 0) {
        if (n_in != 16 || in_sizes[0] != T * D || out_size != T * D || ws_size < WS_END) {
            fprintf(stderr, "kernel_launch: unexpected shapes / workspace (n_in %d, in0 %d, out %d, ws %zu, need %zu); nothing launched\n", n_in, n_in > 0 ? in_sizes[0] : -1, out_size, ws_size, (size_t)WS_END); grid = -1; return; }
        int dev = 0, cus = 0, per_cu = 0;
        if (hipGetDevice(&dev) != hipSuccess || hipDeviceGetAttribute(&cus, hipDeviceAttributeMultiprocessorCount, dev) != hipSuccess) { grid = -1; return; }
        if (hipFuncSetAttribute((const void*)mk_fwd, hipFuncAttributeMaxDynamicSharedMemorySize, LDS_BYTES) != hipSuccess) { fprintf(stderr, "kernel_launch: hipFuncSetAttribute failed\n"); grid = -1; return; }
        if (hipOccupancyMaxActiveBlocksPerMultiprocessor(&per_cu, (const void*)mk_fwd, NWAVES * 64, LDS_BYTES) != hipSuccess || per_cu < 1) { fprintf(stderr, "kernel_launch: occupancy query says %d\n", per_cu); per_cu = 1; }
        (void)hipGetLastError();
        grid = cus;
    }
    if (grid < 0) return;
    (void)hipMemsetAsync((char*)d_ws + WS_CTL, 0, CTL_ZERO_BYTES, stream);
    Args a{};
    for (int i = 0; i < 16; ++i) a.in[i] = (const float*)d_in[i];
    a.out = (float*)d_out; a.ws = (unsigned char*)d_ws;
#if MK_ONE_LAUNCH
    a.ph_lo = 0; a.ph_hi = NPHASE; a.li = 0;
    { void* kargs[] = {&a}; hipError_t e = hipLaunchCooperativeKernel((const void*)mk_fwd, dim3(grid), dim3(NWAVES * 64), kargs, LDS_BYTES, stream);
      if (e != hipSuccess) fprintf(stderr, "kernel_launch: cooperative launch failed: %s\n", hipGetErrorString(e)); }
#else
    for (int p = 0; p < NPHASE; ++p) { a.ph_lo = p; a.ph_hi = p + 1; a.li = 0; hipLaunchKernelGGL(mk_fwd, dim3(grid), dim3(NWAVES * 64), LDS_BYTES, stream, a); }
#endif
}
```

```cpp
#include <hip/hip_runtime.h>
#include <cstdio>
#include <cstdint>

#define GAS __attribute__((address_space(1)))
#define LAS __attribute__((address_space(3)))
typedef unsigned short bf16;
typedef short bf16x8 __attribute__((ext_vector_type(8)));
typedef float f32x4 __attribute__((ext_vector_type(4)));
typedef float f32x16 __attribute__((ext_vector_type(16)));
typedef unsigned v4u __attribute__((ext_vector_type(4)));
typedef unsigned v2u __attribute__((ext_vector_type(2)));
typedef GAS unsigned gu32;
#define RLX_AGENT __ATOMIC_RELAXED, __HIP_MEMORY_SCOPE_AGENT
#define LDS_WAIT() asm volatile("s_waitcnt lgkmcnt(0)" ::: "memory")
#define VM_WAIT() asm volatile("s_waitcnt vmcnt(0)" ::: "memory")

constexpr int BATCH = 4, SEQ = 4096, T = BATCH * SEQ, D = 1024, DIN = 3088, NPROJ = 3072;
constexpr int SBH = 8, SBD = 64, GH = 4, GDK = 64, GDV = 128, GRANK = 16;
constexpr int NE = 32, EPG = 8, NGRP = 4, DFF = 512;
constexpr int COL_SBQ = 0, COL_SBK = 512, COL_SBV = 1024, COL_GQ = 1536, COL_GK = 1792, COL_GV = 2048, COL_GR = 2560, COL_GLR = 3072;
constexpr float RMS_EPS = 1e-6f;
constexpr float LOG2E = 1.4426950408889634f;
constexpr float SBQ_SCALE = 0.125f * LOG2E;
constexpr float GQ_SCALE = 0.125f;
constexpr int NWAVES = 8;
constexpr int CAP = T;

constexpr size_t MiB = 1u << 20;
constexpr size_t WS_CTL = 0, CTL_ZERO_BYTES = 1 * MiB;
constexpr size_t WS_TOKLIST = 1 * MiB;
constexpr size_t WS_GATELIST = 3 * MiB;
constexpr size_t WS_TOKINFO = 5 * MiB;
constexpr size_t WS_GLR = 6 * MiB;
constexpr size_t WS_WIN = 8 * MiB;
constexpr size_t WS_WOUT = 15 * MiB;
constexpr size_t WS_WD = 17 * MiB;
constexpr size_t WS_WGU = 49 * MiB;
constexpr size_t WS_R1 = 113 * MiB;
constexpr size_t WS_R2 = 153 * MiB;
constexpr size_t WS_Y = WS_WGU;
constexpr size_t WS_END = 249 * MiB;
constexpr size_t DO_LOGA = 0;
constexpr size_t DO_OG = 16 * MiB;
constexpr int CW_TMO = 0, CW_CODE = 1;
constexpr int CW_CNT = 1024;
constexpr int CW_BAR = 4096;

constexpr int RING_OFF = 0, RING_BYTES = 131072;
constexpr int LDSCTL_OFF = RING_BYTES, MISC_OFF = LDSCTL_OFF + 320;
constexpr int LDS_BYTES = 147456;

__device__ __forceinline__ unsigned f2bf(float f) { unsigned u = __builtin_bit_cast(unsigned, f); return (u + 0x7fffu + ((u >> 16) & 1u)) >> 16; }
__device__ __forceinline__ unsigned pk2(float lo, float hi) { return f2bf(lo) | (f2bf(hi) << 16); }
__device__ __forceinline__ float bf2f(unsigned b) { return __builtin_bit_cast(float, b << 16); }
__device__ __forceinline__ float bflo(unsigned w) { return __builtin_bit_cast(float, w << 16); }
__device__ __forceinline__ float bfhi(unsigned w) { return __builtin_bit_cast(float, w & 0xffff0000u); }
__device__ __forceinline__ int crow(int r, int hi) { return (r & 3) + 8 * (r >> 2) + 4 * hi; }
__device__ __forceinline__ float wave_sum(float v) {
#pragma unroll
    for (int o = 1; o < 64; o <<= 1) v += __shfl_xor(v, o);
    return v;
}

#define XB_TMO      128
#define XB_XCNT(j)  (256  + 64 * (j))
#define XB_XSUB(j)  (1280 + 64 * (j))
#define XB_XGEN(j)  (2304 + 64 * (j))
#define XB_TOP      3328
#define XB_TOPGEN   3392
#define XCD_BAR_WORDS 3456
#define XB_SPIN_CAP (1u << 18)
__device__ __forceinline__ unsigned xb_ld(unsigned* p)              { return __hip_atomic_load(p, __ATOMIC_RELAXED, __HIP_MEMORY_SCOPE_AGENT); }
__device__ __forceinline__ unsigned xb_add(unsigned* p, unsigned v) { return __hip_atomic_fetch_add(p, v, __ATOMIC_RELAXED, __HIP_MEMORY_SCOPE_AGENT); }
__device__ __forceinline__ unsigned xb_xcc_id() { return (unsigned)__builtin_amdgcn_s_getreg((3 << 11) | 20) & 0xFu; }
#define XB_SPIN(cond, bar) do { unsigned _sp = 0; while (cond) { __builtin_amdgcn_s_sleep(1); \
    if ((++_sp & 255u) == 0u) { if (xb_ld(&(bar)[XB_TMO])) break; if (_sp > XB_SPIN_CAP) { atomicAdd(&(bar)[XB_TMO], 1u); break; } } } } while (0)
struct XcdBarrier { unsigned* bar; unsigned x; volatile LAS unsigned* st; };
__device__ __forceinline__ XcdBarrier xcd_barrier_post(unsigned* bar, volatile LAS unsigned* st) {
    XcdBarrier b; b.bar = bar; b.x = xb_xcc_id(); b.st = st;
    if (threadIdx.x == 0) (void)xb_add(&bar[XB_XCNT(b.x)], 1u);
    return b;
}
__device__ __forceinline__ void xcd_barrier_complete(unsigned* bar, unsigned x, unsigned& nloc, unsigned& nx) {
    const unsigned G = gridDim.x * gridDim.y * gridDim.z;
    unsigned sum, cnt, mine, sp = 0u;
    for (;;) {
        sum = 0u; cnt = 0u; mine = 0u;
#pragma unroll
        for (unsigned j = 0; j < 16; ++j) { const unsigned c = xb_ld(&bar[XB_XCNT(j)]); sum += c; cnt += (c > 0u) ? 1u : 0u; mine = (j == x) ? c : mine; }
        if (sum == G) break;
        __builtin_amdgcn_s_sleep(1);
        if ((++sp & 255u) == 0u) { if (xb_ld(&bar[XB_TMO])) break; if (sp > XB_SPIN_CAP) { atomicAdd(&bar[XB_TMO], 1u); break; } }
    }
    nloc = mine > 0u ? mine : 1u; nx = cnt > 0u ? cnt : 1u;
}
__device__ __forceinline__ void xcd_barrier(const XcdBarrier& b) {
    asm volatile("s_waitcnt vmcnt(0)" ::: "memory");
    __syncthreads();
    if (threadIdx.x == 0) {
        unsigned* bar = b.bar;
        __builtin_amdgcn_s_waitcnt(0);
        unsigned nloc = b.st[0], nx = b.st[1];
        if (nloc == 0u) { xcd_barrier_complete(bar, b.x, nloc, nx); b.st[0] = nloc; b.st[1] = nx; }
        const unsigned old = xb_add(&bar[XB_XSUB(b.x)], 1u);
        const unsigned gen = old / nloc;
        if (old + 1u == (gen + 1u) * nloc) {
            __builtin_amdgcn_fence(__ATOMIC_RELEASE, "agent");
            asm volatile("s_waitcnt vmcnt(0)" ::: "memory");
            const unsigned og = xb_add(&bar[XB_TOP], 1u);
            const unsigned tg = og / nx;
            if (og + 1u == (tg + 1u) * nx) xb_add(&bar[XB_TOPGEN], 1u);
            else XB_SPIN(xb_ld(&bar[XB_TOPGEN]) == tg, bar);
            __builtin_amdgcn_fence(__ATOMIC_ACQUIRE, "agent");
            xb_add(&bar[XB_XGEN(b.x)], 1u);
            asm volatile("s_waitcnt vmcnt(0)" ::: "memory");
        } else {
            XB_SPIN(xb_ld(&bar[XB_XGEN(b.x)]) == gen, bar);
            __builtin_amdgcn_fence(__ATOMIC_ACQUIRE, "agent");
            asm volatile("s_waitcnt vmcnt(0)" ::: "memory");
        }
    }
    __syncthreads();
}

struct Frame {
    LAS unsigned char* lds;
    volatile LAS unsigned* MISC;
    gu32* ctl;
    int tid, lane, wave;
    int vcu, G;
    int gw, NGW;
    const float *x, *ln1_g, *w_in, *gate_w2, *gate_b, *gnorm_g, *w_out, *ln2_g, *w_group, *b_group, *w_expert, *b_expert, *ew_gate, *ew_up, *ew_down, *lnf_g;
    float* out;
    unsigned char* ws;
    bf16 *WinT, *WoutT, *WguT, *WdT, *XN, *OMIX, *H2, *HBUF, *PROJ, *Y;
    float *GLR, *LOGA, *OG, *X1;
    int* toklist; float* gatelist; int* tokinfo; unsigned* cnt;
};

__device__ __forceinline__ void p0_transpose_item(const float* W, int ldw, int K, int k0, int n0, bf16* WT, size_t dst_row0, LAS float* scr, int lane) {
#pragma unroll 8
    for (int i = 0; i < 32; ++i) { const int kk = 2 * i + (lane >> 5); scr[kk * 33 + (lane & 31)] = W[(size_t)(k0 + kk) * ldw + n0 + (lane & 31)]; }
    LDS_WAIT(); asm volatile("" ::: "memory");
    const int c = lane & 7;
#pragma unroll
    for (int j = 0; j < 4; ++j) { const int n = (lane >> 3) + 8 * j; const LAS float* s = scr + (8 * c) * 33 + n;
        v4u o; o.x = pk2(s[0 * 33], s[1 * 33]); o.y = pk2(s[2 * 33], s[3 * 33]); o.z = pk2(s[4 * 33], s[5 * 33]); o.w = pk2(s[6 * 33], s[7 * 33]);
        *(GAS v4u*)(WT + (dst_row0 + n) * K + k0 + 8 * c) = o; }
    LDS_WAIT(); asm volatile("" ::: "memory");
}
__device__ __forceinline__ void rms_row_to_bf16(int lane, const float* xrow, const float* g, bf16* orow) {
    const GAS f32x4* xr = (const GAS f32x4*)xrow + lane; const GAS f32x4* gr = (const GAS f32x4*)g + lane;
    f32x4 v[4]; float s = 0.f;
#pragma unroll
    for (int j = 0; j < 4; ++j) { v[j] = xr[64 * j]; s += (v[j].x * v[j].x + v[j].y * v[j].y) + (v[j].z * v[j].z + v[j].w * v[j].w); }
    const float inv = 1.0f / sqrtf(wave_sum(s) * (1.f / D) + RMS_EPS);
    GAS unsigned long long* o8 = (GAS unsigned long long*)orow + lane;
#pragma unroll
    for (int j = 0; j < 4; ++j) { const f32x4 gg = gr[64 * j];
        o8[64 * j] = (unsigned long long)pk2(v[j].x * inv * gg.x, v[j].y * inv * gg.y) | ((unsigned long long)pk2(v[j].z * inv * gg.z, v[j].w * inv * gg.w) << 32); }
}
__device__ __forceinline__ void p0_prologue(Frame& F) {
    LAS float* scr = (LAS float*)(F.lds + RING_OFF + F.wave * 16384);
    constexpr int I_IN = (D / 64) * (NPROJ / 32);
    constexpr int I_OUT = (D / 64) * (D / 32);
    constexpr int I_G1 = (D / 64) * (DFF / 32);
    constexpr int I_D1 = (DFF / 64) * (D / 32);
    constexpr int NITEMS = I_IN + I_OUT + NE * (2 * I_G1 + I_D1);
    for (int it = F.gw; it < NITEMS; it += F.NGW) {
        int r = it;
        if (r < I_IN) { const int kb = r / (NPROJ / 32), nb = r % (NPROJ / 32); p0_transpose_item(F.w_in, DIN, D, 64 * kb, 32 * nb, F.WinT, (size_t)32 * nb, scr, F.lane); continue; } r -= I_IN;
        if (r < I_OUT) { const int kb = r / (D / 32), nb = r % (D / 32); p0_transpose_item(F.w_out, D, D, 64 * kb, 32 * nb, F.WoutT, (size_t)32 * nb, scr, F.lane); continue; } r -= I_OUT;
        const int e = r / (2 * I_G1 + I_D1); r -= e * (2 * I_G1 + I_D1);
        if (r < 2 * I_G1) { const int up = r / I_G1; r -= up * I_G1; const int kb = r / (DFF / 32), nb = r % (DFF / 32); const int n0 = 32 * nb;
            const float* W = (up ? F.ew_up : F.ew_gate) + (size_t)e * D * DFF;
            const size_t drow = (size_t)e * 1024 + (size_t)(n0 / 128) * 256 + (n0 % 128) + (up ? 128 : 0);
            p0_transpose_item(W, DFF, D, 64 * kb, n0, F.WguT, drow, scr, F.lane); continue; }
        r -= 2 * I_G1;
        { const int kb = r / (D / 32), nb = r % (D / 32);
          p0_transpose_item(F.ew_down + (size_t)e * DFF * D, D, DFF, 64 * kb, 32 * nb, F.WdT, (size_t)e * 1024 + 32 * nb, scr, F.lane); }
    }
    { const int gt = F.gw * 64 + F.lane, NGT = F.NGW * 64;
      for (int i = gt; i < GRANK * D; i += NGT) { const int j = i / D, k = i % D; F.WinT[(size_t)(NPROJ + j) * D + k] = (bf16)f2bf(F.w_in[(size_t)k * DIN + NPROJ + j]); } }
    for (int m = F.gw; m < T; m += F.NGW) rms_row_to_bf16(F.lane, F.x + (size_t)m * D, F.ln1_g, F.XN + (size_t)m * D);
}

__device__ __forceinline__ f32x16 tile32(const bf16* pa, const bf16* pb, int K, int h) {
    f32x16 acc;
#pragma unroll
    for (int i = 0; i < 16; ++i) acc[i] = 0.f;
    const bf16x8* a8 = (const bf16x8*)(pa + 8 * h); const bf16x8* b8 = (const bf16x8*)(pb + 8 * h);
#pragma unroll 4
    for (int k = 0; k < K / 16; ++k) acc = __builtin_amdgcn_mfma_f32_32x32x16_bf16(a8[2 * k], b8[2 * k], acc, 0, 0, 0);
    return acc;
}

__device__ __forceinline__ void p1_proj_base(Frame& F) {
    const int r = F.lane & 31, h = F.lane >> 5;
    constexpr int NT = NPROJ / 32, MT = T / 32;
    for (int it = F.gw; it < MT * NT; it += F.NGW) {
        const int mt = it / NT, nt = it % NT;
        const f32x16 acc = tile32(F.XN + (size_t)(mt * 32 + r) * D, F.WinT + (size_t)(nt * 32 + r) * D, D, h);
        const int col = nt * 32 + r;
        const float sc = col < COL_SBK ? SBQ_SCALE : ((col >= COL_GQ && col < COL_GK) ? GQ_SCALE : 1.0f);
#pragma unroll
        for (int i = 0; i < 16; ++i) F.PROJ[(size_t)(mt * 32 + crow(i, h)) * NPROJ + col] = (bf16)f2bf(acc[i] * sc);
    }
}
__device__ __forceinline__ void p1_glr(Frame& F) {
    const int gt = F.gw * 64 + F.lane, NGT = F.NGW * 64;
    for (int i = gt; i < T * GRANK; i += NGT) { const int t = i / GRANK, j = i % GRANK;
        const v4u* a = (const v4u*)(F.XN + (size_t)t * D); const v4u* b = (const v4u*)(F.WinT + (size_t)(NPROJ + j) * D);
        float s = 0.f;
        for (int k = 0; k < D / 8; ++k) { const v4u av = a[k], bv = b[k];
            s += bflo(av.x) * bflo(bv.x) + bfhi(av.x) * bfhi(bv.x) + bflo(av.y) * bflo(bv.y) + bfhi(av.y) * bfhi(bv.y)
               + bflo(av.z) * bflo(bv.z) + bfhi(av.z) * bfhi(bv.z) + bflo(av.w) * bflo(bv.w) + bfhi(av.w) * bfhi(bv.w); }
        F.GLR[i] = s; }
}

__device__ __forceinline__ void p2_loga(Frame& F) {
    const int gt = F.gw * 64 + F.lane, NGT = F.NGW * 64;
    for (int i = gt; i < T * 256; i += NGT) { const int t = i >> 8, c = i & 255;
        float s = F.gate_b[c];
#pragma unroll
        for (int j = 0; j < GRANK; ++j) s += F.GLR[t * GRANK + j] * F.gate_w2[j * 256 + c];
        const float ls = fminf(s, 0.f) - log1pf(expf(-fabsf(s)));
        F.LOGA[i] = ls * (1.0f / 16.0f); }
}
__device__ __forceinline__ void p2_sb_base(Frame& F) {
    for (int it = F.gw; it < BATCH * SBH * (SEQ / 64); it += F.NGW) {
        const int qb = it % (SEQ / 64), h = (it / (SEQ / 64)) % SBH, b = it / ((SEQ / 64) * SBH);
        const int t = qb * 64 + F.lane; const size_t row = (size_t)b * SEQ + t;
        float q[64], o[64];
        { const v4u* qp = (const v4u*)(F.PROJ + row * NPROJ + COL_SBQ + h * 64);
#pragma unroll
          for (int j = 0; j < 8; ++j) { const v4u w = qp[j]; q[8 * j] = bflo(w.x); q[8 * j + 1] = bfhi(w.x); q[8 * j + 2] = bflo(w.y); q[8 * j + 3] = bfhi(w.y);
              q[8 * j + 4] = bflo(w.z); q[8 * j + 5] = bfhi(w.z); q[8 * j + 6] = bflo(w.w); q[8 * j + 7] = bfhi(w.w); } }
#pragma unroll
        for (int d = 0; d < 64; ++d) o[d] = 0.f;
        float R = 0.f;
        int zero = 0; asm volatile("" : "+v"(zero));
        for (int s = qb * 64 + 62; s >= 0; --s) {
            const bf16* kv = F.PROJ + ((size_t)b * SEQ + s) * NPROJ + h * 64 + zero;
            const v4u* kp = (const v4u*)(kv + COL_SBK); const v4u* vp = (const v4u*)(kv + COL_SBV);
            float z = 0.f;
#pragma unroll
            for (int j = 0; j < 8; ++j) { const v4u w = kp[j];
                z += q[8 * j] * bflo(w.x) + q[8 * j + 1] * bfhi(w.x) + q[8 * j + 2] * bflo(w.y) + q[8 * j + 3] * bfhi(w.y)
                   + q[8 * j + 4] * bflo(w.z) + q[8 * j + 5] * bfhi(w.z) + q[8 * j + 6] * bflo(w.w) + q[8 * j + 7] * bfhi(w.w); }
            const float lb = fminf(z, 0.f) - __log2f(1.0f + exp2f(-fabsf(z)));
            const float wgt = (s < t) ? exp2f(lb + R) : 0.f;
            if (s < t) R += lb - z;
#pragma unroll
            for (int j = 0; j < 8; ++j) { const v4u w = vp[j];
                o[8 * j] += wgt * bflo(w.x); o[8 * j + 1] += wgt * bfhi(w.x); o[8 * j + 2] += wgt * bflo(w.y); o[8 * j + 3] += wgt * bfhi(w.y);
                o[8 * j + 4] += wgt * bflo(w.z); o[8 * j + 5] += wgt * bfhi(w.z); o[8 * j + 6] += wgt * bflo(w.w); o[8 * j + 7] += wgt * bfhi(w.w); }
        }
        v4u* op = (v4u*)(F.OMIX + row * D + h * 64);
#pragma unroll
        for (int j = 0; j < 8; ++j) { v4u w; w.x = pk2(o[8 * j], o[8 * j + 1]); w.y = pk2(o[8 * j + 2], o[8 * j + 3]); w.z = pk2(o[8 * j + 4], o[8 * j + 5]); w.w = pk2(o[8 * j + 6], o[8 * j + 7]); op[j] = w; }
    }
}
__device__ __forceinline__ void p3_gla_base(Frame& F) {
    if (F.gw >= BATCH * GH * 2) return;
    const int b = F.gw / (GH * 2), h = (F.gw / 2) % GH, vc = (F.gw & 1) * 64 + F.lane;
    float S[64];
#pragma unroll
    for (int k = 0; k < 64; ++k) S[k] = 0.f;
    int zero = 0; asm volatile("" : "+v"(zero));
    for (int t = 0; t < SEQ; ++t) {
        const size_t row = (size_t)b * SEQ + t;
        const bf16* pr = F.PROJ + row * NPROJ + zero;
        const float vv = bf2f(pr[COL_GV + h * 128 + vc]);
        const v4u* kp = (const v4u*)(pr + COL_GK + h * 64); const v4u* qp = (const v4u*)(pr + COL_GQ + h * 64);
        const f32x4* lp = (const f32x4*)(F.LOGA + row * 256 + h * 64 + zero);
        float o = 0.f;
#pragma unroll
        for (int j = 0; j < 8; ++j) { const v4u kw = kp[j], qw = qp[j]; const f32x4 l0 = lp[2 * j], l1 = lp[2 * j + 1];
            const float kk[8] = {bflo(kw.x), bfhi(kw.x), bflo(kw.y), bfhi(kw.y), bflo(kw.z), bfhi(kw.z), bflo(kw.w), bfhi(kw.w)};
            const float qq[8] = {bflo(qw.x), bfhi(qw.x), bflo(qw.y), bfhi(qw.y), bflo(qw.z), bfhi(qw.z), bflo(qw.w), bfhi(qw.w)};
            const float ll[8] = {l0.x, l0.y, l0.z, l0.w, l1.x, l1.y, l1.z, l1.w};
#pragma unroll
            for (int i = 0; i < 8; ++i) { const float a = __expf(ll[i]); S[8 * j + i] = a * S[8 * j + i] + kk[i] * vv; o += qq[i] * S[8 * j + i]; } }
        F.OG[row * 512 + h * 128 + vc] = o;
    }
}
__device__ __forceinline__ void p4_gla_out(Frame& F) {
    for (int t = F.gw; t < T; t += F.NGW) {
        const int c0 = F.lane * 8;
        const f32x4* op = (const f32x4*)(F.OG + (size_t)t * 512 + c0); const f32x4 a = op[0], b = op[1];
        float ss = (a.x * a.x + a.y * a.y) + (a.z * a.z + a.w * a.w) + (b.x * b.x + b.y * b.y) + (b.z * b.z + b.w * b.w);
        ss += __shfl_xor(ss, 1); ss += __shfl_xor(ss, 2); ss += __shfl_xor(ss, 4); ss += __shfl_xor(ss, 8);
        const float inv = 1.0f / sqrtf(ss * (1.0f / GDV) + RMS_EPS);
        const f32x4* gp = (const f32x4*)(F.gnorm_g + c0); const f32x4 g0 = gp[0], g1 = gp[1];
        const v4u grw = *(const v4u*)(F.PROJ + (size_t)t * NPROJ + COL_GR + c0);
        const float gr[8] = {bflo(grw.x), bfhi(grw.x), bflo(grw.y), bfhi(grw.y), bflo(grw.z), bfhi(grw.z), bflo(grw.w), bfhi(grw.w)};
        const float ov[8] = {a.x, a.y, a.z, a.w, b.x, b.y, b.z, b.w}; const float gg[8] = {g0.x, g0.y, g0.z, g0.w, g1.x, g1.y, g1.z, g1.w};
        float r[8];
#pragma unroll
        for (int i = 0; i < 8; ++i) { const float sl = gr[i] / (1.0f + __expf(-gr[i])); r[i] = ov[i] * inv * gg[i] * sl; }
        v4u w; w.x = pk2(r[0], r[1]); w.y = pk2(r[2], r[3]); w.z = pk2(r[4], r[5]); w.w = pk2(r[6], r[7]);
        *(v4u*)(F.OMIX + (size_t)t * D + 512 + c0) = w;
    }
}
__device__ __forceinline__ void p5_outproj_base(Frame& F) {
    const int r = F.lane & 31, h = F.lane >> 5;
    constexpr int NT = D / 32, MT = T / 32;
    for (int it = F.gw; it < MT * NT; it += F.NGW) {
        const int mt = it / NT, nt = it % NT;
        const f32x16 acc = tile32(F.OMIX + (size_t)(mt * 32 + r) * D, F.WoutT + (size_t)(nt * 32 + r) * D, D, h);
#pragma unroll
        for (int i = 0; i < 16; ++i) { const size_t idx = (size_t)(mt * 32 + crow(i, h)) * D + nt * 32 + r; F.X1[idx] = F.x[idx] + acc[i]; }
    }
}
__device__ __forceinline__ void p6_route(Frame& F) {
    for (int t = F.gw; t < T; t += F.NGW) {
        const GAS f32x4* xr = (const GAS f32x4*)(F.X1 + (size_t)t * D) + F.lane; const GAS f32x4* gr = (const GAS f32x4*)F.ln2_g + F.lane;
        f32x4 v[4]; float s = 0.f;
#pragma unroll
        for (int j = 0; j < 4; ++j) { v[j] = xr[64 * j]; s += (v[j].x * v[j].x + v[j].y * v[j].y) + (v[j].z * v[j].z + v[j].w * v[j].w); }
        const float inv = 1.0f / sqrtf(wave_sum(s) * (1.f / D) + RMS_EPS);
        GAS unsigned long long* o8 = (GAS unsigned long long*)(F.H2 + (size_t)t * D) + F.lane;
#pragma unroll
        for (int j = 0; j < 4; ++j) { const f32x4 gg = gr[64 * j]; v[j].x = v[j].x * inv * gg.x; v[j].y = v[j].y * inv * gg.y; v[j].z = v[j].z * inv * gg.z; v[j].w = v[j].w * inv * gg.w;
            o8[64 * j] = (unsigned long long)pk2(v[j].x, v[j].y) | ((unsigned long long)pk2(v[j].z, v[j].w) << 32); }
        float lg[NGRP], le[NE];
#pragma unroll
        for (int c = 0; c < NGRP; ++c) lg[c] = 0.f;
#pragma unroll
        for (int c = 0; c < NE; ++c) le[c] = 0.f;
#pragma unroll 1
        for (int jq = 0; jq < 16; ++jq) { const int j = jq >> 2, q = jq & 3;
            const f32x4 vj = j == 0 ? v[0] : (j == 1 ? v[1] : (j == 2 ? v[2] : v[3]));
            const float hv = q == 0 ? vj.x : (q == 1 ? vj.y : (q == 2 ? vj.z : vj.w));
            const int k = 4 * (64 * j + F.lane) + q;
            const f32x4 wg = *(const f32x4*)(F.w_group + (size_t)k * NGRP);
            lg[0] += hv * wg.x; lg[1] += hv * wg.y; lg[2] += hv * wg.z; lg[3] += hv * wg.w;
            const f32x4* we = (const f32x4*)(F.w_expert + (size_t)k * NE);
#pragma unroll
            for (int c4 = 0; c4 < NE / 4; ++c4) { const f32x4 w = we[c4]; le[4 * c4] += hv * w.x; le[4 * c4 + 1] += hv * w.y; le[4 * c4 + 2] += hv * w.z; le[4 * c4 + 3] += hv * w.w; } }
#pragma unroll
        for (int c = 0; c < NGRP; ++c) lg[c] = wave_sum(lg[c]) + F.b_group[c];
#pragma unroll
        for (int c = 0; c < NE; ++c) le[c] = wave_sum(le[c]) + F.b_expert[c];
        int gi = 0; float gm = lg[0];
#pragma unroll
        for (int c = 1; c < NGRP; ++c) if (lg[c] > gm) { gm = lg[c]; gi = c; }
        float gs = 0.f;
#pragma unroll
        for (int c = 0; c < NGRP; ++c) gs += __expf(lg[c] - gm);
        const float gp = 1.0f / gs;
        float sel[EPG];
#pragma unroll
        for (int i = 0; i < EPG; ++i) { sel[i] = le[i];
#pragma unroll
            for (int g = 1; g < NGRP; ++g) sel[i] = (gi == g) ? le[g * EPG + i] : sel[i]; }
        int i1 = 0; float m1 = sel[0];
#pragma unroll
        for (int i = 1; i < EPG; ++i) if (sel[i] > m1) { m1 = sel[i]; i1 = i; }
        int i2 = -1; float m2 = -3.0e38f;
#pragma unroll
        for (int i = 0; i < EPG; ++i) if (i != i1 && sel[i] > m2) { m2 = sel[i]; i2 = i; }
        const float e21 = __expf(m2 - m1); const float w1 = 1.0f / (1.0f + e21), w2 = e21 * w1;
        if (F.lane == 0) {
            const int e1 = gi * EPG + i1, e2 = gi * EPG + i2;
            const int r1 = (int)__hip_atomic_fetch_add(F.cnt + e1, 1u, RLX_AGENT), r2 = (int)__hip_atomic_fetch_add(F.cnt + e2, 1u, RLX_AGENT);
            F.toklist[e1 * CAP + r1] = t; F.gatelist[e1 * CAP + r1] = gp * w1;
            F.toklist[e2 * CAP + r2] = t; F.gatelist[e2 * CAP + r2] = gp * w2;
            *(int4*)(F.tokinfo + 4 * t) = make_int4(e1, r1, e2, r2);
        }
    }
}
__device__ __forceinline__ void load_emap(Frame& F, int& cnt_l, int& pst_l, int& cend32_l) {
    const int e = F.lane & 31;
    cnt_l = (int)__hip_atomic_load(F.cnt + e, RLX_AGENT);
    int p = (cnt_l + 255) & ~255, c = (cnt_l + 31) >> 5;
#pragma unroll
    for (int o = 1; o < 32; o <<= 1) { const int pp = __shfl_up(p, o), cc = __shfl_up(c, o); if (e >= o) { p += pp; c += cc; } }
    pst_l = p - ((cnt_l + 255) & ~255); cend32_l = c;
}
__device__ __forceinline__ void p7_gateup_base(Frame& F) {
    const int r = F.lane & 31, h = F.lane >> 5;
    int cnt_l, pst_l, cend_l; load_emap(F, cnt_l, pst_l, cend_l);
    const int total = __shfl(cend_l, 31) * (DFF / 32);
    for (int it = F.gw; it < total; it += F.NGW) {
        const int g = it / (DFF / 32), nt = it % (DFF / 32);
        const int e = __popcll(__ballot(F.lane < 32 && cend_l <= g));
        const int base = e > 0 ? __shfl(cend_l, e - 1) : 0;
        const int mt = g - base; const int n_e = __shfl(cnt_l, e); const int ps = __shfl(pst_l, e);
        const int idx = mt * 32 + r; const int tok = idx < n_e ? F.toklist[e * CAP + idx] : 0;
        const int hc = nt * 32 + r; const size_t brow = (size_t)e * 1024 + (size_t)(hc / 128) * 256 + (hc % 128);
        const f32x16 ag = tile32(F.H2 + (size_t)tok * D, F.WguT + brow * D, D, h);
        const f32x16 au = tile32(F.H2 + (size_t)tok * D, F.WguT + (brow + 128) * D, D, h);
#pragma unroll
        for (int i = 0; i < 16; ++i) { const int rr = mt * 32 + crow(i, h);
            if (rr < n_e) { const float gv = ag[i]; const float hv = gv / (1.0f + __expf(-gv)) * au[i]; F.HBUF[(size_t)(ps + rr) * DFF + hc] = (bf16)f2bf(hv); } }
    }
}
__device__ __forceinline__ void p8_down_base(Frame& F) {
    const int r = F.lane & 31, h = F.lane >> 5;
    int cnt_l, pst_l, cend_l; load_emap(F, cnt_l, pst_l, cend_l);
    const int total = __shfl(cend_l, 31) * (D / 32);
    for (int it = F.gw; it < total; it += F.NGW) {
        const int g = it / (D / 32), nt = it % (D / 32);
        const int e = __popcll(__ballot(F.lane < 32 && cend_l <= g));
        const int base = e > 0 ? __shfl(cend_l, e - 1) : 0;
        const int mt = g - base; const int n_e = __shfl(cnt_l, e); const int ps = __shfl(pst_l, e);
        int idx = mt * 32 + r; if (idx >= n_e) idx = n_e - 1;
        const f32x16 acc = tile32(F.HBUF + (size_t)(ps + idx) * DFF, F.WdT + ((size_t)e * 1024 + nt * 32 + r) * DFF, DFF, h);
#pragma unroll
        for (int i = 0; i < 16; ++i) { const int rr = mt * 32 + crow(i, h);
            if (rr < n_e) F.Y[(size_t)(ps + rr) * D + nt * 32 + r] = (bf16)f2bf(acc[i] * F.gatelist[e * CAP + rr]); }
    }
}
__device__ __forceinline__ void p9_final(Frame& F) {
    int cnt_l, pst_l, cend_l; load_emap(F, cnt_l, pst_l, cend_l);
    for (int t = F.gw; t < T; t += F.NGW) {
        const int4 ti = *(const int4*)(F.tokinfo + 4 * t);
        const int s1 = __shfl(pst_l, ti.x) + ti.y, s2 = __shfl(pst_l, ti.z) + ti.w;
        GAS f32x4* xr = (GAS f32x4*)(F.X1 + (size_t)t * D) + F.lane; const GAS f32x4* gr = (const GAS f32x4*)F.lnf_g + F.lane;
        const GAS v2u* y1 = (const GAS v2u*)(F.Y + (size_t)s1 * D) + F.lane; const GAS v2u* y2 = (const GAS v2u*)(F.Y + (size_t)s2 * D) + F.lane;
        f32x4 v[4]; float s = 0.f;
#pragma unroll
        for (int j = 0; j < 4; ++j) { v[j] = xr[64 * j]; const v2u a = y1[64 * j], b = y2[64 * j];
            v[j].x += bflo(a.x) + bflo(b.x); v[j].y += bfhi(a.x) + bfhi(b.x); v[j].z += bflo(a.y) + bflo(b.y); v[j].w += bfhi(a.y) + bfhi(b.y);
            s += (v[j].x * v[j].x + v[j].y * v[j].y) + (v[j].z * v[j].z + v[j].w * v[j].w); }
        const float inv = 1.0f / sqrtf(wave_sum(s) * (1.f / D) + RMS_EPS);
#pragma unroll
        for (int j = 0; j < 4; ++j) { const f32x4 gg = gr[64 * j]; f32x4 o; o.x = v[j].x * inv * gg.x; o.y = v[j].y * inv * gg.y; o.z = v[j].z * inv * gg.z; o.w = v[j].w * inv * gg.w; xr[64 * j] = o; }
    }
}

constexpr int NPHASE = 10;
struct Args { const float* in[16]; float* out; unsigned char* ws; int ph_lo, ph_hi, li, pad; };
__global__ void __launch_bounds__(NWAVES * 64, 2) mk_fwd(Args args) {
    extern __shared__ __attribute__((aligned(16))) unsigned char lds[];
    Frame F;
    F.lds = (LAS unsigned char*)lds;
    F.MISC = (volatile LAS unsigned*)(F.lds + MISC_OFF);
    F.tid = threadIdx.x; F.lane = F.tid & 63; F.wave = __builtin_amdgcn_readfirstlane(F.tid >> 6);
    F.G = gridDim.x; { const int bx = blockIdx.x; F.vcu = (F.G % 8 == 0) ? (bx % 8) * (F.G / 8) + bx / 8 : bx; }
    F.gw = F.vcu * NWAVES + F.wave; F.NGW = F.G * NWAVES;
    unsigned char* ws = args.ws; F.ws = ws;
    F.ctl = (gu32*)(ws + WS_CTL);
    F.x = args.in[0]; F.ln1_g = args.in[1]; F.w_in = args.in[2]; F.gate_w2 = args.in[3]; F.gate_b = args.in[4]; F.gnorm_g = args.in[5]; F.w_out = args.in[6]; F.ln2_g = args.in[7];
    F.w_group = args.in[8]; F.b_group = args.in[9]; F.w_expert = args.in[10]; F.b_expert = args.in[11]; F.ew_gate = args.in[12]; F.ew_up = args.in[13]; F.ew_down = args.in[14]; F.lnf_g = args.in[15];
    F.out = args.out;
    F.WinT = (bf16*)(ws + WS_WIN); F.WoutT = (bf16*)(ws + WS_WOUT); F.WguT = (bf16*)(ws + WS_WGU); F.WdT = (bf16*)(ws + WS_WD);
    F.XN = (bf16*)(ws + WS_R1); F.OMIX = (bf16*)(ws + WS_R1); F.H2 = (bf16*)(ws + WS_R1);
    F.PROJ = (bf16*)(ws + WS_R2); F.HBUF = (bf16*)(ws + WS_R2); F.Y = (bf16*)(ws + WS_Y);
    F.GLR = (float*)(ws + WS_GLR); F.LOGA = (float*)((unsigned char*)args.out + DO_LOGA); F.OG = (float*)((unsigned char*)args.out + DO_OG); F.X1 = args.out;
    F.toklist = (int*)(ws + WS_TOKLIST); F.gatelist = (float*)(ws + WS_GATELIST); F.tokinfo = (int*)(ws + WS_TOKINFO); F.cnt = (unsigned*)(ws + WS_CTL) + CW_CNT;
    for (int u = F.tid; u < (LDS_BYTES - LDSCTL_OFF) / 4; u += NWAVES * 64) ((LAS unsigned*)(F.lds + LDSCTL_OFF))[u] = 0u;
    __syncthreads();
    XcdBarrier bar = xcd_barrier_post((unsigned*)(F.ctl + CW_BAR) + args.li * XCD_BAR_WORDS, F.MISC + 8);
    const int lo = args.ph_lo, hi = args.ph_hi;
#define IN(k) (lo <= (k) && (k) < hi)
#define SEAM(k) do { if (IN(k) && IN((k) + 1)) xcd_barrier(bar); } while (0)
    if (IN(0)) { p0_prologue(F); } SEAM(0);
    if (IN(1)) { p1_proj_base(F); p1_glr(F); } SEAM(1);
    if (IN(2)) { p2_loga(F); p2_sb_base(F); } SEAM(2);
    if (IN(3)) { p3_gla_base(F); } SEAM(3);
    if (IN(4)) { p4_gla_out(F); } SEAM(4);
    if (IN(5)) { p5_outproj_base(F); } SEAM(5);
    if (IN(6)) { p6_route(F); } SEAM(6);
    if (IN(7)) { p7_gateup_base(F); } SEAM(7);
    if (IN(8)) { p8_down_base(F); } SEAM(8);
    if (IN(9)) { p9_final(F); }
#undef IN
#undef SEAM
}

#ifndef MK_ONE_LAUNCH
#define MK_ONE_LAUNCH 1
#endif
extern "C" void kernel_launch(void* const* d_in, const int* in_sizes, int n_in, void* d_out, int out_size, void* d_ws, size_t ws_size, hipStream_t stream) {
    static int grid = 0;
    if (grid == 0) {
        if (n_in != 16 || in_sizes[0] != T * D || out_size != T * D || ws_size < WS_END) {
            fprintf(stderr, "kernel_launch: unexpected shapes / workspace (n_in %d, in0 %d, out %d, ws %zu, need %zu); nothing launched\n", n_in, n_in > 0 ? in_sizes[0] : -1, out_size, ws_size, (size_t)WS_END); grid = -1; return; }
        int dev = 0, cus = 0, per_cu = 0;
        if (hipGetDevice(&dev) != hipSuccess || hipDeviceGetAttribute(&cus, hipDeviceAttributeMultiprocessorCount, dev) != hipSuccess) { grid = -1; return; }
        if (hipFuncSetAttribute((const void*)mk_fwd, hipFuncAttributeMaxDynamicSharedMemorySize, LDS_BYTES) != hipSuccess) { fprintf(stderr, "kernel_launch: hipFuncSetAttribute failed\n"); grid = -1; return; }
        if (hipOccupancyMaxActiveBlocksPerMultiprocessor(&per_cu, (const void*)mk_fwd, NWAVES * 64, LDS_BYTES) != hipSuccess || per_cu < 1) { fprintf(stderr, "kernel_launch: occupancy query says %d\n", per_cu); per_cu = 1; }
        (void)hipGetLastError();
        grid = cus;
    }
    if (grid < 0) return;
    (void)hipMemsetAsync((char*)d_ws + WS_CTL, 0, CTL_ZERO_BYTES, stream);
    Args a{};
    for (int i = 0; i < 16; ++i) a.in[i] = (const float*)d_in[i];
    a.out = (float*)d_out; a.ws = (unsigned char*)d_ws;
#if MK_ONE_LAUNCH
    a.ph_lo = 0; a.ph_hi = NPHASE; a.li = 0;
    { void* kargs[] = {&a}; hipError_t e = hipLaunchCooperativeKernel((const void*)mk_fwd, dim3(grid), dim3(NWAVES * 64), kargs, LDS_BYTES, stream);
      if (e != hipSuccess) fprintf(stderr, "kernel_launch: cooperative launch failed: %s\n", hipGetErrorString(e)); }
#else
    for (int p = 0; p < NPHASE; ++p) { a.ph_lo = p; a.ph_hi = p + 1; a.li = 0; hipLaunchKernelGGL(mk_fwd, dim3(grid), dim3(NWAVES * 64), LDS_BYTES, stream, a); }
#endif
}
```

```cpp
#include <hip/hip_runtime.h>
#include <cstdio>
#include <cstdint>

#define GAS __attribute__((address_space(1)))
#define LAS __attribute__((address_space(3)))
typedef unsigned short bf16;
typedef short bf16x8 __attribute__((ext_vector_type(8)));
typedef float f32x4 __attribute__((ext_vector_type(4)));
typedef float f32x16 __attribute__((ext_vector_type(16)));
typedef unsigned v4u __attribute__((ext_vector_type(4)));
typedef unsigned v2u __attribute__((ext_vector_type(2)));
typedef GAS unsigned gu32;
#define RLX_AGENT __ATOMIC_RELAXED, __HIP_MEMORY_SCOPE_AGENT
#define LDS_WAIT() asm volatile("s_waitcnt lgkmcnt(0)" ::: "memory")
#define VM_WAIT() asm volatile("s_waitcnt vmcnt(0)" ::: "memory")

constexpr int BATCH = 4, SEQ = 4096, T = BATCH * SEQ, D = 1024, DIN = 3088, NPROJ = 3072;
constexpr int SBH = 8, SBD = 64, GH = 4, GDK = 64, GDV = 128, GRANK = 16;
constexpr int NE = 32, EPG = 8, NGRP = 4, DFF = 512;
constexpr int COL_SBQ = 0, COL_SBK = 512, COL_SBV = 1024, COL_GQ = 1536, COL_GK = 1792, COL_GV = 2048, COL_GR = 2560, COL_GLR = 3072;
constexpr float RMS_EPS = 1e-6f;
constexpr float LOG2E = 1.4426950408889634f;
constexpr float SBQ_SCALE = 0.125f * LOG2E;
constexpr float GQ_SCALE = 0.125f;
constexpr int NWAVES = 8;
constexpr int CAP = T;

constexpr size_t MiB = 1u << 20;
constexpr size_t WS_CTL = 0, CTL_ZERO_BYTES = 1 * MiB;
constexpr size_t WS_TOKLIST = 1 * MiB;
constexpr size_t WS_GATELIST = 3 * MiB;
constexpr size_t WS_TOKINFO = 5 * MiB;
constexpr size_t WS_GLR = 6 * MiB;
constexpr size_t WS_DEC = 7 * MiB;
constexpr size_t WS_WIN = 8 * MiB;
constexpr size_t WS_WOUT = 15 * MiB;
constexpr size_t WS_WD = 17 * MiB;
constexpr size_t WS_WGU = 49 * MiB;
constexpr size_t WS_R1 = 113 * MiB;
constexpr size_t WS_R2 = 153 * MiB;
constexpr size_t WS_Y = WS_WGU;
constexpr size_t WS_END = 249 * MiB;
constexpr size_t DO_LOGA = 0;
constexpr size_t DO_OG = 16 * MiB;
constexpr size_t DO_ST = 48 * MiB;
constexpr int CW_TMO = 0, CW_CODE = 1;
constexpr int CW_CNT = 1024;
constexpr int CW_BAR = 4096;

constexpr int RING_OFF = 0, RING_BYTES = 131072;
constexpr int LDSCTL_OFF = RING_BYTES, MISC_OFF = LDSCTL_OFF + 320;
constexpr int LDS_BYTES = 147456;

__device__ __forceinline__ unsigned f2bf(float f) { unsigned u = __builtin_bit_cast(unsigned, f); return (u + 0x7fffu + ((u >> 16) & 1u)) >> 16; }
__device__ __forceinline__ unsigned pk2(float lo, float hi) { return f2bf(lo) | (f2bf(hi) << 16); }
__device__ __forceinline__ float bf2f(unsigned b) { return __builtin_bit_cast(float, b << 16); }
__device__ __forceinline__ float bflo(unsigned w) { return __builtin_bit_cast(float, w << 16); }
__device__ __forceinline__ float bfhi(unsigned w) { return __builtin_bit_cast(float, w & 0xffff0000u); }
__device__ __forceinline__ int crow(int r, int hi) { return (r & 3) + 8 * (r >> 2) + 4 * hi; }
__device__ __forceinline__ float wave_sum(float v) {
#pragma unroll
    for (int o = 1; o < 64; o <<= 1) v += __shfl_xor(v, o);
    return v;
}

#define XB_TMO      128
#define XB_XCNT(j)  (256  + 64 * (j))
#define XB_XSUB(j)  (1280 + 64 * (j))
#define XB_XGEN(j)  (2304 + 64 * (j))
#define XB_TOP      3328
#define XB_TOPGEN   3392
#define XCD_BAR_WORDS 3456
#define XB_SPIN_CAP (1u << 18)
__device__ __forceinline__ unsigned xb_ld(unsigned* p)              { return __hip_atomic_load(p, __ATOMIC_RELAXED, __HIP_MEMORY_SCOPE_AGENT); }
__device__ __forceinline__ unsigned xb_add(unsigned* p, unsigned v) { return __hip_atomic_fetch_add(p, v, __ATOMIC_RELAXED, __HIP_MEMORY_SCOPE_AGENT); }
__device__ __forceinline__ unsigned xb_xcc_id() { return (unsigned)__builtin_amdgcn_s_getreg((3 << 11) | 20) & 0xFu; }
#define XB_SPIN(cond, bar) do { unsigned _sp = 0; while (cond) { __builtin_amdgcn_s_sleep(1); \
    if ((++_sp & 255u) == 0u) { if (xb_ld(&(bar)[XB_TMO])) break; if (_sp > XB_SPIN_CAP) { atomicAdd(&(bar)[XB_TMO], 1u); break; } } } } while (0)
struct XcdBarrier { unsigned* bar; unsigned x; volatile LAS unsigned* st; };
__device__ __forceinline__ XcdBarrier xcd_barrier_post(unsigned* bar, volatile LAS unsigned* st) {
    XcdBarrier b; b.bar = bar; b.x = xb_xcc_id(); b.st = st;
    if (threadIdx.x == 0) (void)xb_add(&bar[XB_XCNT(b.x)], 1u);
    return b;
}
__device__ __forceinline__ void xcd_barrier_complete(unsigned* bar, unsigned x, unsigned& nloc, unsigned& nx) {
    const unsigned G = gridDim.x * gridDim.y * gridDim.z;
    unsigned sum, cnt, mine, sp = 0u;
    for (;;) {
        sum = 0u; cnt = 0u; mine = 0u;
#pragma unroll
        for (unsigned j = 0; j < 16; ++j) { const unsigned c = xb_ld(&bar[XB_XCNT(j)]); sum += c; cnt += (c > 0u) ? 1u : 0u; mine = (j == x) ? c : mine; }
        if (sum == G) break;
        __builtin_amdgcn_s_sleep(1);
        if ((++sp & 255u) == 0u) { if (xb_ld(&bar[XB_TMO])) break; if (sp > XB_SPIN_CAP) { atomicAdd(&bar[XB_TMO], 1u); break; } }
    }
    nloc = mine > 0u ? mine : 1u; nx = cnt > 0u ? cnt : 1u;
}
__device__ __forceinline__ void xcd_barrier(const XcdBarrier& b) {
    asm volatile("s_waitcnt vmcnt(0)" ::: "memory");
    __syncthreads();
    if (threadIdx.x == 0) {
        unsigned* bar = b.bar;
        __builtin_amdgcn_s_waitcnt(0);
        unsigned nloc = b.st[0], nx = b.st[1];
        if (nloc == 0u) { xcd_barrier_complete(bar, b.x, nloc, nx); b.st[0] = nloc; b.st[1] = nx; }
        const unsigned old = xb_add(&bar[XB_XSUB(b.x)], 1u);
        const unsigned gen = old / nloc;
        if (old + 1u == (gen + 1u) * nloc) {
            __builtin_amdgcn_fence(__ATOMIC_RELEASE, "agent");
            asm volatile("s_waitcnt vmcnt(0)" ::: "memory");
            const unsigned og = xb_add(&bar[XB_TOP], 1u);
            const unsigned tg = og / nx;
            if (og + 1u == (tg + 1u) * nx) xb_add(&bar[XB_TOPGEN], 1u);
            else XB_SPIN(xb_ld(&bar[XB_TOPGEN]) == tg, bar);
            __builtin_amdgcn_fence(__ATOMIC_ACQUIRE, "agent");
            xb_add(&bar[XB_XGEN(b.x)], 1u);
            asm volatile("s_waitcnt vmcnt(0)" ::: "memory");
        } else {
            XB_SPIN(xb_ld(&bar[XB_XGEN(b.x)]) == gen, bar);
            __builtin_amdgcn_fence(__ATOMIC_ACQUIRE, "agent");
            asm volatile("s_waitcnt vmcnt(0)" ::: "memory");
        }
    }
    __syncthreads();
}


namespace pg8 {
#define PG8_LAS __attribute__((address_space(3)))
typedef unsigned short bf16_t;
typedef unsigned u32x4 __attribute__((ext_vector_type(4)));
constexpr int BM = 256, BK = 64, HALF = 128, HTB = HALF * BK * 2, STAGE_BYTES = 8 * HTB, NXCD = 8, WGM = 8;
__host__ __device__ __forceinline__ int lds_byte(int r, int c) { const int st = (r >> 4) * 2 + (c >> 5), rr = r & 15, cc = c & 31, ob = rr * 64 + cc * 2; return st * 1024 + (ob ^ (((ob >> 9) & 1) << 5)); }
__host__ __device__ __forceinline__ void stage_rc(int b, int& R, int& C) { const int st = b / 1024, sb = b % 1024, swz = sb ^ (((sb >> 9) & 1) << 5); R = (st >> 1) * 16 + swz / 64; C = (st & 1) * 32 + (swz % 64) / 2; }
__host__ __device__ __forceinline__ int perm32(int rho) { const int n = rho >> 4, i = rho & 15; return 8 * (i >> 2) + 4 * n + (i & 3); }
struct Unit { int pm, pn, e, r0, ne; };
struct Gemm { const bf16_t* A; const bf16_t* Bt; int M, N, K; };
struct StaticOrder {
    int nM, nN, nwg, G, c;
    __device__ void init(int M, int N, int G_, int c_) { nM = M / BM; nN = N / BM; nwg = nM * nN; G = G_; c = c_; }
    __device__ __forceinline__ bool next(int i, Unit& u) const {
        const long L = (long)i * G + c; if (L >= nwg) return false;
        int wgid = (int)L; { const int q = nwg / NXCD, r = nwg % NXCD, xcd = wgid % NXCD, off = wgid / NXCD; wgid = (xcd < r ? xcd * (q + 1) : r * (q + 1) + (xcd - r) * q) + off; }
        const int nig = WGM * nN, gid = wgid / nig, fm = gid * WGM, gsz = (nM - fm) < WGM ? (nM - fm) : WGM;
        u.pm = fm + ((wgid % nig) % gsz); u.pn = (wgid % nig) / gsz; u.e = 0; u.r0 = 0; u.ne = 0; return true;
    }
    __device__ __forceinline__ int src_row(const Unit& u, int R) const { return u.pm * BM + R; }
};
__device__ __forceinline__ unsigned cvt_pk_bf16(float lo, float hi) { unsigned r; asm volatile("v_cvt_pk_bf16_f32 %0, %1, %2" : "=v"(r) : "v"(lo), "v"(hi)); return r; }

template <class Epi, class Sched, bool ALIGN_EPI, bool GATHER>
__device__ __forceinline__ void gemm_phase(PG8_LAS unsigned char* lds, const Gemm g, const Sched& S, const Epi& E) {
    const int tid = threadIdx.x, wid = __builtin_amdgcn_readfirstlane(tid >> 6), lane = tid & 63, wr = wid >> 2, wc = wid & 3, fr = lane & 15, fq = lane >> 4;
    const int K = g.K, nt = K / BK;
    int RA[2], CA[2]; unsigned voffB[2];
#pragma unroll
    for (int i = 0; i < 2; ++i) { int R, C; stage_rc(tid * 16 + i * 8192, R, C); const int Rb = Epi::PERM ? ((R & ~31) + perm32(R & 31)) : R;
        RA[i] = R; CA[i] = C; voffB[i] = (unsigned)(Rb * K + C) * 2u; }
    const size_t kstep = (size_t)(BK * 2);
    const size_t hstep = (size_t)HALF * K * 2;
    const size_t tstep = 2 * hstep;
    const unsigned ldsw = (unsigned)wid * 1024u;
    const int aoff = lds_byte(wr * 64 + fr, fq * 8), boff = lds_byte(wc * 32 + fr, fq * 8);
#define PG8_SA(b, h) (((b) * 2 + (h)) * HTB)
#define PG8_SB(b, h) ((4 + (b) * 2 + (h)) * HTB)
#define PG8_STAGE(bufoff, gbase, voff) do { _Pragma("unroll") for (int _i = 0; _i < 2; ++_i) \
        __builtin_amdgcn_global_load_lds((const unsigned*)((const char*)(gbase) + (voff)[_i]), (PG8_LAS unsigned*)(lds + (bufoff) + ldsw + _i * 8192), 16, 0, 0); } while (0)
#define PG8_LDA(dst, b, h) do { _Pragma("unroll") for (int m = 0; m < 4; ++m) _Pragma("unroll") for (int k = 0; k < 2; ++k) dst[m][k] = *(const PG8_LAS bf16x8*)(lds + PG8_SA(b, h) + aoff + m * 2048 + k * 1024); } while (0)
#define PG8_LDB(dst, b, h) do { _Pragma("unroll") for (int n = 0; n < 2; ++n) _Pragma("unroll") for (int k = 0; k < 2; ++k) dst[n][k] = *(const PG8_LAS bf16x8*)(lds + PG8_SB(b, h) + boff + n * 2048 + k * 1024); } while (0)
#define PG8_MMA(ai, bj, At, Bt) do { __builtin_amdgcn_s_setprio(1); _Pragma("unroll") for (int m = 0; m < 4; ++m) _Pragma("unroll") for (int n = 0; n < 2; ++n) _Pragma("unroll") for (int k = 0; k < 2; ++k) \
        acc[ai][bj][m][n] = __builtin_amdgcn_mfma_f32_16x16x32_bf16(Bt[n][k], At[m][k], acc[ai][bj][m][n], 0, 0, 0); __builtin_amdgcn_s_setprio(0); } while (0)
#define PG8_WAIT_V(n) asm volatile("s_waitcnt vmcnt(" #n ")" ::: "memory")
#define PG8_WAIT_L(n) asm volatile("s_waitcnt lgkmcnt(" #n ")" ::: "memory")
#define PG8_BAR __builtin_amdgcn_s_barrier()
#define PG8_SCHED __builtin_amdgcn_sched_barrier(0)
#define PG8_CALC_VA(dst, u) do { _Pragma("unroll") for (int _h = 0; _h < 2; ++_h) _Pragma("unroll") for (int _i = 0; _i < 2; ++_i) { \
        if constexpr (GATHER) dst[_h][_i] = (unsigned)(S.src_row(u, _h * HALF + RA[_i]) * K + CA[_i]) * 2u; \
        else dst[_h][_i] = (unsigned)((_h * HALF + RA[_i]) * K + CA[_i]) * 2u; } } while (0)
    Unit cur, nxt; int ui = 0;
    if (!S.next(0, cur)) return;
    f32x4 acc[2][2][4][2];
#pragma unroll
    for (int a = 0; a < 2; ++a)
#pragma unroll
        for (int b = 0; b < 2; ++b)
#pragma unroll
            for (int m = 0; m < 4; ++m)
#pragma unroll
                for (int n = 0; n < 2; ++n) acc[a][b][m][n] = (f32x4){0.f, 0.f, 0.f, 0.f};
    bf16x8 At[4][2], B0[2][2], B1[2][2];
    unsigned vA[2][2], vAn[2][2];
    PG8_CALC_VA(vA, cur);
    const char* cA = (const char*)g.A + (GATHER ? (size_t)0 : (size_t)cur.pm * tstep); const char* cB = (const char*)g.Bt + (size_t)cur.pn * tstep;
    PG8_STAGE(PG8_SB(0, 0), cB, voffB); PG8_STAGE(PG8_SB(0, 1), cB + hstep, voffB); PG8_STAGE(PG8_SA(0, 0), cA, vA[0]); PG8_STAGE(PG8_SA(0, 1), cA, vA[1]);
    if (wr == 1) PG8_BAR;
    PG8_WAIT_V(2); PG8_BAR;
    PG8_STAGE(PG8_SB(1, 0), cB + kstep, voffB); PG8_STAGE(PG8_SA(1, 0), cA + kstep, vA[0]); PG8_STAGE(PG8_SB(1, 1), cB + hstep + kstep, voffB);
    PG8_WAIT_V(6); PG8_BAR;
    for (;;) {
        const bool has_next = S.next(ui + 1, nxt);
        if (!has_next) nxt = cur;
        const char* nA = (const char*)g.A + (GATHER ? (size_t)0 : (size_t)nxt.pm * tstep); const char* nB = (const char*)g.Bt + (size_t)nxt.pn * tstep;
        if (has_next) { PG8_CALC_VA(vAn, nxt); } else {
#pragma unroll
            for (int _h = 0; _h < 2; ++_h)
#pragma unroll
                for (int _i = 0; _i < 2; ++_i) vAn[_h][_i] = vA[_h][_i]; }
        for (int t = 0; t < nt; t += 2) {
            const bool last = (t == nt - 2);
            const char* a1 = cA + (size_t)(t + 1) * kstep;
            const char* a2 = last ? nA : cA + (size_t)(t + 2) * kstep; const char* b2 = last ? nB : cB + (size_t)(t + 2) * kstep;
            const char* a3 = a2 + kstep; const char* b3 = b2 + kstep;
            unsigned w0[2], w1[2];
#pragma unroll
            for (int _i = 0; _i < 2; ++_i) { w0[_i] = last ? vAn[0][_i] : vA[0][_i]; w1[_i] = last ? vAn[1][_i] : vA[1][_i]; }
            PG8_LDB(B0, 0, 0); PG8_LDB(B1, 0, 1); PG8_SCHED; PG8_LDA(At, 0, 0); PG8_STAGE(PG8_SA(1, 1), a1, vA[1]);
            PG8_WAIT_V(8); PG8_WAIT_L(0); PG8_BAR; PG8_MMA(0, 0, At, B0); PG8_MMA(0, 1, At, B1); PG8_BAR; PG8_SCHED;
            PG8_LDA(At, 0, 1); PG8_STAGE(PG8_SB(0, 0), b2, voffB); PG8_STAGE(PG8_SB(0, 1), b2 + hstep, voffB); PG8_STAGE(PG8_SA(0, 0), a2, w0);
            PG8_WAIT_V(8); PG8_WAIT_L(0); PG8_BAR; PG8_MMA(1, 0, At, B0); PG8_MMA(1, 1, At, B1); PG8_BAR; PG8_SCHED;
            PG8_LDB(B0, 1, 0); PG8_LDB(B1, 1, 1); PG8_SCHED; PG8_LDA(At, 1, 0); PG8_STAGE(PG8_SA(0, 1), a2, w1);
            PG8_WAIT_V(8); PG8_WAIT_L(0); PG8_BAR; PG8_MMA(0, 0, At, B0); PG8_MMA(0, 1, At, B1); PG8_BAR; PG8_SCHED;
            PG8_LDA(At, 1, 1); PG8_STAGE(PG8_SB(1, 0), b3, voffB); PG8_STAGE(PG8_SB(1, 1), b3 + hstep, voffB); PG8_STAGE(PG8_SA(1, 0), a3, w0);
            PG8_WAIT_V(8); PG8_WAIT_L(0); PG8_BAR; PG8_MMA(1, 0, At, B0); PG8_MMA(1, 1, At, B1); PG8_BAR; PG8_SCHED;
        }
        if constexpr (ALIGN_EPI) { if (wr == 0) PG8_BAR; }
        E(acc, cur, wr, wc, fr, fq);
        if (!has_next) break;
#pragma unroll
        for (int a = 0; a < 2; ++a)
#pragma unroll
            for (int b = 0; b < 2; ++b)
#pragma unroll
                for (int m = 0; m < 4; ++m)
#pragma unroll
                    for (int n = 0; n < 2; ++n) acc[a][b][m][n] = (f32x4){0.f, 0.f, 0.f, 0.f};
        cur = nxt; cA = nA; cB = nB; ++ui;
#pragma unroll
        for (int _h = 0; _h < 2; ++_h)
#pragma unroll
            for (int _i = 0; _i < 2; ++_i) vA[_h][_i] = vAn[_h][_i];
        if constexpr (ALIGN_EPI) { if (wr == 1) PG8_BAR; }
    }
    PG8_WAIT_V(0);
    if constexpr (!ALIGN_EPI) { if (wr == 0) PG8_BAR; }
    PG8_BAR;
#undef PG8_SA
#undef PG8_SB
#undef PG8_STAGE
#undef PG8_LDA
#undef PG8_LDB
#undef PG8_MMA
#undef PG8_WAIT_V
#undef PG8_WAIT_L
#undef PG8_BAR
#undef PG8_SCHED
#undef PG8_CALC_VA
}

struct EpiProj {
    static constexpr bool PERM = true;
    bf16_t* O;
    __device__ __forceinline__ void operator()(const f32x4 (&acc)[2][2][4][2], const Unit& u, int wr, int wc, int fr, int fq) const {
        const int row0 = u.pm * BM + wr * 64 + fr; const int col0 = u.pn * BM + wc * 32 + 8 * fq;
        const float sc = u.pn < 2 ? SBQ_SCALE : (u.pn == 6 ? GQ_SCALE : 1.0f);
#pragma unroll
        for (int ai = 0; ai < 2; ++ai)
#pragma unroll
            for (int m = 0; m < 4; ++m) { bf16_t* rowp = O + (size_t)(row0 + ai * HALF + m * 16) * NPROJ + col0;
#pragma unroll
                for (int bj = 0; bj < 2; ++bj) { const f32x4 v0 = acc[ai][bj][m][0] * sc, v1 = acc[ai][bj][m][1] * sc;
                    u32x4 w; w.x = cvt_pk_bf16(v0[0], v0[1]); w.y = cvt_pk_bf16(v0[2], v0[3]); w.z = cvt_pk_bf16(v1[0], v1[1]); w.w = cvt_pk_bf16(v1[2], v1[3]);
                    *(u32x4*)(rowp + bj * HALF) = w; } }
    }
};
struct EpiResid {
    static constexpr bool PERM = false;
    const float* X; float* C;
    __device__ __forceinline__ void operator()(const f32x4 (&acc)[2][2][4][2], const Unit& u, int wr, int wc, int fr, int fq) const {
        const int row0 = u.pm * BM + wr * 64 + fr, col0 = u.pn * BM + wc * 32 + 4 * fq;
#pragma unroll
        for (int ai = 0; ai < 2; ++ai)
#pragma unroll
            for (int m = 0; m < 4; ++m) { const size_t off = (size_t)(row0 + ai * HALF + m * 16) * D + col0;
#pragma unroll
                for (int bj = 0; bj < 2; ++bj)
#pragma unroll
                    for (int n = 0; n < 2; ++n) *(f32x4*)(C + off + bj * HALF + n * 16) = *(const f32x4*)(X + off + bj * HALF + n * 16) + acc[ai][bj][m][n]; }
    }
};
struct EpiGateUp {
    static constexpr bool PERM = true;
    bf16_t* H;
    __device__ __forceinline__ void operator()(const f32x4 (&acc)[2][2][4][2], const Unit& u, int wr, int wc, int fr, int fq) const {
        const int row0 = u.pm * BM + wr * 64 + fr; const int col0 = (u.pn & 3) * HALF + wc * 32 + 8 * fq;
#pragma unroll
        for (int ai = 0; ai < 2; ++ai)
#pragma unroll
            for (int m = 0; m < 4; ++m) { float hv[8];
#pragma unroll
                for (int n = 0; n < 2; ++n)
#pragma unroll
                    for (int j = 0; j < 4; ++j) { const float gv = acc[ai][0][m][n][j], uv = acc[ai][1][m][n][j]; hv[4 * n + j] = gv * __builtin_amdgcn_rcpf(1.0f + __expf(-gv)) * uv; }
                u32x4 w; w.x = cvt_pk_bf16(hv[0], hv[1]); w.y = cvt_pk_bf16(hv[2], hv[3]); w.z = cvt_pk_bf16(hv[4], hv[5]); w.w = cvt_pk_bf16(hv[6], hv[7]);
                *(u32x4*)(H + (size_t)(row0 + ai * HALF + m * 16) * DFF + col0) = w; }
    }
};
struct EpiY {
    static constexpr bool PERM = true;
    bf16_t* Y;
    __device__ __forceinline__ void operator()(const f32x4 (&acc)[2][2][4][2], const Unit& u, int wr, int wc, int fr, int fq) const {
        const int row0 = u.pm * BM + wr * 64 + fr; const int col0 = (u.pn & 3) * BM + wc * 32 + 8 * fq;
#pragma unroll
        for (int ai = 0; ai < 2; ++ai)
#pragma unroll
            for (int m = 0; m < 4; ++m) { bf16_t* rowp = Y + (size_t)(row0 + ai * HALF + m * 16) * D + col0;
#pragma unroll
                for (int bj = 0; bj < 2; ++bj) { const f32x4 v0 = acc[ai][bj][m][0], v1 = acc[ai][bj][m][1];
                    u32x4 w; w.x = cvt_pk_bf16(v0[0], v0[1]); w.y = cvt_pk_bf16(v0[2], v0[3]); w.z = cvt_pk_bf16(v1[0], v1[1]); w.w = cvt_pk_bf16(v1[2], v1[3]);
                    *(u32x4*)(rowp + bj * HALF) = w; } }
    }
};
struct MoeOrder {
    int G, c, MT, nwg; const PG8_LAS int* tab;
    const int* toklist;
    __device__ __forceinline__ bool next(int i, Unit& u) const {
        const long L = (long)i * G + c; if (L >= nwg) return false;
        int wgid = (int)L; { const int q = nwg / NXCD, r = nwg % NXCD, xcd = wgid % NXCD, off = wgid / NXCD; wgid = (xcd < r ? xcd * (q + 1) : r * (q + 1) + (xcd - r) * q) + off; }
        const int st = wgid >> 2, ntl = wgid & 3;
        const int ln = threadIdx.x & 31;
        const int e = __popcll(__ballot(tab[64 + ln] <= st)) >> 1;
        u.pm = st; u.pn = e * 4 + ntl; u.e = e; u.r0 = __builtin_amdgcn_readfirstlane(tab[32 + e]); u.ne = __builtin_amdgcn_readfirstlane(tab[e]); return true;
    }
    __device__ __forceinline__ int src_row(const Unit& u, int R) const { const int idx = u.pm * BM + R - u.r0; return idx < u.ne ? toklist[u.e * CAP + idx] : 0; }
};
}

struct Frame {
    LAS unsigned char* lds;
    volatile LAS unsigned* MISC;
    gu32* ctl;
    int tid, lane, wave;
    int vcu, G;
    int gw, NGW;
    const float *x, *ln1_g, *w_in, *gate_w2, *gate_b, *gnorm_g, *w_out, *ln2_g, *w_group, *b_group, *w_expert, *b_expert, *ew_gate, *ew_up, *ew_down, *lnf_g;
    float* out;
    unsigned char* ws;
    bf16 *WinT, *WoutT, *WguT, *WdT, *XN, *OMIX, *H2, *HBUF, *PROJ, *Y;
    float *GLR, *LOGA, *OG, *X1, *DS, *DEC; bf16* ST;
    int* toklist; float* gatelist; int* tokinfo; unsigned* cnt;
};

__device__ __forceinline__ void p0_transpose_item(const float* W, int ldw, int K, int k0, int n0, bf16* WT, size_t dst_row0, LAS float* scr, int lane) {
#pragma unroll 8
    for (int i = 0; i < 32; ++i) { const int kk = 2 * i + (lane >> 5); scr[kk * 33 + (lane & 31)] = W[(size_t)(k0 + kk) * ldw + n0 + (lane & 31)]; }
    LDS_WAIT(); asm volatile("" ::: "memory");
    const int c = lane & 7;
#pragma unroll
    for (int j = 0; j < 4; ++j) { const int n = (lane >> 3) + 8 * j; const LAS float* s = scr + (8 * c) * 33 + n;
        v4u o; o.x = pk2(s[0 * 33], s[1 * 33]); o.y = pk2(s[2 * 33], s[3 * 33]); o.z = pk2(s[4 * 33], s[5 * 33]); o.w = pk2(s[6 * 33], s[7 * 33]);
        *(GAS v4u*)(WT + (dst_row0 + n) * K + k0 + 8 * c) = o; }
    LDS_WAIT(); asm volatile("" ::: "memory");
}
__device__ __forceinline__ void rms_row_to_bf16(int lane, const float* xrow, const float* g, bf16* orow) {
    const GAS f32x4* xr = (const GAS f32x4*)xrow + lane; const GAS f32x4* gr = (const GAS f32x4*)g + lane;
    f32x4 v[4]; float s = 0.f;
#pragma unroll
    for (int j = 0; j < 4; ++j) { v[j] = xr[64 * j]; s += (v[j].x * v[j].x + v[j].y * v[j].y) + (v[j].z * v[j].z + v[j].w * v[j].w); }
    const float inv = 1.0f / sqrtf(wave_sum(s) * (1.f / D) + RMS_EPS);
    GAS unsigned long long* o8 = (GAS unsigned long long*)orow + lane;
#pragma unroll
    for (int j = 0; j < 4; ++j) { const f32x4 gg = gr[64 * j];
        o8[64 * j] = (unsigned long long)pk2(v[j].x * inv * gg.x, v[j].y * inv * gg.y) | ((unsigned long long)pk2(v[j].z * inv * gg.z, v[j].w * inv * gg.w) << 32); }
}
__device__ __forceinline__ void p0_prologue(Frame& F) {
    LAS float* scr = (LAS float*)(F.lds + RING_OFF + F.wave * 16384);
    constexpr int I_IN = (D / 64) * (NPROJ / 32);
    constexpr int I_OUT = (D / 64) * (D / 32);
    constexpr int I_G1 = (D / 64) * (DFF / 32);
    constexpr int I_D1 = (DFF / 64) * (D / 32);
    constexpr int NITEMS = I_IN + I_OUT + NE * (2 * I_G1 + I_D1);
    for (int it = F.gw; it < NITEMS; it += F.NGW) {
        int r = it;
        if (r < I_IN) { const int kb = r / (NPROJ / 32), nb = r % (NPROJ / 32); p0_transpose_item(F.w_in, DIN, D, 64 * kb, 32 * nb, F.WinT, (size_t)32 * nb, scr, F.lane); continue; } r -= I_IN;
        if (r < I_OUT) { const int kb = r / (D / 32), nb = r % (D / 32); p0_transpose_item(F.w_out, D, D, 64 * kb, 32 * nb, F.WoutT, (size_t)32 * nb, scr, F.lane); continue; } r -= I_OUT;
        const int e = r / (2 * I_G1 + I_D1); r -= e * (2 * I_G1 + I_D1);
        if (r < 2 * I_G1) { const int up = r / I_G1; r -= up * I_G1; const int kb = r / (DFF / 32), nb = r % (DFF / 32); const int n0 = 32 * nb;
            const float* W = (up ? F.ew_up : F.ew_gate) + (size_t)e * D * DFF;
            const size_t drow = (size_t)e * 1024 + (size_t)(n0 / 128) * 256 + (n0 % 128) + (up ? 128 : 0);
            p0_transpose_item(W, DFF, D, 64 * kb, n0, F.WguT, drow, scr, F.lane); continue; }
        r -= 2 * I_G1;
        { const int kb = r / (D / 32), nb = r % (D / 32);
          p0_transpose_item(F.ew_down + (size_t)e * DFF * D, D, DFF, 64 * kb, 32 * nb, F.WdT, (size_t)e * 1024 + 32 * nb, scr, F.lane); }
    }
    { const int gt = F.gw * 64 + F.lane, NGT = F.NGW * 64;
      for (int i = gt; i < GRANK * D; i += NGT) { const int j = i / D, k = i % D; F.WinT[(size_t)(NPROJ + j) * D + k] = (bf16)f2bf(F.w_in[(size_t)k * DIN + NPROJ + j]); } }
    for (int m = F.gw; m < T; m += F.NGW) rms_row_to_bf16(F.lane, F.x + (size_t)m * D, F.ln1_g, F.XN + (size_t)m * D);
}

__device__ __forceinline__ f32x16 tile32(const bf16* pa, const bf16* pb, int K, int h) {
    f32x16 acc;
#pragma unroll
    for (int i = 0; i < 16; ++i) acc[i] = 0.f;
    const bf16x8* a8 = (const bf16x8*)(pa + 8 * h); const bf16x8* b8 = (const bf16x8*)(pb + 8 * h);
#pragma unroll 4
    for (int k = 0; k < K / 16; ++k) acc = __builtin_amdgcn_mfma_f32_32x32x16_bf16(a8[2 * k], b8[2 * k], acc, 0, 0, 0);
    return acc;
}

__device__ __forceinline__ void p1_proj_base(Frame& F) {
    const int r = F.lane & 31, h = F.lane >> 5;
    constexpr int NT = NPROJ / 32, MT = T / 32;
    for (int it = F.gw; it < MT * NT; it += F.NGW) {
        const int mt = it / NT, nt = it % NT;
        const f32x16 acc = tile32(F.XN + (size_t)(mt * 32 + r) * D, F.WinT + (size_t)(nt * 32 + r) * D, D, h);
        const int col = nt * 32 + r;
        const float sc = col < COL_SBK ? SBQ_SCALE : ((col >= COL_GQ && col < COL_GK) ? GQ_SCALE : 1.0f);
#pragma unroll
        for (int i = 0; i < 16; ++i) F.PROJ[(size_t)(mt * 32 + crow(i, h)) * NPROJ + col] = (bf16)f2bf(acc[i] * sc);
    }
}
__device__ __forceinline__ void p1_glr(Frame& F) {
    const int gt = F.gw * 64 + F.lane, NGT = F.NGW * 64;
    for (int i = gt; i < T * GRANK; i += NGT) { const int t = i / GRANK, j = i % GRANK;
        const v4u* a = (const v4u*)(F.XN + (size_t)t * D); const v4u* b = (const v4u*)(F.WinT + (size_t)(NPROJ + j) * D);
        float s = 0.f;
        for (int k = 0; k < D / 8; ++k) { const v4u av = a[k], bv = b[k];
            s += bflo(av.x) * bflo(bv.x) + bfhi(av.x) * bfhi(bv.x) + bflo(av.y) * bflo(bv.y) + bfhi(av.y) * bfhi(bv.y)
               + bflo(av.z) * bflo(bv.z) + bfhi(av.z) * bfhi(bv.z) + bflo(av.w) * bflo(bv.w) + bfhi(av.w) * bfhi(bv.w); }
        F.GLR[i] = s; }
}

__device__ __forceinline__ void p2_loga(Frame& F) {
    const int gt = F.gw * 64 + F.lane, NGT = F.NGW * 64;
    for (int i = gt; i < T * 256; i += NGT) { const int t = i >> 8, c = i & 255;
        float s = F.gate_b[c];
#pragma unroll
        for (int j = 0; j < GRANK; ++j) s += F.GLR[t * GRANK + j] * F.gate_w2[j * 256 + c];
        const float ls = fminf(s, 0.f) - log1pf(expf(-fabsf(s)));
        F.LOGA[i] = ls * (1.0f / 16.0f); }
}
__device__ __forceinline__ void p2_sb_base(Frame& F) {
    for (int it = F.gw; it < BATCH * SBH * (SEQ / 64); it += F.NGW) {
        const int qb = it % (SEQ / 64), h = (it / (SEQ / 64)) % SBH, b = it / ((SEQ / 64) * SBH);
        const int t = qb * 64 + F.lane; const size_t row = (size_t)b * SEQ + t;
        float q[64], o[64];
        { const v4u* qp = (const v4u*)(F.PROJ + row * NPROJ + COL_SBQ + h * 64);
#pragma unroll
          for (int j = 0; j < 8; ++j) { const v4u w = qp[j]; q[8 * j] = bflo(w.x); q[8 * j + 1] = bfhi(w.x); q[8 * j + 2] = bflo(w.y); q[8 * j + 3] = bfhi(w.y);
              q[8 * j + 4] = bflo(w.z); q[8 * j + 5] = bfhi(w.z); q[8 * j + 6] = bflo(w.w); q[8 * j + 7] = bfhi(w.w); } }
#pragma unroll
        for (int d = 0; d < 64; ++d) o[d] = 0.f;
        float R = 0.f;
        int zero = 0; asm volatile("" : "+v"(zero));
        for (int s = qb * 64 + 62; s >= 0; --s) {
            const bf16* kv = F.PROJ + ((size_t)b * SEQ + s) * NPROJ + h * 64 + zero;
            const v4u* kp = (const v4u*)(kv + COL_SBK); const v4u* vp = (const v4u*)(kv + COL_SBV);
            float z = 0.f;
#pragma unroll
            for (int j = 0; j < 8; ++j) { const v4u w = kp[j];
                z += q[8 * j] * bflo(w.x) + q[8 * j + 1] * bfhi(w.x) + q[8 * j + 2] * bflo(w.y) + q[8 * j + 3] * bfhi(w.y)
                   + q[8 * j + 4] * bflo(w.z) + q[8 * j + 5] * bfhi(w.z) + q[8 * j + 6] * bflo(w.w) + q[8 * j + 7] * bfhi(w.w); }
            const float lb = fminf(z, 0.f) - __log2f(1.0f + exp2f(-fabsf(z)));
            const float wgt = (s < t) ? exp2f(lb + R) : 0.f;
            if (s < t) R += lb - z;
#pragma unroll
            for (int j = 0; j < 8; ++j) { const v4u w = vp[j];
                o[8 * j] += wgt * bflo(w.x); o[8 * j + 1] += wgt * bfhi(w.x); o[8 * j + 2] += wgt * bflo(w.y); o[8 * j + 3] += wgt * bfhi(w.y);
                o[8 * j + 4] += wgt * bflo(w.z); o[8 * j + 5] += wgt * bfhi(w.z); o[8 * j + 6] += wgt * bflo(w.w); o[8 * j + 7] += wgt * bfhi(w.w); }
        }
        v4u* op = (v4u*)(F.OMIX + row * D + h * 64);
#pragma unroll
        for (int j = 0; j < 8; ++j) { v4u w; w.x = pk2(o[8 * j], o[8 * j + 1]); w.y = pk2(o[8 * j + 2], o[8 * j + 3]); w.z = pk2(o[8 * j + 4], o[8 * j + 5]); w.w = pk2(o[8 * j + 6], o[8 * j + 7]); op[j] = w; }
    }
}

typedef short s16x4 __attribute__((ext_vector_type(4)));
typedef short v4i16_t __attribute__((ext_vector_type(4)));
typedef float f32x2_t __attribute__((ext_vector_type(2))); typedef __bf16 bf16x2_t __attribute__((ext_vector_type(2)));
__device__ __forceinline__ unsigned cvtpk_s(float lo, float hi) { f32x2_t v = {lo, hi}; bf16x2_t b = __builtin_convertvector(v, bf16x2_t); return __builtin_bit_cast(unsigned, b); }
__device__ __forceinline__ s16x4 vtr(const LAS char* p) { return __builtin_bit_cast(s16x4, __builtin_amdgcn_ds_read_tr16_b64_v4i16((LAS v4i16_t*)p)); }
__device__ __forceinline__ bf16x8 pack8(const float* x) { v4u p; p.x = cvtpk_s(x[0], x[1]); p.y = cvtpk_s(x[2], x[3]); p.z = cvtpk_s(x[4], x[5]); p.w = cvtpk_s(x[6], x[7]); return __builtin_bit_cast(bf16x8, p); }
constexpr float SB_STOP = -152.0f;
__device__ __forceinline__ void p2_sb_fast(Frame& F) {
    const int lane = F.lane, r = lane & 31, hh = lane >> 5;
    LAS char* vl = (LAS char*)(F.lds + RING_OFF + F.wave * 16384);
    const LAS char* vbase = vl + (4 * hh + ((lane & 15) >> 2)) * 64 + ((lane >> 4) & 1) * 32 + (lane & 3) * 8;
    bf16x8 U0, U1;
#pragma unroll
    for (int j = 0; j < 8; ++j) { const int k0 = 8 * (j >> 2) + 4 * hh + (j & 3); U0[j] = (k0 > r) ? (short)0x3F80 : (short)0; U1[j] = (16 + k0 > r) ? (short)0x3F80 : (short)0; }
    constexpr int NQB = SEQ / 32;
    for (int unit = F.gw; unit < BATCH * SBH * NQB; unit += F.NGW) {
        const int qb = unit % NQB, head = (unit / NQB) % SBH, b = unit / (NQB * SBH);
        const size_t rowbase = (size_t)b * SEQ; const int t0 = qb * 32;
        bf16x8 qf[4];
        { const bf16* Qp = F.PROJ + (rowbase + t0 + r) * NPROJ + COL_SBQ + head * 64 + 8 * hh;
#pragma unroll
          for (int ks = 0; ks < 4; ++ks) qf[ks] = *(const bf16x8*)(Qp + 16 * ks); }
        f32x16 O0, O1;
#pragma unroll
        for (int i = 0; i < 16; ++i) { O0[i] = 0.f; O1[i] = 0.f; }
        float R = 0.f;
        for (int kt = qb; kt >= 0; --kt) {
            const int s0 = kt * 32; const bool diag = (kt == qb);
            bf16x8 kf[4];
            { const bf16* Kp = F.PROJ + (rowbase + s0 + r) * NPROJ + COL_SBK + head * 64 + 8 * hh;
#pragma unroll
              for (int ks = 0; ks < 4; ++ks) kf[ks] = *(const bf16x8*)(Kp + 16 * ks); }
#pragma unroll
            for (int i = 0; i < 4; ++i) { const int c = i * 64 + lane, key = c >> 3, dch = c & 7;
                const v4u val = *(const v4u*)(F.PROJ + (rowbase + s0 + key) * NPROJ + COL_SBV + head * 64 + 8 * dch);
                *(LAS v4u*)(vl + ((key >> 3) * 2 + (dch >> 2)) * 512 + (key & 7) * 64 + (dch & 3) * 16) = val; }
            f32x16 S;
#pragma unroll
            for (int i = 0; i < 16; ++i) S[i] = 0.f;
#pragma unroll
            for (int ks = 0; ks < 4; ++ks) S = __builtin_amdgcn_mfma_f32_32x32x16_bf16(kf[ks], qf[ks], S, 0, 0, 0);
            float lom[16]; f32x16 C; float rs = 0.f;
#pragma unroll
            for (int i = 0; i < 16; ++i) { const float z = S[i];
                const float l = __builtin_amdgcn_logf(1.0f + __builtin_amdgcn_exp2f(-fabsf(z)));
                const float lbv = fminf(z, 0.f) - l; float lm = lbv - z;
                if (diag && !(crow(i, hh) < r)) lm = 0.f;
                lom[i] = lm; rs += lm; C[i] = lbv + R; }
            rs += __shfl_xor(rs, 32);
            const bf16x8 pb0 = pack8(lom), pb1 = pack8(lom + 8);
            C = __builtin_amdgcn_mfma_f32_32x32x16_bf16(U0, pb0, C, 0, 0, 0);
            C = __builtin_amdgcn_mfma_f32_32x32x16_bf16(U1, pb1, C, 0, 0, 0);
            float w[16];
#pragma unroll
            for (int i = 0; i < 16; ++i) { float wv = __builtin_amdgcn_exp2f(C[i]); if (diag && !(crow(i, hh) < r)) wv = 0.f; w[i] = wv; }
            const bf16x8 pa0 = pack8(w), pa1 = pack8(w + 8);
#pragma unroll
            for (int nb = 0; nb < 2; ++nb) {
                const s16x4 l0 = vtr(vbase + (0 * 2 + nb) * 512), h0 = vtr(vbase + (1 * 2 + nb) * 512), l1 = vtr(vbase + (2 * 2 + nb) * 512), h1 = vtr(vbase + (3 * 2 + nb) * 512);
                const bf16x8 v0 = (bf16x8){l0[0], l0[1], l0[2], l0[3], h0[0], h0[1], h0[2], h0[3]}, v1 = (bf16x8){l1[0], l1[1], l1[2], l1[3], h1[0], h1[1], h1[2], h1[3]};
                if (nb == 0) { O0 = __builtin_amdgcn_mfma_f32_32x32x16_bf16(pa0, v0, O0, 0, 0, 0); O0 = __builtin_amdgcn_mfma_f32_32x32x16_bf16(pa1, v1, O0, 0, 0, 0); }
                else { O1 = __builtin_amdgcn_mfma_f32_32x32x16_bf16(pa0, v0, O1, 0, 0, 0); O1 = __builtin_amdgcn_mfma_f32_32x32x16_bf16(pa1, v1, O1, 0, 0, 0); }
            }
            R += rs;
            if (__all(R < SB_STOP)) break;
        }
        bf16* Op = F.OMIX + (rowbase + t0) * D + head * 64 + r;
#pragma unroll
        for (int i = 0; i < 16; ++i) { const int tr = crow(i, hh); Op[(size_t)tr * D] = (bf16)f2bf(O0[i]); Op[(size_t)tr * D + 32] = (bf16)f2bf(O1[i]); }
    }
}


__device__ __forceinline__ void p1_loga(Frame& F) {
    for (int t = F.gw; t < T; t += F.NGW) {
        const v4u* xp = (const v4u*)(F.XN + (size_t)t * D + 16 * F.lane); const v4u x0 = xp[0], x1 = xp[1];
        const float xv[16] = {bflo(x0.x), bfhi(x0.x), bflo(x0.y), bfhi(x0.y), bflo(x0.z), bfhi(x0.z), bflo(x0.w), bfhi(x0.w), bflo(x1.x), bfhi(x1.x), bflo(x1.y), bfhi(x1.y), bflo(x1.z), bfhi(x1.z), bflo(x1.w), bfhi(x1.w)};
        float gl[GRANK];
#pragma unroll
        for (int j = 0; j < GRANK; ++j) { const v4u* wp = (const v4u*)(F.WinT + (size_t)(NPROJ + j) * D + 16 * F.lane); const v4u w0 = wp[0], w1 = wp[1];
            float s = xv[0] * bflo(w0.x) + xv[1] * bfhi(w0.x) + xv[2] * bflo(w0.y) + xv[3] * bfhi(w0.y) + xv[4] * bflo(w0.z) + xv[5] * bfhi(w0.z) + xv[6] * bflo(w0.w) + xv[7] * bfhi(w0.w)
                    + xv[8] * bflo(w1.x) + xv[9] * bfhi(w1.x) + xv[10] * bflo(w1.y) + xv[11] * bfhi(w1.y) + xv[12] * bflo(w1.z) + xv[13] * bfhi(w1.z) + xv[14] * bflo(w1.w) + xv[15] * bfhi(w1.w);
            gl[j] = wave_sum(s); }
        const int c0 = 4 * F.lane;
        f32x4 acc = *(const f32x4*)(F.gate_b + c0);
#pragma unroll
        for (int j = 0; j < GRANK; ++j) { const f32x4 w = *(const f32x4*)(F.gate_w2 + j * 256 + c0); acc.x += gl[j] * w.x; acc.y += gl[j] * w.y; acc.z += gl[j] * w.z; acc.w += gl[j] * w.w; }
        f32x4 o;
#pragma unroll
        for (int q = 0; q < 4; ++q) { const float sv = acc[q]; o[q] = (fminf(sv, 0.f) - log1pf(__expf(-fabsf(sv)))) * (1.0f / 16.0f); }
        *(f32x4*)(F.LOGA + (size_t)t * 256 + c0) = o;
    }
}
__device__ __forceinline__ bf16x8 tr_frag(const LAS char* img, int ncb, int ra, int rb, int cb, int lane) {
    const int q = (lane & 15) >> 2, p = lane & 3, g16 = (lane >> 4) & 1;
    const s16x4 lo = vtr(img + ((ra >> 3) * ncb + cb) * 512 + ((ra & 7) + q) * 64 + g16 * 32 + p * 8);
    const s16x4 hi = vtr(img + ((rb >> 3) * ncb + cb) * 512 + ((rb & 7) + q) * 64 + g16 * 32 + p * 8);
    return (bf16x8){lo[0], lo[1], lo[2], lo[3], hi[0], hi[1], hi[2], hi[3]};
}
__device__ __forceinline__ void gla_pass_a(Frame& F) {
    const int lane = F.lane, r = lane & 31, hh = lane >> 5;
    LAS char* KD = (LAS char*)(F.lds + RING_OFF + F.wave * 16384); LAS char* VV = KD + 8192;
    for (int unit = F.gw; unit < BATCH * GH * 64 * 2; unit += F.NGW) {
        const int vhalf = unit & 1, c = (unit >> 1) & 63, bh = unit >> 7, b = bh >> 2, h = bh & 3;
        const size_t row0 = (size_t)b * SEQ + c * 64;
        float g[64]; float total = 0.f;
#pragma unroll
        for (int t = 0; t < 64; ++t) { g[t] = F.LOGA[(row0 + t) * 256 + h * 64 + lane]; total += g[t]; }
        if (vhalf == 0) F.DEC[(bh * 64 + c) * 64 + lane] = __expf(total);
        float run = 0.f;
#pragma unroll
        for (int t = 0; t < 64; ++t) { run += g[t];
            const float kd = bf2f(F.PROJ[(row0 + t) * NPROJ + COL_GK + h * 64 + lane]) * __expf(total - run);
            *(LAS bf16*)(KD + ((t >> 3) * 2 + (lane >> 5)) * 512 + (t & 7) * 64 + (lane & 31) * 2) = (bf16)f2bf(kd); }
#pragma unroll
        for (int i = 0; i < 8; ++i) { const int ch = i * 64 + lane, t = ch >> 3, cc = ch & 7;
            const v4u val = *(const v4u*)(F.PROJ + (row0 + t) * NPROJ + COL_GV + h * 128 + vhalf * 64 + cc * 8);
            *(LAS v4u*)(VV + ((t >> 3) * 2 + (cc >> 2)) * 512 + (t & 7) * 64 + (cc & 3) * 16) = val; }
        asm volatile("" ::: "memory");
        f32x16 acc[2][2];
#pragma unroll
        for (int a = 0; a < 2; ++a)
#pragma unroll
            for (int bb = 0; bb < 2; ++bb)
#pragma unroll
                for (int i = 0; i < 16; ++i) acc[a][bb][i] = 0.f;
#pragma unroll
        for (int ks = 0; ks < 4; ++ks) { const int ra = 16 * ks + 8 * hh, rb = ra + 4;
            const bf16x8 a0 = tr_frag(VV, 2, ra, rb, 0, lane), a1 = tr_frag(VV, 2, ra, rb, 1, lane);
            const bf16x8 b0 = tr_frag(KD, 2, ra, rb, 0, lane), b1 = tr_frag(KD, 2, ra, rb, 1, lane);
            acc[0][0] = __builtin_amdgcn_mfma_f32_32x32x16_bf16(a0, b0, acc[0][0], 0, 0, 0); acc[0][1] = __builtin_amdgcn_mfma_f32_32x32x16_bf16(a0, b1, acc[0][1], 0, 0, 0);
            acc[1][0] = __builtin_amdgcn_mfma_f32_32x32x16_bf16(a1, b0, acc[1][0], 0, 0, 0); acc[1][1] = __builtin_amdgcn_mfma_f32_32x32x16_bf16(a1, b1, acc[1][1], 0, 0, 0); }
        float* dsp = F.DS + ((size_t)(bh * 64 + c) * 128 + 64 * vhalf) * 64 + r;
#pragma unroll
        for (int vb = 0; vb < 2; ++vb)
#pragma unroll
            for (int kb = 0; kb < 2; ++kb)
#pragma unroll
                for (int i = 0; i < 16; ++i) dsp[(size_t)(32 * vb + crow(i, hh)) * 64 + 32 * kb] = acc[vb][kb][i];
        asm volatile("" ::: "memory");
    }
}
__device__ __forceinline__ void gla_pass_b(Frame& F) {
    const int gt = F.gw * 64 + F.lane, NGT = F.NGW * 64;
    for (int e = gt; e < BATCH * GH * 8192; e += NGT) {
        const int bh = e >> 13, rem = e & 8191, k = rem & 63;
        float S = 0.f;
#pragma unroll 8
        for (int c = 0; c < 64; ++c) { const size_t o = ((size_t)(bh * 64 + c) << 13) + rem;
            F.ST[o] = (bf16)f2bf(S); S = F.DEC[(bh * 64 + c) * 64 + k] * S + F.DS[o]; }
    }
}
__device__ __forceinline__ void gla_pass_c(Frame& F) {
    const int lane = F.lane, r = lane & 31, hh = lane >> 5;
    LAS char* KT = (LAS char*)(F.lds + RING_OFF + F.wave * 16384); LAS char* QT = KT + 8192; LAS char* VV = KT + 12288;
    for (int unit = F.gw; unit < BATCH * GH * 64 * 2; unit += F.NGW) {
        const int thalf = unit & 1, c = (unit >> 1) & 63, bh = unit >> 7, b = bh >> 2, h = bh & 3;
        const size_t row0 = (size_t)b * SEQ + c * 64;
        float run = 0.f;
        for (int tb = 0; tb <= thalf; ++tb) {
#pragma unroll
            for (int tt = 0; tt < 32; ++tt) { const int t = 32 * tb + tt;
                run += F.LOGA[(row0 + t) * 256 + h * 64 + lane];
                const float kt = bf2f(F.PROJ[(row0 + t) * NPROJ + COL_GK + h * 64 + lane]) * __expf(-run);
                *(LAS bf16*)(KT + t * 128 + ((lane * 2) ^ ((t & 7) << 4))) = (bf16)f2bf(kt);
                if (tb == thalf) { const float qt = bf2f(F.PROJ[(row0 + t) * NPROJ + COL_GQ + h * 64 + lane]) * __expf(run);
                    *(LAS bf16*)(QT + tt * 128 + ((lane * 2) ^ ((tt & 7) << 4))) = (bf16)f2bf(qt); } }
        }
        asm volatile("" ::: "memory");
        bf16x8 qf[4];
#pragma unroll
        for (int ks = 0; ks < 4; ++ks) qf[ks] = *(const LAS bf16x8*)(QT + r * 128 + ((32 * ks + 16 * hh) ^ ((r & 7) << 4)));
        bf16x8 pa[2][2];
#pragma unroll
        for (int sb = 0; sb < 2; ++sb) {
            if (sb <= thalf) {
                f32x16 P;
#pragma unroll
                for (int i = 0; i < 16; ++i) P[i] = 0.f;
                const int srow = 32 * sb + r;
#pragma unroll
                for (int ks = 0; ks < 4; ++ks) { const bf16x8 kf = *(const LAS bf16x8*)(KT + srow * 128 + ((32 * ks + 16 * hh) ^ ((srow & 7) << 4)));
                    P = __builtin_amdgcn_mfma_f32_32x32x16_bf16(kf, qf[ks], P, 0, 0, 0); }
                float pm[16];
#pragma unroll
                for (int i = 0; i < 16; ++i) pm[i] = (32 * sb + crow(i, hh) <= 32 * thalf + r) ? P[i] : 0.f;
                pa[sb][0] = pack8(pm); pa[sb][1] = pack8(pm + 8);
            } else { pa[sb][0] = (bf16x8){0, 0, 0, 0, 0, 0, 0, 0}; pa[sb][1] = pa[sb][0]; }
        }
        f32x16 o[4];
#pragma unroll
        for (int vb = 0; vb < 4; ++vb) {
#pragma unroll
            for (int i = 0; i < 16; ++i) o[vb][i] = 0.f;
#pragma unroll
            for (int i = 0; i < 4; ++i) { const int ch = i * 64 + lane, sidx = ch >> 2, cc = ch & 3;
                const v4u val = *(const v4u*)(F.PROJ + (row0 + sidx) * NPROJ + COL_GV + h * 128 + 32 * vb + cc * 8);
                *(LAS v4u*)(VV + (sidx >> 3) * 512 + (sidx & 7) * 64 + cc * 16) = val; }
            asm volatile("" ::: "memory");
            const bf16* stp = F.ST + ((size_t)(bh * 64 + c) * 128 + 32 * vb + r) * 64 + 8 * hh;
#pragma unroll
            for (int ks = 0; ks < 4; ++ks) { const bf16x8 sf = *(const bf16x8*)(stp + 16 * ks); o[vb] = __builtin_amdgcn_mfma_f32_32x32x16_bf16(qf[ks], sf, o[vb], 0, 0, 0); }
#pragma unroll
            for (int sb = 0; sb < 2; ++sb) {
                if (sb <= thalf) {
#pragma unroll
                    for (int s2 = 0; s2 < 2; ++s2) { const int ra = 32 * sb + 16 * s2 + 4 * hh, rb = ra + 8;
                        const bf16x8 vf = tr_frag(VV, 1, ra, rb, 0, lane);
                        o[vb] = __builtin_amdgcn_mfma_f32_32x32x16_bf16(pa[sb][s2], vf, o[vb], 0, 0, 0); }
                }
            }
        }
#pragma unroll
        for (int i = 0; i < 16; ++i) {
            float ss = o[0][i] * o[0][i] + o[1][i] * o[1][i] + o[2][i] * o[2][i] + o[3][i] * o[3][i];
            ss += __shfl_xor(ss, 1); ss += __shfl_xor(ss, 2); ss += __shfl_xor(ss, 4); ss += __shfl_xor(ss, 8); ss += __shfl_xor(ss, 16);
            const float inv = 1.0f / sqrtf(ss * (1.0f / GDV) + RMS_EPS);
            const size_t trow = row0 + 32 * thalf + crow(i, hh);
#pragma unroll
            for (int vb = 0; vb < 4; ++vb) { const int col = h * 128 + 32 * vb + r;
                const float gr = bf2f(F.PROJ[trow * NPROJ + COL_GR + col]);
                const float val = o[vb][i] * inv * F.gnorm_g[col] * gr / (1.0f + __expf(-gr));
                F.OMIX[trow * D + 512 + col] = (bf16)f2bf(val); }
        }
        asm volatile("" ::: "memory");
    }
}

__device__ __forceinline__ void p3_gla_base(Frame& F) {
    if (F.gw >= BATCH * GH * 2) return;
    const int b = F.gw / (GH * 2), h = (F.gw / 2) % GH, vc = (F.gw & 1) * 64 + F.lane;
    float S[64];
#pragma unroll
    for (int k = 0; k < 64; ++k) S[k] = 0.f;
    int zero = 0; asm volatile("" : "+v"(zero));
    for (int t = 0; t < SEQ; ++t) {
        const size_t row = (size_t)b * SEQ + t;
        const bf16* pr = F.PROJ + row * NPROJ + zero;
        const float vv = bf2f(pr[COL_GV + h * 128 + vc]);
        const v4u* kp = (const v4u*)(pr + COL_GK + h * 64); const v4u* qp = (const v4u*)(pr + COL_GQ + h * 64);
        const f32x4* lp = (const f32x4*)(F.LOGA + row * 256 + h * 64 + zero);
        float o = 0.f;
#pragma unroll
        for (int j = 0; j < 8; ++j) { const v4u kw = kp[j], qw = qp[j]; const f32x4 l0 = lp[2 * j], l1 = lp[2 * j + 1];
            const float kk[8] = {bflo(kw.x), bfhi(kw.x), bflo(kw.y), bfhi(kw.y), bflo(kw.z), bfhi(kw.z), bflo(kw.w), bfhi(kw.w)};
            const float qq[8] = {bflo(qw.x), bfhi(qw.x), bflo(qw.y), bfhi(qw.y), bflo(qw.z), bfhi(qw.z), bflo(qw.w), bfhi(qw.w)};
            const float ll[8] = {l0.x, l0.y, l0.z, l0.w, l1.x, l1.y, l1.z, l1.w};
#pragma unroll
            for (int i = 0; i < 8; ++i) { const float a = __expf(ll[i]); S[8 * j + i] = a * S[8 * j + i] + kk[i] * vv; o += qq[i] * S[8 * j + i]; } }
        F.OG[row * 512 + h * 128 + vc] = o;
    }
}
__device__ __forceinline__ void p4_gla_out(Frame& F) {
    for (int t = F.gw; t < T; t += F.NGW) {
        const int c0 = F.lane * 8;
        const f32x4* op = (const f32x4*)(F.OG + (size_t)t * 512 + c0); const f32x4 a = op[0], b = op[1];
        float ss = (a.x * a.x + a.y * a.y) + (a.z * a.z + a.w * a.w) + (b.x * b.x + b.y * b.y) + (b.z * b.z + b.w * b.w);
        ss += __shfl_xor(ss, 1); ss += __shfl_xor(ss, 2); ss += __shfl_xor(ss, 4); ss += __shfl_xor(ss, 8);
        const float inv = 1.0f / sqrtf(ss * (1.0f / GDV) + RMS_EPS);
        const f32x4* gp = (const f32x4*)(F.gnorm_g + c0); const f32x4 g0 = gp[0], g1 = gp[1];
        const v4u grw = *(const v4u*)(F.PROJ + (size_t)t * NPROJ + COL_GR + c0);
        const float gr[8] = {bflo(grw.x), bfhi(grw.x), bflo(grw.y), bfhi(grw.y), bflo(grw.z), bfhi(grw.z), bflo(grw.w), bfhi(grw.w)};
        const float ov[8] = {a.x, a.y, a.z, a.w, b.x, b.y, b.z, b.w}; const float gg[8] = {g0.x, g0.y, g0.z, g0.w, g1.x, g1.y, g1.z, g1.w};
        float r[8];
#pragma unroll
        for (int i = 0; i < 8; ++i) { const float sl = gr[i] / (1.0f + __expf(-gr[i])); r[i] = ov[i] * inv * gg[i] * sl; }
        v4u w; w.x = pk2(r[0], r[1]); w.y = pk2(r[2], r[3]); w.z = pk2(r[4], r[5]); w.w = pk2(r[6], r[7]);
        *(v4u*)(F.OMIX + (size_t)t * D + 512 + c0) = w;
    }
}
__device__ __forceinline__ void p5_outproj_base(Frame& F) {
    const int r = F.lane & 31, h = F.lane >> 5;
    constexpr int NT = D / 32, MT = T / 32;
    for (int it = F.gw; it < MT * NT; it += F.NGW) {
        const int mt = it / NT, nt = it % NT;
        const f32x16 acc = tile32(F.OMIX + (size_t)(mt * 32 + r) * D, F.WoutT + (size_t)(nt * 32 + r) * D, D, h);
#pragma unroll
        for (int i = 0; i < 16; ++i) { const size_t idx = (size_t)(mt * 32 + crow(i, h)) * D + nt * 32 + r; F.X1[idx] = F.x[idx] + acc[i]; }
    }
}
__device__ __forceinline__ void p6_route(Frame& F) {
    for (int t = F.gw; t < T; t += F.NGW) {
        const GAS f32x4* xr = (const GAS f32x4*)(F.X1 + (size_t)t * D) + F.lane; const GAS f32x4* gr = (const GAS f32x4*)F.ln2_g + F.lane;
        f32x4 v[4]; float s = 0.f;
#pragma unroll
        for (int j = 0; j < 4; ++j) { v[j] = xr[64 * j]; s += (v[j].x * v[j].x + v[j].y * v[j].y) + (v[j].z * v[j].z + v[j].w * v[j].w); }
        const float inv = 1.0f / sqrtf(wave_sum(s) * (1.f / D) + RMS_EPS);
        GAS unsigned long long* o8 = (GAS unsigned long long*)(F.H2 + (size_t)t * D) + F.lane;
#pragma unroll
        for (int j = 0; j < 4; ++j) { const f32x4 gg = gr[64 * j]; v[j].x = v[j].x * inv * gg.x; v[j].y = v[j].y * inv * gg.y; v[j].z = v[j].z * inv * gg.z; v[j].w = v[j].w * inv * gg.w;
            o8[64 * j] = (unsigned long long)pk2(v[j].x, v[j].y) | ((unsigned long long)pk2(v[j].z, v[j].w) << 32); }
        float lg[NGRP], le[NE];
#pragma unroll
        for (int c = 0; c < NGRP; ++c) lg[c] = 0.f;
#pragma unroll
        for (int c = 0; c < NE; ++c) le[c] = 0.f;
#pragma unroll 1
        for (int jq = 0; jq < 16; ++jq) { const int j = jq >> 2, q = jq & 3;
            const f32x4 vj = j == 0 ? v[0] : (j == 1 ? v[1] : (j == 2 ? v[2] : v[3]));
            const float hv = q == 0 ? vj.x : (q == 1 ? vj.y : (q == 2 ? vj.z : vj.w));
            const int k = 4 * (64 * j + F.lane) + q;
            const f32x4 wg = *(const f32x4*)(F.w_group + (size_t)k * NGRP);
            lg[0] += hv * wg.x; lg[1] += hv * wg.y; lg[2] += hv * wg.z; lg[3] += hv * wg.w;
            const f32x4* we = (const f32x4*)(F.w_expert + (size_t)k * NE);
#pragma unroll
            for (int c4 = 0; c4 < NE / 4; ++c4) { const f32x4 w = we[c4]; le[4 * c4] += hv * w.x; le[4 * c4 + 1] += hv * w.y; le[4 * c4 + 2] += hv * w.z; le[4 * c4 + 3] += hv * w.w; } }
#pragma unroll
        for (int c = 0; c < NGRP; ++c) lg[c] = wave_sum(lg[c]) + F.b_group[c];
#pragma unroll
        for (int c = 0; c < NE; ++c) le[c] = wave_sum(le[c]) + F.b_expert[c];
        int gi = 0; float gm = lg[0];
#pragma unroll
        for (int c = 1; c < NGRP; ++c) if (lg[c] > gm) { gm = lg[c]; gi = c; }
        float gs = 0.f;
#pragma unroll
        for (int c = 0; c < NGRP; ++c) gs += __expf(lg[c] - gm);
        const float gp = 1.0f / gs;
        float sel[EPG];
#pragma unroll
        for (int i = 0; i < EPG; ++i) { sel[i] = le[i];
#pragma unroll
            for (int g = 1; g < NGRP; ++g) sel[i] = (gi == g) ? le[g * EPG + i] : sel[i]; }
        int i1 = 0; float m1 = sel[0];
#pragma unroll
        for (int i = 1; i < EPG; ++i) if (sel[i] > m1) { m1 = sel[i]; i1 = i; }
        int i2 = -1; float m2 = -3.0e38f;
#pragma unroll
        for (int i = 0; i < EPG; ++i) if (i != i1 && sel[i] > m2) { m2 = sel[i]; i2 = i; }
        const float e21 = __expf(m2 - m1); const float w1 = 1.0f / (1.0f + e21), w2 = e21 * w1;
        if (F.lane == 0) {
            const int e1 = gi * EPG + i1, e2 = gi * EPG + i2;
            const int r1 = (int)__hip_atomic_fetch_add(F.cnt + e1, 1u, RLX_AGENT), r2 = (int)__hip_atomic_fetch_add(F.cnt + e2, 1u, RLX_AGENT);
            F.toklist[e1 * CAP + r1] = t; F.toklist[e2 * CAP + r2] = t;
            *(int4*)(F.tokinfo + 8 * t) = make_int4(e1, r1, e2, r2);
            *(int4*)(F.tokinfo + 8 * t + 4) = make_int4(__float_as_int(gp * w1), __float_as_int(gp * w2), 0, 0);
        }
    }
}
__device__ __forceinline__ void load_emap(Frame& F, int& cnt_l, int& pst_l, int& cend32_l) {
    const int e = F.lane & 31;
    cnt_l = (int)__hip_atomic_load(F.cnt + e, RLX_AGENT);
    int p = (cnt_l + 255) & ~255, c = (cnt_l + 31) >> 5;
#pragma unroll
    for (int o = 1; o < 32; o <<= 1) { const int pp = __shfl_up(p, o), cc = __shfl_up(c, o); if (e >= o) { p += pp; c += cc; } }
    pst_l = p - ((cnt_l + 255) & ~255); cend32_l = c;
}
__device__ __forceinline__ void p7_gateup_base(Frame& F) {
    const int r = F.lane & 31, h = F.lane >> 5;
    int cnt_l, pst_l, cend_l; load_emap(F, cnt_l, pst_l, cend_l);
    const int total = __shfl(cend_l, 31) * (DFF / 32);
    for (int it = F.gw; it < total; it += F.NGW) {
        const int g = it / (DFF / 32), nt = it % (DFF / 32);
        const int e = __popcll(__ballot(F.lane < 32 && cend_l <= g));
        const int base = e > 0 ? __shfl(cend_l, e - 1) : 0;
        const int mt = g - base; const int n_e = __shfl(cnt_l, e); const int ps = __shfl(pst_l, e);
        const int idx = mt * 32 + r; const int tok = idx < n_e ? F.toklist[e * CAP + idx] : 0;
        const int hc = nt * 32 + r; const size_t brow = (size_t)e * 1024 + (size_t)(hc / 128) * 256 + (hc % 128);
        const f32x16 ag = tile32(F.H2 + (size_t)tok * D, F.WguT + brow * D, D, h);
        const f32x16 au = tile32(F.H2 + (size_t)tok * D, F.WguT + (brow + 128) * D, D, h);
#pragma unroll
        for (int i = 0; i < 16; ++i) { const int rr = mt * 32 + crow(i, h);
            if (rr < n_e) { const float gv = ag[i]; const float hv = gv / (1.0f + __expf(-gv)) * au[i]; F.HBUF[(size_t)(ps + rr) * DFF + hc] = (bf16)f2bf(hv); } }
    }
}
__device__ __forceinline__ void p8_down_base(Frame& F) {
    const int r = F.lane & 31, h = F.lane >> 5;
    int cnt_l, pst_l, cend_l; load_emap(F, cnt_l, pst_l, cend_l);
    const int total = __shfl(cend_l, 31) * (D / 32);
    for (int it = F.gw; it < total; it += F.NGW) {
        const int g = it / (D / 32), nt = it % (D / 32);
        const int e = __popcll(__ballot(F.lane < 32 && cend_l <= g));
        const int base = e > 0 ? __shfl(cend_l, e - 1) : 0;
        const int mt = g - base; const int n_e = __shfl(cnt_l, e); const int ps = __shfl(pst_l, e);
        int idx = mt * 32 + r; if (idx >= n_e) idx = n_e - 1;
        const f32x16 acc = tile32(F.HBUF + (size_t)(ps + idx) * DFF, F.WdT + ((size_t)e * 1024 + nt * 32 + r) * DFF, DFF, h);
#pragma unroll
        for (int i = 0; i < 16; ++i) { const int rr = mt * 32 + crow(i, h);
            if (rr < n_e) F.Y[(size_t)(ps + rr) * D + nt * 32 + r] = (bf16)f2bf(acc[i]); }
    }
}
__device__ __forceinline__ void p9_final(Frame& F) {
    int cnt_l, pst_l, cend_l; load_emap(F, cnt_l, pst_l, cend_l);
    for (int t = F.gw; t < T; t += F.NGW) {
        const int4 ti = *(const int4*)(F.tokinfo + 8 * t); const int4 tg = *(const int4*)(F.tokinfo + 8 * t + 4);
        const float g1 = __int_as_float(tg.x), g2 = __int_as_float(tg.y);
        const int s1 = __shfl(pst_l, ti.x) + ti.y, s2 = __shfl(pst_l, ti.z) + ti.w;
        GAS f32x4* xr = (GAS f32x4*)(F.X1 + (size_t)t * D) + F.lane; const GAS f32x4* gr = (const GAS f32x4*)F.lnf_g + F.lane;
        const GAS v2u* y1 = (const GAS v2u*)(F.Y + (size_t)s1 * D) + F.lane; const GAS v2u* y2 = (const GAS v2u*)(F.Y + (size_t)s2 * D) + F.lane;
        f32x4 v[4]; float s = 0.f;
#pragma unroll
        for (int j = 0; j < 4; ++j) { v[j] = xr[64 * j]; const v2u a = y1[64 * j], b = y2[64 * j];
            v[j].x += g1 * bflo(a.x) + g2 * bflo(b.x); v[j].y += g1 * bfhi(a.x) + g2 * bfhi(b.x); v[j].z += g1 * bflo(a.y) + g2 * bflo(b.y); v[j].w += g1 * bfhi(a.y) + g2 * bfhi(b.y);
            s += (v[j].x * v[j].x + v[j].y * v[j].y) + (v[j].z * v[j].z + v[j].w * v[j].w); }
        const float inv = 1.0f / sqrtf(wave_sum(s) * (1.f / D) + RMS_EPS);
#pragma unroll
        for (int j = 0; j < 4; ++j) { const f32x4 gg = gr[64 * j]; f32x4 o; o.x = v[j].x * inv * gg.x; o.y = v[j].y * inv * gg.y; o.z = v[j].z * inv * gg.z; o.w = v[j].w * inv * gg.w; xr[64 * j] = o; }
    }
}


__device__ __forceinline__ void load_emap256(Frame& F, int& cnt_l, int& pst_l, int& cend_l) {
    const int e = F.lane & 31;
    cnt_l = (int)__hip_atomic_load(F.cnt + e, RLX_AGENT);
    int c = (cnt_l + 255) >> 8;
#pragma unroll
    for (int o = 1; o < 32; o <<= 1) { const int cc = __shfl_up(c, o); if (e >= o) c += cc; }
    cend_l = c; pst_l = (c - ((cnt_l + 255) >> 8)) * 256;
}
__device__ __forceinline__ void p1_proj_pg8(Frame& F) {
    pg8::Gemm g{F.XN, F.WinT, T, NPROJ, D}; pg8::StaticOrder S; S.init(T, NPROJ, F.G, (int)blockIdx.x);
    pg8::EpiProj E{F.PROJ};
    pg8::gemm_phase<pg8::EpiProj, pg8::StaticOrder, true, false>(F.lds + RING_OFF, g, S, E);
}
__device__ __forceinline__ void p5_outproj_pg8(Frame& F) {
    pg8::Gemm g{F.OMIX, F.WoutT, T, D, D}; pg8::StaticOrder S; S.init(T, D, F.G, (int)blockIdx.x);
    pg8::EpiResid E{F.x, F.X1};
    pg8::gemm_phase<pg8::EpiResid, pg8::StaticOrder, false, false>(F.lds + RING_OFF, g, S, E);
}
constexpr int EMAP_OFF = LDSCTL_OFF + 1024;
__device__ __forceinline__ void moe_order_init(Frame& F, pg8::MoeOrder& S) {
    LAS int* tab = (LAS int*)(F.lds + EMAP_OFF);
    if (F.wave == 0) { int cnt_l, pst_l, cend_l; load_emap256(F, cnt_l, pst_l, cend_l); if (F.lane < 32) { tab[F.lane] = cnt_l; tab[32 + F.lane] = pst_l; tab[64 + F.lane] = cend_l; } }
    __syncthreads();
    S.G = F.G; S.c = (int)blockIdx.x; S.toklist = F.toklist; S.tab = tab; S.MT = __builtin_amdgcn_readfirstlane(tab[64 + 31]); S.nwg = S.MT * 4;
}
__device__ __forceinline__ void p7_gateup_pg8(Frame& F) {
    pg8::MoeOrder S; moe_order_init(F, S);
    pg8::Gemm g{F.H2, F.WguT, 0, 0, D}; pg8::EpiGateUp E{F.HBUF};
    pg8::gemm_phase<pg8::EpiGateUp, pg8::MoeOrder, true, true>(F.lds + RING_OFF, g, S, E);
}
__device__ __forceinline__ void p8_down_pg8(Frame& F) {
    pg8::MoeOrder S; moe_order_init(F, S);
    pg8::Gemm g{F.HBUF, F.WdT, 0, 0, DFF}; pg8::EpiY E{F.Y};
    pg8::gemm_phase<pg8::EpiY, pg8::MoeOrder, true, false>(F.lds + RING_OFF, g, S, E);
}

#ifndef USE_GLAFAST
#define USE_GLAFAST 1
#endif
#ifndef USE_SBFAST
#define USE_SBFAST 1
#endif
#ifndef USE_PG8
#define USE_PG8 15
#endif
constexpr int NPHASE = 10;
struct Args { const float* in[16]; float* out; unsigned char* ws; int ph_lo, ph_hi, li, pad; };
__global__ void __launch_bounds__(NWAVES * 64, 2) mk_fwd(Args args) {
    extern __shared__ __attribute__((aligned(16))) unsigned char lds[];
    Frame F;
    F.lds = (LAS unsigned char*)lds;
    F.MISC = (volatile LAS unsigned*)(F.lds + MISC_OFF);
    F.tid = threadIdx.x; F.lane = F.tid & 63; F.wave = __builtin_amdgcn_readfirstlane(F.tid >> 6);
    F.G = gridDim.x; { const int bx = blockIdx.x; F.vcu = (F.G % 8 == 0) ? (bx % 8) * (F.G / 8) + bx / 8 : bx; }
    F.gw = F.vcu * NWAVES + F.wave; F.NGW = F.G * NWAVES;
    unsigned char* ws = args.ws; F.ws = ws;
    F.ctl = (gu32*)(ws + WS_CTL);
    F.x = args.in[0]; F.ln1_g = args.in[1]; F.w_in = args.in[2]; F.gate_w2 = args.in[3]; F.gate_b = args.in[4]; F.gnorm_g = args.in[5]; F.w_out = args.in[6]; F.ln2_g = args.in[7];
    F.w_group = args.in[8]; F.b_group = args.in[9]; F.w_expert = args.in[10]; F.b_expert = args.in[11]; F.ew_gate = args.in[12]; F.ew_up = args.in[13]; F.ew_down = args.in[14]; F.lnf_g = args.in[15];
    F.out = args.out;
    F.WinT = (bf16*)(ws + WS_WIN); F.WoutT = (bf16*)(ws + WS_WOUT); F.WguT = (bf16*)(ws + WS_WGU); F.WdT = (bf16*)(ws + WS_WD);
    F.XN = (bf16*)(ws + WS_R1); F.OMIX = (bf16*)(ws + WS_R1); F.H2 = (bf16*)(ws + WS_R1);
    F.PROJ = (bf16*)(ws + WS_R2); F.HBUF = (bf16*)(ws + WS_R2); F.Y = (bf16*)(ws + WS_Y);
    F.GLR = (float*)(ws + WS_GLR); F.LOGA = (float*)((unsigned char*)args.out + DO_LOGA); F.OG = (float*)((unsigned char*)args.out + DO_OG); F.X1 = args.out; F.DS = F.OG; F.DEC = (float*)(ws + WS_DEC); F.ST = (bf16*)((unsigned char*)args.out + DO_ST);
    F.toklist = (int*)(ws + WS_TOKLIST); F.gatelist = (float*)(ws + WS_GATELIST); F.tokinfo = (int*)(ws + WS_TOKINFO); F.cnt = (unsigned*)(ws + WS_CTL) + CW_CNT;
    for (int u = F.tid; u < (LDS_BYTES - LDSCTL_OFF) / 4; u += NWAVES * 64) ((LAS unsigned*)(F.lds + LDSCTL_OFF))[u] = 0u;
    __syncthreads();
    XcdBarrier bar = xcd_barrier_post((unsigned*)(F.ctl + CW_BAR) + args.li * XCD_BAR_WORDS, F.MISC + 8);
    const int lo = args.ph_lo, hi = args.ph_hi;
#define IN(k) (lo <= (k) && (k) < hi)
#define SEAM(k) do { if (IN(k) && IN((k) + 1)) xcd_barrier(bar); } while (0)
    if (IN(0)) { p0_prologue(F); } SEAM(0);
    if (IN(1)) { if (USE_PG8 & 1) p1_proj_pg8(F); else p1_proj_base(F); p1_loga(F); } SEAM(1);
    if (IN(2)) { if (USE_SBFAST) p2_sb_fast(F); else p2_sb_base(F); if (USE_GLAFAST) gla_pass_a(F); } SEAM(2);
    if (IN(3)) { if (USE_GLAFAST) gla_pass_b(F); else p3_gla_base(F); } SEAM(3);
    if (IN(4)) { if (USE_GLAFAST) gla_pass_c(F); else p4_gla_out(F); } SEAM(4);
    if (IN(5)) { if (USE_PG8 & 2) p5_outproj_pg8(F); else p5_outproj_base(F); } SEAM(5);
    if (IN(6)) { p6_route(F); } SEAM(6);
    if (IN(7)) { if (USE_PG8 & 4) p7_gateup_pg8(F); else p7_gateup_base(F); } SEAM(7);
    if (IN(8)) { if (USE_PG8 & 8) p8_down_pg8(F); else p8_down_base(F); } SEAM(8);
    if (IN(9)) { p9_final(F); }
#undef IN
#undef SEAM
}

#ifndef MK_ONE_LAUNCH
#define MK_ONE_LAUNCH 1
#endif
extern "C" void kernel_launch(void* const* d_in, const int* in_sizes, int n_in, void* d_out, int out_size, void* d_ws, size_t ws_size, hipStream_t stream) {
    static int grid = 0;
    if (grid == 0) {
        if (n_in != 16 || in_sizes[0] != T * D || out_size != T * D || ws_size < WS_END) {
            fprintf(stderr, "kernel_launch: unexpected shapes / workspace (n_in %d, in0 %d, out %d, ws %zu, need %zu); nothing launched\n", n_in, n_in > 0 ? in_sizes[0] : -1, out_size, ws_size, (size_t)WS_END); grid = -1; return; }
        int dev = 0, cus = 0, per_cu = 0;
        if (hipGetDevice(&dev) != hipSuccess || hipDeviceGetAttribute(&cus, hipDeviceAttributeMultiprocessorCount, dev) != hipSuccess) { grid = -1; return; }
        if (hipFuncSetAttribute((const void*)mk_fwd, hipFuncAttributeMaxDynamicSharedMemorySize, LDS_BYTES) != hipSuccess) { fprintf(stderr, "kernel_launch: hipFuncSetAttribute failed\n"); grid = -1; return; }
        if (hipOccupancyMaxActiveBlocksPerMultiprocessor(&per_cu, (const void*)mk_fwd, NWAVES * 64, LDS_BYTES) != hipSuccess || per_cu < 1) { fprintf(stderr, "kernel_launch: occupancy query says %d\n", per_cu); per_cu = 1; }
        (void)hipGetLastError();
        grid = cus;
    }
    if (grid < 0) return;
    (void)hipMemsetAsync((char*)d_ws + WS_CTL, 0, CTL_ZERO_BYTES, stream);
    Args a{};
    for (int i = 0; i < 16; ++i) a.in[i] = (const float*)d_in[i];
    a.out = (float*)d_out; a.ws = (unsigned char*)d_ws;
#if MK_ONE_LAUNCH
    a.ph_lo = 0; a.ph_hi = NPHASE; a.li = 0;
    { void* kargs[] = {&a}; hipError_t e = hipLaunchCooperativeKernel((const void*)mk_fwd, dim3(grid), dim3(NWAVES * 64), kargs, LDS_BYTES, stream);
      if (e != hipSuccess) fprintf(stderr, "kernel_launch: cooperative launch failed: %s\n", hipGetErrorString(e)); }
#else
    for (int p = 0; p < NPHASE; ++p) { a.ph_lo = p; a.ph_hi = p + 1; a.li = 0; hipLaunchKernelGGL(mk_fwd, dim3(grid), dim3(NWAVES * 64), LDS_BYTES, stream, a); }
#endif
}
```

```cpp
#include <hip/hip_runtime.h>
#include <cstdio>
#include <cstdint>

#define GAS __attribute__((address_space(1)))
#define LAS __attribute__((address_space(3)))
typedef unsigned short bf16;
typedef short bf16x8 __attribute__((ext_vector_type(8)));
typedef float f32x4 __attribute__((ext_vector_type(4)));
typedef float f32x16 __attribute__((ext_vector_type(16)));
typedef unsigned v4u __attribute__((ext_vector_type(4)));
typedef unsigned v2u __attribute__((ext_vector_type(2)));
typedef GAS unsigned gu32;
#define RLX_AGENT __ATOMIC_RELAXED, __HIP_MEMORY_SCOPE_AGENT
#define LDS_WAIT() asm volatile("s_waitcnt lgkmcnt(0)" ::: "memory")
#define VM_WAIT() asm volatile("s_waitcnt vmcnt(0)" ::: "memory")

constexpr int BATCH = 4, SEQ = 4096, T = BATCH * SEQ, D = 1024, DIN = 3088, NPROJ = 3072;
constexpr int SBH = 8, SBD = 64, GH = 4, GDK = 64, GDV = 128, GRANK = 16;
constexpr int NE = 32, EPG = 8, NGRP = 4, DFF = 512;
constexpr int COL_SBQ = 0, COL_SBK = 512, COL_SBV = 1024, COL_GQ = 1536, COL_GK = 1792, COL_GV = 2048, COL_GR = 2560, COL_GLR = 3072;
constexpr float RMS_EPS = 1e-6f;
constexpr float LOG2E = 1.4426950408889634f;
constexpr float SBQ_SCALE = 0.125f * LOG2E;
constexpr float GQ_SCALE = 0.125f;
constexpr int NWAVES = 8;
constexpr int CAP = T;

constexpr size_t MiB = 1u << 20;
constexpr size_t WS_CTL = 0, CTL_ZERO_BYTES = 1 * MiB;
constexpr size_t WS_TOKLIST = 1 * MiB;
constexpr size_t WS_GATELIST = 3 * MiB;
constexpr size_t WS_TOKINFO = 5 * MiB;
constexpr size_t WS_GLR = 6 * MiB;
constexpr size_t WS_WRT = 7 * MiB + 512 * 1024;
constexpr size_t WS_DEC = 7 * MiB;
constexpr size_t WS_WIN = 8 * MiB;
constexpr size_t WS_WOUT = 15 * MiB;
constexpr size_t WS_WD = 17 * MiB;
constexpr size_t WS_WGU = 49 * MiB;
constexpr size_t WS_R1 = 113 * MiB;
constexpr size_t WS_R2 = 153 * MiB;
constexpr size_t WS_Y = WS_WGU;
constexpr size_t WS_END = 249 * MiB;
constexpr size_t DO_LOGA = 0;
constexpr size_t DO_OG = 16 * MiB;
constexpr size_t DO_ST = 48 * MiB;
constexpr int CW_TMO = 0, CW_CODE = 1;
constexpr int CW_CNT = 1024, CNT_STRIDE = 32;
constexpr int CW_BAR = 4096;

constexpr int RING_OFF = 0, RING_BYTES = 131072;
constexpr int LDSCTL_OFF = RING_BYTES, MISC_OFF = LDSCTL_OFF + 320;
constexpr int LDS_BYTES = 147456;

__device__ __forceinline__ unsigned f2bf(float f) { unsigned u = __builtin_bit_cast(unsigned, f); return (u + 0x7fffu + ((u >> 16) & 1u)) >> 16; }
__device__ __forceinline__ unsigned pk2(float lo, float hi) { return f2bf(lo) | (f2bf(hi) << 16); }
__device__ __forceinline__ float bf2f(unsigned b) { return __builtin_bit_cast(float, b << 16); }
__device__ __forceinline__ float bflo(unsigned w) { return __builtin_bit_cast(float, w << 16); }
__device__ __forceinline__ float bfhi(unsigned w) { return __builtin_bit_cast(float, w & 0xffff0000u); }
__device__ __forceinline__ int crow(int r, int hi) { return (r & 3) + 8 * (r >> 2) + 4 * hi; }
__device__ __forceinline__ float wave_sum(float v) {
#pragma unroll
    for (int o = 1; o < 64; o <<= 1) v += __shfl_xor(v, o);
    return v;
}

#define XB_TMO      128
#define XB_XCNT(j)  (256  + 64 * (j))
#define XB_XSUB(j)  (1280 + 64 * (j))
#define XB_XGEN(j)  (2304 + 64 * (j))
#define XB_TOP      3328
#define XB_TOPGEN   3392
#define XCD_BAR_WORDS 3456
#define XB_SPIN_CAP (1u << 18)
__device__ __forceinline__ unsigned xb_ld(unsigned* p)              { return __hip_atomic_load(p, __ATOMIC_RELAXED, __HIP_MEMORY_SCOPE_AGENT); }
__device__ __forceinline__ unsigned xb_add(unsigned* p, unsigned v) { return __hip_atomic_fetch_add(p, v, __ATOMIC_RELAXED, __HIP_MEMORY_SCOPE_AGENT); }
__device__ __forceinline__ unsigned xb_xcc_id() { return (unsigned)__builtin_amdgcn_s_getreg((3 << 11) | 20) & 0xFu; }
#define XB_SPIN(cond, bar) do { unsigned _sp = 0; while (cond) { __builtin_amdgcn_s_sleep(1); \
    if ((++_sp & 255u) == 0u) { if (xb_ld(&(bar)[XB_TMO])) break; if (_sp > XB_SPIN_CAP) { atomicAdd(&(bar)[XB_TMO], 1u); break; } } } } while (0)
struct XcdBarrier { unsigned* bar; unsigned x; volatile LAS unsigned* st; };
__device__ __forceinline__ XcdBarrier xcd_barrier_post(unsigned* bar, volatile LAS unsigned* st) {
    XcdBarrier b; b.bar = bar; b.x = xb_xcc_id(); b.st = st;
    if (threadIdx.x == 0) (void)xb_add(&bar[XB_XCNT(b.x)], 1u);
    return b;
}
__device__ __forceinline__ void xcd_barrier_complete(unsigned* bar, unsigned x, unsigned& nloc, unsigned& nx) {
    const unsigned G = gridDim.x * gridDim.y * gridDim.z;
    unsigned sum, cnt, mine, sp = 0u;
    for (;;) {
        sum = 0u; cnt = 0u; mine = 0u;
#pragma unroll
        for (unsigned j = 0; j < 16; ++j) { const unsigned c = xb_ld(&bar[XB_XCNT(j)]); sum += c; cnt += (c > 0u) ? 1u : 0u; mine = (j == x) ? c : mine; }
        if (sum == G) break;
        __builtin_amdgcn_s_sleep(1);
        if ((++sp & 255u) == 0u) { if (xb_ld(&bar[XB_TMO])) break; if (sp > XB_SPIN_CAP) { atomicAdd(&bar[XB_TMO], 1u); break; } }
    }
    nloc = mine > 0u ? mine : 1u; nx = cnt > 0u ? cnt : 1u;
}
__device__ __forceinline__ void xcd_barrier(const XcdBarrier& b) {
    asm volatile("s_waitcnt vmcnt(0)" ::: "memory");
    __syncthreads();
    if (threadIdx.x == 0) {
        unsigned* bar = b.bar;
        __builtin_amdgcn_s_waitcnt(0);
        unsigned nloc = b.st[0], nx = b.st[1];
        if (nloc == 0u) { xcd_barrier_complete(bar, b.x, nloc, nx); b.st[0] = nloc; b.st[1] = nx; }
        const unsigned old = xb_add(&bar[XB_XSUB(b.x)], 1u);
        const unsigned gen = old / nloc;
        if (old + 1u == (gen + 1u) * nloc) {
            __builtin_amdgcn_fence(__ATOMIC_RELEASE, "agent");
            asm volatile("s_waitcnt vmcnt(0)" ::: "memory");
            const unsigned og = xb_add(&bar[XB_TOP], 1u);
            const unsigned tg = og / nx;
            if (og + 1u == (tg + 1u) * nx) xb_add(&bar[XB_TOPGEN], 1u);
            else XB_SPIN(xb_ld(&bar[XB_TOPGEN]) == tg, bar);
            __builtin_amdgcn_fence(__ATOMIC_ACQUIRE, "agent");
            xb_add(&bar[XB_XGEN(b.x)], 1u);
            asm volatile("s_waitcnt vmcnt(0)" ::: "memory");
        } else {
            XB_SPIN(xb_ld(&bar[XB_XGEN(b.x)]) == gen, bar);
            __builtin_amdgcn_fence(__ATOMIC_ACQUIRE, "agent");
            asm volatile("s_waitcnt vmcnt(0)" ::: "memory");
        }
    }
    __syncthreads();
}


namespace pg8 {
#define PG8_LAS __attribute__((address_space(3)))
typedef unsigned short bf16_t;
typedef unsigned u32x4 __attribute__((ext_vector_type(4)));
constexpr int BM = 256, BK = 64, HALF = 128, HTB = HALF * BK * 2, STAGE_BYTES = 8 * HTB, NXCD = 8, WGM = 8;
__host__ __device__ __forceinline__ int lds_byte(int r, int c) { const int st = (r >> 4) * 2 + (c >> 5), rr = r & 15, cc = c & 31, ob = rr * 64 + cc * 2; return st * 1024 + (ob ^ (((ob >> 9) & 1) << 5)); }
__host__ __device__ __forceinline__ void stage_rc(int b, int& R, int& C) { const int st = b / 1024, sb = b % 1024, swz = sb ^ (((sb >> 9) & 1) << 5); R = (st >> 1) * 16 + swz / 64; C = (st & 1) * 32 + (swz % 64) / 2; }
__host__ __device__ __forceinline__ int perm32(int rho) { const int n = rho >> 4, i = rho & 15; return 8 * (i >> 2) + 4 * n + (i & 3); }
struct Unit { int pm, pn, e, r0, ne; };
struct Gemm { const bf16_t* A; const bf16_t* Bt; int M, N, K; };
struct StaticOrder {
    int nM, nN, nwg, G, c;
    __device__ void init(int M, int N, int G_, int c_) { nM = M / BM; nN = N / BM; nwg = nM * nN; G = G_; c = c_; }
    __device__ __forceinline__ bool next(int i, Unit& u) const {
        const long L = (long)i * G + c; if (L >= nwg) return false;
        int wgid = (int)L; { const int q = nwg / NXCD, r = nwg % NXCD, xcd = wgid % NXCD, off = wgid / NXCD; wgid = (xcd < r ? xcd * (q + 1) : r * (q + 1) + (xcd - r) * q) + off; }
        const int nig = WGM * nN, gid = wgid / nig, fm = gid * WGM, gsz = (nM - fm) < WGM ? (nM - fm) : WGM;
        u.pm = fm + ((wgid % nig) % gsz); u.pn = (wgid % nig) / gsz; u.e = 0; u.r0 = 0; u.ne = 0; return true;
    }
    __device__ __forceinline__ int src_row(const Unit& u, int R) const { return u.pm * BM + R; }
};
__device__ __forceinline__ unsigned cvt_pk_bf16(float lo, float hi) { unsigned r; asm volatile("v_cvt_pk_bf16_f32 %0, %1, %2" : "=v"(r) : "v"(lo), "v"(hi)); return r; }

template <class Epi, class Sched, bool ALIGN_EPI, bool GATHER>
__device__ __forceinline__ void gemm_phase(PG8_LAS unsigned char* lds, const Gemm g, const Sched& S, const Epi& E) {
    const int tid = threadIdx.x, wid = __builtin_amdgcn_readfirstlane(tid >> 6), lane = tid & 63, wr = wid >> 2, wc = wid & 3, fr = lane & 15, fq = lane >> 4;
    const int K = g.K, nt = K / BK;
    int RA[2], CA[2]; unsigned voffB[2];
#pragma unroll
    for (int i = 0; i < 2; ++i) { int R, C; stage_rc(tid * 16 + i * 8192, R, C); const int Rb = Epi::PERM ? ((R & ~31) + perm32(R & 31)) : R;
        RA[i] = R; CA[i] = C; voffB[i] = (unsigned)(Rb * K + C) * 2u; }
    const size_t kstep = (size_t)(BK * 2);
    const size_t hstep = (size_t)HALF * K * 2;
    const size_t tstep = 2 * hstep;
    const unsigned ldsw = (unsigned)wid * 1024u;
    const int aoff = lds_byte(wr * 64 + fr, fq * 8), boff = lds_byte(wc * 32 + fr, fq * 8);
#define PG8_SA(b, h) (((b) * 2 + (h)) * HTB)
#define PG8_SB(b, h) ((4 + (b) * 2 + (h)) * HTB)
#define PG8_STAGE(bufoff, gbase, voff) do { _Pragma("unroll") for (int _i = 0; _i < 2; ++_i) \
        __builtin_amdgcn_global_load_lds((const unsigned*)((const char*)(gbase) + (voff)[_i]), (PG8_LAS unsigned*)(lds + (bufoff) + ldsw + _i * 8192), 16, 0, 0); } while (0)
#define PG8_LDA(dst, b, h) do { _Pragma("unroll") for (int m = 0; m < 4; ++m) _Pragma("unroll") for (int k = 0; k < 2; ++k) dst[m][k] = *(const PG8_LAS bf16x8*)(lds + PG8_SA(b, h) + aoff + m * 2048 + k * 1024); } while (0)
#define PG8_LDB(dst, b, h) do { _Pragma("unroll") for (int n = 0; n < 2; ++n) _Pragma("unroll") for (int k = 0; k < 2; ++k) dst[n][k] = *(const PG8_LAS bf16x8*)(lds + PG8_SB(b, h) + boff + n * 2048 + k * 1024); } while (0)
#define PG8_MMA(ai, bj, At, Bt) do { __builtin_amdgcn_s_setprio(1); _Pragma("unroll") for (int m = 0; m < 4; ++m) _Pragma("unroll") for (int n = 0; n < 2; ++n) _Pragma("unroll") for (int k = 0; k < 2; ++k) \
        acc[ai][bj][m][n] = __builtin_amdgcn_mfma_f32_16x16x32_bf16(Bt[n][k], At[m][k], acc[ai][bj][m][n], 0, 0, 0); __builtin_amdgcn_s_setprio(0); } while (0)
#define PG8_WAIT_V(n) asm volatile("s_waitcnt vmcnt(" #n ")" ::: "memory")
#define PG8_WAIT_L(n) asm volatile("s_waitcnt lgkmcnt(" #n ")" ::: "memory")
#define PG8_BAR __builtin_amdgcn_s_barrier()
#define PG8_SCHED __builtin_amdgcn_sched_barrier(0)
#define PG8_CALC_VA(dst, u) do { _Pragma("unroll") for (int _h = 0; _h < 2; ++_h) _Pragma("unroll") for (int _i = 0; _i < 2; ++_i) { \
        if constexpr (GATHER) dst[_h][_i] = (unsigned)(S.src_row(u, _h * HALF + RA[_i]) * K + CA[_i]) * 2u; \
        else dst[_h][_i] = (unsigned)((_h * HALF + RA[_i]) * K + CA[_i]) * 2u; } } while (0)
    Unit cur, nxt; int ui = 0;
    if (!S.next(0, cur)) return;
    f32x4 acc[2][2][4][2];
#pragma unroll
    for (int a = 0; a < 2; ++a)
#pragma unroll
        for (int b = 0; b < 2; ++b)
#pragma unroll
            for (int m = 0; m < 4; ++m)
#pragma unroll
                for (int n = 0; n < 2; ++n) acc[a][b][m][n] = (f32x4){0.f, 0.f, 0.f, 0.f};
    bf16x8 At[4][2], B0[2][2], B1[2][2];
    unsigned vA[2][2], vAn[2][2];
    PG8_CALC_VA(vA, cur);
    const char* cA = (const char*)g.A + (GATHER ? (size_t)0 : (size_t)cur.pm * tstep); const char* cB = (const char*)g.Bt + (size_t)cur.pn * tstep;
    PG8_STAGE(PG8_SB(0, 0), cB, voffB); PG8_STAGE(PG8_SB(0, 1), cB + hstep, voffB); PG8_STAGE(PG8_SA(0, 0), cA, vA[0]); PG8_STAGE(PG8_SA(0, 1), cA, vA[1]);
    if (wr == 1) PG8_BAR;
    PG8_WAIT_V(2); PG8_BAR;
    PG8_STAGE(PG8_SB(1, 0), cB + kstep, voffB); PG8_STAGE(PG8_SA(1, 0), cA + kstep, vA[0]); PG8_STAGE(PG8_SB(1, 1), cB + hstep + kstep, voffB);
    PG8_WAIT_V(6); PG8_BAR;
    for (;;) {
        const bool has_next = S.next(ui + 1, nxt);
        if (!has_next) nxt = cur;
        const char* nA = (const char*)g.A + (GATHER ? (size_t)0 : (size_t)nxt.pm * tstep); const char* nB = (const char*)g.Bt + (size_t)nxt.pn * tstep;
        if (has_next) { PG8_CALC_VA(vAn, nxt); } else {
#pragma unroll
            for (int _h = 0; _h < 2; ++_h)
#pragma unroll
                for (int _i = 0; _i < 2; ++_i) vAn[_h][_i] = vA[_h][_i]; }
        for (int t = 0; t < nt; t += 2) {
            const bool last = (t == nt - 2);
            const char* a1 = cA + (size_t)(t + 1) * kstep;
            const char* a2 = last ? nA : cA + (size_t)(t + 2) * kstep; const char* b2 = last ? nB : cB + (size_t)(t + 2) * kstep;
            const char* a3 = a2 + kstep; const char* b3 = b2 + kstep;
            unsigned w0[2], w1[2];
#pragma unroll
            for (int _i = 0; _i < 2; ++_i) { w0[_i] = last ? vAn[0][_i] : vA[0][_i]; w1[_i] = last ? vAn[1][_i] : vA[1][_i]; }
            PG8_LDB(B0, 0, 0); PG8_LDB(B1, 0, 1); PG8_SCHED; PG8_LDA(At, 0, 0); PG8_STAGE(PG8_SA(1, 1), a1, vA[1]);
            PG8_WAIT_V(8); PG8_WAIT_L(0); PG8_BAR; PG8_MMA(0, 0, At, B0); PG8_MMA(0, 1, At, B1); PG8_BAR; PG8_SCHED;
            PG8_LDA(At, 0, 1); PG8_STAGE(PG8_SB(0, 0), b2, voffB); PG8_STAGE(PG8_SB(0, 1), b2 + hstep, voffB); PG8_STAGE(PG8_SA(0, 0), a2, w0);
            PG8_WAIT_V(8); PG8_WAIT_L(0); PG8_BAR; PG8_MMA(1, 0, At, B0); PG8_MMA(1, 1, At, B1); PG8_BAR; PG8_SCHED;
            PG8_LDB(B0, 1, 0); PG8_LDB(B1, 1, 1); PG8_SCHED; PG8_LDA(At, 1, 0); PG8_STAGE(PG8_SA(0, 1), a2, w1);
            PG8_WAIT_V(8); PG8_WAIT_L(0); PG8_BAR; PG8_MMA(0, 0, At, B0); PG8_MMA(0, 1, At, B1); PG8_BAR; PG8_SCHED;
            PG8_LDA(At, 1, 1); PG8_STAGE(PG8_SB(1, 0), b3, voffB); PG8_STAGE(PG8_SB(1, 1), b3 + hstep, voffB); PG8_STAGE(PG8_SA(1, 0), a3, w0);
            PG8_WAIT_V(8); PG8_WAIT_L(0); PG8_BAR; PG8_MMA(1, 0, At, B0); PG8_MMA(1, 1, At, B1); PG8_BAR; PG8_SCHED;
        }
        if constexpr (ALIGN_EPI) { if (wr == 0) PG8_BAR; }
        E(acc, cur, wr, wc, fr, fq);
        if (!has_next) break;
#pragma unroll
        for (int a = 0; a < 2; ++a)
#pragma unroll
            for (int b = 0; b < 2; ++b)
#pragma unroll
                for (int m = 0; m < 4; ++m)
#pragma unroll
                    for (int n = 0; n < 2; ++n) acc[a][b][m][n] = (f32x4){0.f, 0.f, 0.f, 0.f};
        cur = nxt; cA = nA; cB = nB; ++ui;
#pragma unroll
        for (int _h = 0; _h < 2; ++_h)
#pragma unroll
            for (int _i = 0; _i < 2; ++_i) vA[_h][_i] = vAn[_h][_i];
        if constexpr (ALIGN_EPI) { if (wr == 1) PG8_BAR; }
    }
    PG8_WAIT_V(0);
    if constexpr (!ALIGN_EPI) { if (wr == 0) PG8_BAR; }
    PG8_BAR;
#undef PG8_SA
#undef PG8_SB
#undef PG8_STAGE
#undef PG8_LDA
#undef PG8_LDB
#undef PG8_MMA
#undef PG8_WAIT_V
#undef PG8_WAIT_L
#undef PG8_BAR
#undef PG8_SCHED
#undef PG8_CALC_VA
}

struct EpiProj {
    static constexpr bool PERM = true;
    bf16_t* O;
    __device__ __forceinline__ void operator()(const f32x4 (&acc)[2][2][4][2], const Unit& u, int wr, int wc, int fr, int fq) const {
        const int row0 = u.pm * BM + wr * 64 + fr; const int col0 = u.pn * BM + wc * 32 + 8 * fq;
        const float sc = u.pn < 2 ? SBQ_SCALE : (u.pn == 6 ? GQ_SCALE : 1.0f);
#pragma unroll
        for (int ai = 0; ai < 2; ++ai)
#pragma unroll
            for (int m = 0; m < 4; ++m) { bf16_t* rowp = O + (size_t)(row0 + ai * HALF + m * 16) * NPROJ + col0;
#pragma unroll
                for (int bj = 0; bj < 2; ++bj) { const f32x4 v0 = acc[ai][bj][m][0] * sc, v1 = acc[ai][bj][m][1] * sc;
                    u32x4 w; w.x = cvt_pk_bf16(v0[0], v0[1]); w.y = cvt_pk_bf16(v0[2], v0[3]); w.z = cvt_pk_bf16(v1[0], v1[1]); w.w = cvt_pk_bf16(v1[2], v1[3]);
                    *(u32x4*)(rowp + bj * HALF) = w; } }
    }
};
struct EpiResid {
    static constexpr bool PERM = false;
    const float* X; float* C; const float* G; bf16_t* H2;
    __device__ __forceinline__ void operator()(const f32x4 (&acc)[2][2][4][2], const Unit& u, int wr, int wc, int fr, int fq) const {
        const int row0 = u.pm * BM + wr * 64 + fr, col0 = u.pn * BM + wc * 32 + 4 * fq;
        f32x4 gv[2][2];
#pragma unroll
        for (int bj = 0; bj < 2; ++bj)
#pragma unroll
            for (int n = 0; n < 2; ++n) gv[bj][n] = *(const f32x4*)(G + col0 + bj * HALF + n * 16);
#pragma unroll
        for (int ai = 0; ai < 2; ++ai)
#pragma unroll
            for (int m = 0; m < 4; ++m) { const size_t off = (size_t)(row0 + ai * HALF + m * 16) * D + col0;
#pragma unroll
                for (int bj = 0; bj < 2; ++bj)
#pragma unroll
                    for (int n = 0; n < 2; ++n) { const f32x4 v = *(const f32x4*)(X + off + bj * HALF + n * 16) + acc[ai][bj][m][n]; *(f32x4*)(C + off + bj * HALF + n * 16) = v;
                        const f32x4 hv = v * gv[bj][n]; v2u w; w.x = cvt_pk_bf16(hv[0], hv[1]); w.y = cvt_pk_bf16(hv[2], hv[3]); *(v2u*)(H2 + off + bj * HALF + n * 16) = w; } }
    }
};
struct EpiGateUp {
    static constexpr bool PERM = true;
    bf16_t* H; const float* invlist;
    __device__ __forceinline__ void operator()(const f32x4 (&acc)[2][2][4][2], const Unit& u, int wr, int wc, int fr, int fq) const {
        const int row0 = u.pm * BM + wr * 64 + fr; const int col0 = (u.pn & 3) * HALF + wc * 32 + 8 * fq;
#pragma unroll
        for (int ai = 0; ai < 2; ++ai)
#pragma unroll
            for (int m = 0; m < 4; ++m) { float hv[8]; const int row = row0 + ai * HALF + m * 16; const int idx = row - u.r0;
                const float inv = idx < u.ne ? invlist[u.e * CAP + idx] : 0.f;
#pragma unroll
                for (int n = 0; n < 2; ++n)
#pragma unroll
                    for (int j = 0; j < 4; ++j) { const float gv = acc[ai][0][m][n][j] * inv, uv = acc[ai][1][m][n][j] * inv; hv[4 * n + j] = gv * __builtin_amdgcn_rcpf(1.0f + __expf(-gv)) * uv; }
                u32x4 w; w.x = cvt_pk_bf16(hv[0], hv[1]); w.y = cvt_pk_bf16(hv[2], hv[3]); w.z = cvt_pk_bf16(hv[4], hv[5]); w.w = cvt_pk_bf16(hv[6], hv[7]);
                *(u32x4*)(H + (size_t)row * DFF + col0) = w; }
    }
};
struct EpiY {
    static constexpr bool PERM = true;
    bf16_t* Y;
    __device__ __forceinline__ void operator()(const f32x4 (&acc)[2][2][4][2], const Unit& u, int wr, int wc, int fr, int fq) const {
        const int row0 = u.pm * BM + wr * 64 + fr; const int col0 = (u.pn & 3) * BM + wc * 32 + 8 * fq;
#pragma unroll
        for (int ai = 0; ai < 2; ++ai)
#pragma unroll
            for (int m = 0; m < 4; ++m) { bf16_t* rowp = Y + (size_t)(row0 + ai * HALF + m * 16) * D + col0;
#pragma unroll
                for (int bj = 0; bj < 2; ++bj) { const f32x4 v0 = acc[ai][bj][m][0], v1 = acc[ai][bj][m][1];
                    u32x4 w; w.x = cvt_pk_bf16(v0[0], v0[1]); w.y = cvt_pk_bf16(v0[2], v0[3]); w.z = cvt_pk_bf16(v1[0], v1[1]); w.w = cvt_pk_bf16(v1[2], v1[3]);
                    *(u32x4*)(rowp + bj * HALF) = w; } }
    }
};
struct MoeOrder {
    int G, c, MT, nwg; const PG8_LAS int* tab;
    const int* toklist;
    __device__ __forceinline__ bool next(int i, Unit& u) const {
        const long L = (long)i * G + c; if (L >= nwg) return false;
        int wgid = (int)L; { const int q = nwg / NXCD, r = nwg % NXCD, xcd = wgid % NXCD, off = wgid / NXCD; wgid = (xcd < r ? xcd * (q + 1) : r * (q + 1) + (xcd - r) * q) + off; }
        const int st = wgid >> 2, ntl = wgid & 3;
        const int ln = threadIdx.x & 31;
        const int e = __popcll(__ballot(tab[64 + ln] <= st)) >> 1;
        u.pm = st; u.pn = e * 4 + ntl; u.e = e; u.r0 = __builtin_amdgcn_readfirstlane(tab[32 + e]); u.ne = __builtin_amdgcn_readfirstlane(tab[e]); return true;
    }
    __device__ __forceinline__ int src_row(const Unit& u, int R) const { const int idx = u.pm * BM + R - u.r0; return idx < u.ne ? toklist[u.e * CAP + idx] : 0; }
};
}

struct Frame {
    LAS unsigned char* lds;
    volatile LAS unsigned* MISC;
    gu32* ctl;
    int tid, lane, wave;
    int vcu, G;
    int gw, NGW;
    const float *x, *ln1_g, *w_in, *gate_w2, *gate_b, *gnorm_g, *w_out, *ln2_g, *w_group, *b_group, *w_expert, *b_expert, *ew_gate, *ew_up, *ew_down, *lnf_g;
    float* out;
    unsigned char* ws;
    bf16 *WinT, *WoutT, *WguT, *WdT, *XN, *OMIX, *H2, *HBUF, *PROJ, *Y;
    float *GLR, *LOGA, *OG, *X1, *DS, *DEC, *WrT; bf16* ST;
    int* toklist; float* gatelist; float* invlist; int* tokinfo; unsigned* cnt;
};

__device__ __forceinline__ void p0_transpose_item(const float* W, int ldw, int K, int k0, int n0, bf16* WT, size_t dst_row0, LAS float* scr, int lane) {
#pragma unroll 8
    for (int i = 0; i < 32; ++i) { const int kk = 2 * i + (lane >> 5); scr[kk * 33 + (lane & 31)] = W[(size_t)(k0 + kk) * ldw + n0 + (lane & 31)]; }
    LDS_WAIT(); asm volatile("" ::: "memory");
    const int c = lane & 7;
#pragma unroll
    for (int j = 0; j < 4; ++j) { const int n = (lane >> 3) + 8 * j; const LAS float* s = scr + (8 * c) * 33 + n;
        v4u o; o.x = pk2(s[0 * 33], s[1 * 33]); o.y = pk2(s[2 * 33], s[3 * 33]); o.z = pk2(s[4 * 33], s[5 * 33]); o.w = pk2(s[6 * 33], s[7 * 33]);
        *(GAS v4u*)(WT + (dst_row0 + n) * K + k0 + 8 * c) = o; }
    LDS_WAIT(); asm volatile("" ::: "memory");
}
__device__ __forceinline__ void rms_row_to_bf16(int lane, const float* xrow, const float* g, bf16* orow) {
    const GAS f32x4* xr = (const GAS f32x4*)xrow + lane; const GAS f32x4* gr = (const GAS f32x4*)g + lane;
    f32x4 v[4]; float s = 0.f;
#pragma unroll
    for (int j = 0; j < 4; ++j) { v[j] = xr[64 * j]; s += (v[j].x * v[j].x + v[j].y * v[j].y) + (v[j].z * v[j].z + v[j].w * v[j].w); }
    const float inv = 1.0f / sqrtf(wave_sum(s) * (1.f / D) + RMS_EPS);
    GAS unsigned long long* o8 = (GAS unsigned long long*)orow + lane;
#pragma unroll
    for (int j = 0; j < 4; ++j) { const f32x4 gg = gr[64 * j];
        o8[64 * j] = (unsigned long long)pk2(v[j].x * inv * gg.x, v[j].y * inv * gg.y) | ((unsigned long long)pk2(v[j].z * inv * gg.z, v[j].w * inv * gg.w) << 32); }
}
__device__ __forceinline__ void p0_prologue(Frame& F) {
    LAS float* scr = (LAS float*)(F.lds + RING_OFF + F.wave * 16384);
    constexpr int I_IN = (D / 64) * (NPROJ / 32);
    constexpr int I_OUT = (D / 64) * (D / 32);
    constexpr int I_G1 = (D / 64) * (DFF / 32);
    constexpr int I_D1 = (DFF / 64) * (D / 32);
    constexpr int NITEMS = I_IN + I_OUT + NE * (2 * I_G1 + I_D1);
    for (int it = F.gw; it < NITEMS; it += F.NGW) {
        int r = it;
        if (r < I_IN) { const int kb = r / (NPROJ / 32), nb = r % (NPROJ / 32); p0_transpose_item(F.w_in, DIN, D, 64 * kb, 32 * nb, F.WinT, (size_t)32 * nb, scr, F.lane); continue; } r -= I_IN;
        if (r < I_OUT) { const int kb = r / (D / 32), nb = r % (D / 32); p0_transpose_item(F.w_out, D, D, 64 * kb, 32 * nb, F.WoutT, (size_t)32 * nb, scr, F.lane); continue; } r -= I_OUT;
        const int e = r / (2 * I_G1 + I_D1); r -= e * (2 * I_G1 + I_D1);
        if (r < 2 * I_G1) { const int up = r / I_G1; r -= up * I_G1; const int kb = r / (DFF / 32), nb = r % (DFF / 32); const int n0 = 32 * nb;
            const float* W = (up ? F.ew_up : F.ew_gate) + (size_t)e * D * DFF;
            const size_t drow = (size_t)e * 1024 + (size_t)(n0 / 128) * 256 + (n0 % 128) + (up ? 128 : 0);
            p0_transpose_item(W, DFF, D, 64 * kb, n0, F.WguT, drow, scr, F.lane); continue; }
        r -= 2 * I_G1;
        { const int kb = r / (D / 32), nb = r % (D / 32);
          p0_transpose_item(F.ew_down + (size_t)e * DFF * D, D, DFF, 64 * kb, 32 * nb, F.WdT, (size_t)e * 1024 + 32 * nb, scr, F.lane); }
    }
    { const int gt = F.gw * 64 + F.lane, NGT = F.NGW * 64;
      for (int i = gt; i < GRANK * D; i += NGT) { const int j = i / D, k = i % D; F.WinT[(size_t)(NPROJ + j) * D + k] = (bf16)f2bf(F.w_in[(size_t)k * DIN + NPROJ + j]); } }
    { const int gt = F.gw * 64 + F.lane, NGT = F.NGW * 64;
      for (int i = gt; i < 64 * D; i += NGT) { const int j = i / D, k = i % D;
          const float w = j < NE ? F.w_expert[(size_t)k * NE + j] : (j < NE + NGRP ? F.w_group[(size_t)k * NGRP + (j - NE)] : 0.f);
          F.WrT[i] = w * F.ln2_g[k]; } }
    for (int m = F.gw; m < T; m += F.NGW) rms_row_to_bf16(F.lane, F.x + (size_t)m * D, F.ln1_g, F.XN + (size_t)m * D);
}

__device__ __forceinline__ f32x16 tile32(const bf16* pa, const bf16* pb, int K, int h) {
    f32x16 acc;
#pragma unroll
    for (int i = 0; i < 16; ++i) acc[i] = 0.f;
    const bf16x8* a8 = (const bf16x8*)(pa + 8 * h); const bf16x8* b8 = (const bf16x8*)(pb + 8 * h);
#pragma unroll 4
    for (int k = 0; k < K / 16; ++k) acc = __builtin_amdgcn_mfma_f32_32x32x16_bf16(a8[2 * k], b8[2 * k], acc, 0, 0, 0);
    return acc;
}

__device__ __forceinline__ void p1_proj_base(Frame& F) {
    const int r = F.lane & 31, h = F.lane >> 5;
    constexpr int NT = NPROJ / 32, MT = T / 32;
    for (int it = F.gw; it < MT * NT; it += F.NGW) {
        const int mt = it / NT, nt = it % NT;
        const f32x16 acc = tile32(F.XN + (size_t)(mt * 32 + r) * D, F.WinT + (size_t)(nt * 32 + r) * D, D, h);
        const int col = nt * 32 + r;
        const float sc = col < COL_SBK ? SBQ_SCALE : ((col >= COL_GQ && col < COL_GK) ? GQ_SCALE : 1.0f);
#pragma unroll
        for (int i = 0; i < 16; ++i) F.PROJ[(size_t)(mt * 32 + crow(i, h)) * NPROJ + col] = (bf16)f2bf(acc[i] * sc);
    }
}
__device__ __forceinline__ void p1_glr(Frame& F) {
    const int gt = F.gw * 64 + F.lane, NGT = F.NGW * 64;
    for (int i = gt; i < T * GRANK; i += NGT) { const int t = i / GRANK, j = i % GRANK;
        const v4u* a = (const v4u*)(F.XN + (size_t)t * D); const v4u* b = (const v4u*)(F.WinT + (size_t)(NPROJ + j) * D);
        float s = 0.f;
        for (int k = 0; k < D / 8; ++k) { const v4u av = a[k], bv = b[k];
            s += bflo(av.x) * bflo(bv.x) + bfhi(av.x) * bfhi(bv.x) + bflo(av.y) * bflo(bv.y) + bfhi(av.y) * bfhi(bv.y)
               + bflo(av.z) * bflo(bv.z) + bfhi(av.z) * bfhi(bv.z) + bflo(av.w) * bflo(bv.w) + bfhi(av.w) * bfhi(bv.w); }
        F.GLR[i] = s; }
}

__device__ __forceinline__ void p2_loga(Frame& F) {
    const int gt = F.gw * 64 + F.lane, NGT = F.NGW * 64;
    for (int i = gt; i < T * 256; i += NGT) { const int t = i >> 8, c = i & 255;
        float s = F.gate_b[c];
#pragma unroll
        for (int j = 0; j < GRANK; ++j) s += F.GLR[t * GRANK + j] * F.gate_w2[j * 256 + c];
        const float ls = fminf(s, 0.f) - log1pf(expf(-fabsf(s)));
        F.LOGA[i] = ls * (1.0f / 16.0f); }
}
__device__ __forceinline__ void p2_sb_base(Frame& F) {
    for (int it = F.gw; it < BATCH * SBH * (SEQ / 64); it += F.NGW) {
        const int qb = it % (SEQ / 64), h = (it / (SEQ / 64)) % SBH, b = it / ((SEQ / 64) * SBH);
        const int t = qb * 64 + F.lane; const size_t row = (size_t)b * SEQ + t;
        float q[64], o[64];
        { const v4u* qp = (const v4u*)(F.PROJ + row * NPROJ + COL_SBQ + h * 64);
#pragma unroll
          for (int j = 0; j < 8; ++j) { const v4u w = qp[j]; q[8 * j] = bflo(w.x); q[8 * j + 1] = bfhi(w.x); q[8 * j + 2] = bflo(w.y); q[8 * j + 3] = bfhi(w.y);
              q[8 * j + 4] = bflo(w.z); q[8 * j + 5] = bfhi(w.z); q[8 * j + 6] = bflo(w.w); q[8 * j + 7] = bfhi(w.w); } }
#pragma unroll
        for (int d = 0; d < 64; ++d) o[d] = 0.f;
        float R = 0.f;
        int zero = 0; asm volatile("" : "+v"(zero));
        for (int s = qb * 64 + 62; s >= 0; --s) {
            const bf16* kv = F.PROJ + ((size_t)b * SEQ + s) * NPROJ + h * 64 + zero;
            const v4u* kp = (const v4u*)(kv + COL_SBK); const v4u* vp = (const v4u*)(kv + COL_SBV);
            float z = 0.f;
#pragma unroll
            for (int j = 0; j < 8; ++j) { const v4u w = kp[j];
                z += q[8 * j] * bflo(w.x) + q[8 * j + 1] * bfhi(w.x) + q[8 * j + 2] * bflo(w.y) + q[8 * j + 3] * bfhi(w.y)
                   + q[8 * j + 4] * bflo(w.z) + q[8 * j + 5] * bfhi(w.z) + q[8 * j + 6] * bflo(w.w) + q[8 * j + 7] * bfhi(w.w); }
            const float lb = fminf(z, 0.f) - __log2f(1.0f + exp2f(-fabsf(z)));
            const float wgt = (s < t) ? exp2f(lb + R) : 0.f;
            if (s < t) R += lb - z;
#pragma unroll
            for (int j = 0; j < 8; ++j) { const v4u w = vp[j];
                o[8 * j] += wgt * bflo(w.x); o[8 * j + 1] += wgt * bfhi(w.x); o[8 * j + 2] += wgt * bflo(w.y); o[8 * j + 3] += wgt * bfhi(w.y);
                o[8 * j + 4] += wgt * bflo(w.z); o[8 * j + 5] += wgt * bfhi(w.z); o[8 * j + 6] += wgt * bflo(w.w); o[8 * j + 7] += wgt * bfhi(w.w); }
        }
        v4u* op = (v4u*)(F.OMIX + row * D + h * 64);
#pragma unroll
        for (int j = 0; j < 8; ++j) { v4u w; w.x = pk2(o[8 * j], o[8 * j + 1]); w.y = pk2(o[8 * j + 2], o[8 * j + 3]); w.z = pk2(o[8 * j + 4], o[8 * j + 5]); w.w = pk2(o[8 * j + 6], o[8 * j + 7]); op[j] = w; }
    }
}

typedef short s16x4 __attribute__((ext_vector_type(4)));
typedef short v4i16_t __attribute__((ext_vector_type(4)));
typedef float f32x2_t __attribute__((ext_vector_type(2))); typedef __bf16 bf16x2_t __attribute__((ext_vector_type(2)));
__device__ __forceinline__ unsigned cvtpk_s(float lo, float hi) { f32x2_t v = {lo, hi}; bf16x2_t b = __builtin_convertvector(v, bf16x2_t); return __builtin_bit_cast(unsigned, b); }
__device__ __forceinline__ s16x4 vtr(const LAS char* p) { return __builtin_bit_cast(s16x4, __builtin_amdgcn_ds_read_tr16_b64_v4i16((LAS v4i16_t*)p)); }
__device__ __forceinline__ bf16x8 pack8(const float* x) { v4u p; p.x = cvtpk_s(x[0], x[1]); p.y = cvtpk_s(x[2], x[3]); p.z = cvtpk_s(x[4], x[5]); p.w = cvtpk_s(x[6], x[7]); return __builtin_bit_cast(bf16x8, p); }
constexpr float SB_STOP = -152.0f;
__device__ __forceinline__ void p2_sb_fast(Frame& F) {
    const int lane = F.lane, r = lane & 31, hh = lane >> 5;
    LAS char* vl = (LAS char*)(F.lds + RING_OFF + F.wave * 16384);
    const LAS char* vbase = vl + (4 * hh + ((lane & 15) >> 2)) * 64 + ((lane >> 4) & 1) * 32 + (lane & 3) * 8;
    bf16x8 U0, U1;
#pragma unroll
    for (int j = 0; j < 8; ++j) { const int k0 = 8 * (j >> 2) + 4 * hh + (j & 3); U0[j] = (k0 > r) ? (short)0x3F80 : (short)0; U1[j] = (16 + k0 > r) ? (short)0x3F80 : (short)0; }
    constexpr int NQB = SEQ / 32;
    for (int unit = F.gw; unit < BATCH * SBH * NQB; unit += F.NGW) {
        const int qb = unit % NQB, head = (unit / NQB) % SBH, b = unit / (NQB * SBH);
        const size_t rowbase = (size_t)b * SEQ; const int t0 = qb * 32;
        bf16x8 qf[4];
        { const bf16* Qp = F.PROJ + (rowbase + t0 + r) * NPROJ + COL_SBQ + head * 64 + 8 * hh;
#pragma unroll
          for (int ks = 0; ks < 4; ++ks) qf[ks] = *(const bf16x8*)(Qp + 16 * ks); }
        f32x16 O0, O1;
#pragma unroll
        for (int i = 0; i < 16; ++i) { O0[i] = 0.f; O1[i] = 0.f; }
        float R = 0.f;
        for (int kt = qb; kt >= 0; --kt) {
            const int s0 = kt * 32; const bool diag = (kt == qb);
            bf16x8 kf[4];
            { const bf16* Kp = F.PROJ + (rowbase + s0 + r) * NPROJ + COL_SBK + head * 64 + 8 * hh;
#pragma unroll
              for (int ks = 0; ks < 4; ++ks) kf[ks] = *(const bf16x8*)(Kp + 16 * ks); }
#pragma unroll
            for (int i = 0; i < 4; ++i) { const int c = i * 64 + lane, key = c >> 3, dch = c & 7;
                const v4u val = *(const v4u*)(F.PROJ + (rowbase + s0 + key) * NPROJ + COL_SBV + head * 64 + 8 * dch);
                *(LAS v4u*)(vl + ((key >> 3) * 2 + (dch >> 2)) * 512 + (key & 7) * 64 + (dch & 3) * 16) = val; }
            f32x16 S;
#pragma unroll
            for (int i = 0; i < 16; ++i) S[i] = 0.f;
#pragma unroll
            for (int ks = 0; ks < 4; ++ks) S = __builtin_amdgcn_mfma_f32_32x32x16_bf16(kf[ks], qf[ks], S, 0, 0, 0);
            float lom[16]; f32x16 C; float rs = 0.f;
#pragma unroll
            for (int i = 0; i < 16; ++i) { const float z = S[i];
                const float l = __builtin_amdgcn_logf(1.0f + __builtin_amdgcn_exp2f(-fabsf(z)));
                const float lbv = fminf(z, 0.f) - l; float lm = lbv - z;
                if (diag && !(crow(i, hh) < r)) lm = 0.f;
                lom[i] = lm; rs += lm; C[i] = lbv + R; }
            rs += __shfl_xor(rs, 32);
            const bf16x8 pb0 = pack8(lom), pb1 = pack8(lom + 8);
            C = __builtin_amdgcn_mfma_f32_32x32x16_bf16(U0, pb0, C, 0, 0, 0);
            C = __builtin_amdgcn_mfma_f32_32x32x16_bf16(U1, pb1, C, 0, 0, 0);
            float w[16];
#pragma unroll
            for (int i = 0; i < 16; ++i) { float wv = __builtin_amdgcn_exp2f(C[i]); if (diag && !(crow(i, hh) < r)) wv = 0.f; w[i] = wv; }
            const bf16x8 pa0 = pack8(w), pa1 = pack8(w + 8);
#pragma unroll
            for (int nb = 0; nb < 2; ++nb) {
                const s16x4 l0 = vtr(vbase + (0 * 2 + nb) * 512), h0 = vtr(vbase + (1 * 2 + nb) * 512), l1 = vtr(vbase + (2 * 2 + nb) * 512), h1 = vtr(vbase + (3 * 2 + nb) * 512);
                const bf16x8 v0 = (bf16x8){l0[0], l0[1], l0[2], l0[3], h0[0], h0[1], h0[2], h0[3]}, v1 = (bf16x8){l1[0], l1[1], l1[2], l1[3], h1[0], h1[1], h1[2], h1[3]};
                if (nb == 0) { O0 = __builtin_amdgcn_mfma_f32_32x32x16_bf16(pa0, v0, O0, 0, 0, 0); O0 = __builtin_amdgcn_mfma_f32_32x32x16_bf16(pa1, v1, O0, 0, 0, 0); }
                else { O1 = __builtin_amdgcn_mfma_f32_32x32x16_bf16(pa0, v0, O1, 0, 0, 0); O1 = __builtin_amdgcn_mfma_f32_32x32x16_bf16(pa1, v1, O1, 0, 0, 0); }
            }
            R += rs;
            if (__all(R < SB_STOP)) break;
        }
        bf16* Op = F.OMIX + (rowbase + t0) * D + head * 64 + r;
#pragma unroll
        for (int i = 0; i < 16; ++i) { const int tr = crow(i, hh); Op[(size_t)tr * D] = (bf16)f2bf(O0[i]); Op[(size_t)tr * D + 32] = (bf16)f2bf(O1[i]); }
    }
}


typedef float f32x4v __attribute__((ext_vector_type(4)));
__device__ __forceinline__ void p1_loga(Frame& F) {
    const int lane = F.lane, rw = lane & 15, kq = lane >> 4;
    LAS float* gl = (LAS float*)(F.lds + RING_OFF + F.wave * 16384);
    const int uw = F.wave * F.G + F.vcu, NU = F.G * NWAVES;
    if (uw >= T / 16) return;
    f32x4 w2r[GRANK]; const f32x4 bias = *(const f32x4*)(F.gate_b + 4 * lane);
#pragma unroll
    for (int j = 0; j < GRANK; ++j) w2r[j] = *(const f32x4*)(F.gate_w2 + j * 256 + 4 * lane);
    for (int unit = uw; unit < T / 16; unit += NU) {
        const int t0 = unit * 16;
        const bf16* ap = F.XN + (size_t)(t0 + rw) * D + 8 * kq; const bf16* bp = F.WinT + (size_t)(NPROJ + rw) * D + 8 * kq;
        f32x4 acc = {0.f, 0.f, 0.f, 0.f};
#pragma unroll 8
        for (int ks = 0; ks < D / 32; ++ks) acc = __builtin_amdgcn_mfma_f32_16x16x32_bf16(*(const bf16x8*)(ap + 32 * ks), *(const bf16x8*)(bp + 32 * ks), acc, 0, 0, 0);
#pragma unroll
        for (int q = 0; q < 4; ++q) gl[(4 * kq + q) * 16 + rw] = acc[q];
        asm volatile("" ::: "memory");
#pragma unroll 4
        for (int tk = 0; tk < 16; ++tk) {
            const LAS f32x4* gp = (const LAS f32x4*)(gl + tk * 16);
            f32x4 a = bias;
#pragma unroll
            for (int j4 = 0; j4 < 4; ++j4) { const f32x4 g4 = gp[j4];
#pragma unroll
                for (int q = 0; q < 4; ++q) a += w2r[4 * j4 + q] * g4[q]; }
            f32x4 o;
#pragma unroll
            for (int q = 0; q < 4; ++q) { const float sv = a[q]; o[q] = (fminf(sv, 0.f) - __logf(1.0f + __expf(-fabsf(sv)))) * (1.0f / 16.0f); }
            *(f32x4*)(F.LOGA + (size_t)(t0 + tk) * 256 + 4 * lane) = o;
        }
        asm volatile("" ::: "memory");
    }
}
__device__ __forceinline__ bf16x8 tr_frag(const LAS char* img, int ncb, int ra, int rb, int cb, int lane) {
    const int q = (lane & 15) >> 2, p = lane & 3, g16 = (lane >> 4) & 1;
    const s16x4 lo = vtr(img + ((ra >> 3) * ncb + cb) * 512 + ((ra & 7) + q) * 64 + g16 * 32 + p * 8);
    const s16x4 hi = vtr(img + ((rb >> 3) * ncb + cb) * 512 + ((rb & 7) + q) * 64 + g16 * 32 + p * 8);
    return (bf16x8){lo[0], lo[1], lo[2], lo[3], hi[0], hi[1], hi[2], hi[3]};
}
__device__ __forceinline__ void gla_pass_a(Frame& F) {
    const int lane = F.lane, r = lane & 31, hh = lane >> 5;
    LAS char* KD = (LAS char*)(F.lds + RING_OFF + F.wave * 16384); LAS char* VV = KD + 8192;
    for (int unit = F.gw; unit < BATCH * GH * 64 * 2; unit += F.NGW) {
        const int vhalf = unit & 1, c = (unit >> 1) & 63, bh = unit >> 7, b = bh >> 2, h = bh & 3;
        const size_t row0 = (size_t)b * SEQ + c * 64;
        float g[64]; float total = 0.f;
#pragma unroll
        for (int t = 0; t < 64; ++t) { g[t] = F.LOGA[(row0 + t) * 256 + h * 64 + lane]; total += g[t]; }
        if (vhalf == 0) F.DEC[(bh * 64 + c) * 64 + lane] = __expf(total);
        float run = 0.f;
#pragma unroll
        for (int t = 0; t < 64; ++t) { run += g[t];
            const float kd = bf2f(F.PROJ[(row0 + t) * NPROJ + COL_GK + h * 64 + lane]) * __expf(total - run);
            *(LAS bf16*)(KD + ((t >> 3) * 2 + (lane >> 5)) * 512 + (t & 7) * 64 + (lane & 31) * 2) = (bf16)f2bf(kd); }
#pragma unroll
        for (int i = 0; i < 8; ++i) { const int ch = i * 64 + lane, t = ch >> 3, cc = ch & 7;
            const v4u val = *(const v4u*)(F.PROJ + (row0 + t) * NPROJ + COL_GV + h * 128 + vhalf * 64 + cc * 8);
            *(LAS v4u*)(VV + ((t >> 3) * 2 + (cc >> 2)) * 512 + (t & 7) * 64 + (cc & 3) * 16) = val; }
        asm volatile("" ::: "memory");
        f32x16 acc[2][2];
#pragma unroll
        for (int a = 0; a < 2; ++a)
#pragma unroll
            for (int bb = 0; bb < 2; ++bb)
#pragma unroll
                for (int i = 0; i < 16; ++i) acc[a][bb][i] = 0.f;
#pragma unroll
        for (int ks = 0; ks < 4; ++ks) { const int ra = 16 * ks + 8 * hh, rb = ra + 4;
            const bf16x8 a0 = tr_frag(VV, 2, ra, rb, 0, lane), a1 = tr_frag(VV, 2, ra, rb, 1, lane);
            const bf16x8 b0 = tr_frag(KD, 2, ra, rb, 0, lane), b1 = tr_frag(KD, 2, ra, rb, 1, lane);
            acc[0][0] = __builtin_amdgcn_mfma_f32_32x32x16_bf16(a0, b0, acc[0][0], 0, 0, 0); acc[0][1] = __builtin_amdgcn_mfma_f32_32x32x16_bf16(a0, b1, acc[0][1], 0, 0, 0);
            acc[1][0] = __builtin_amdgcn_mfma_f32_32x32x16_bf16(a1, b0, acc[1][0], 0, 0, 0); acc[1][1] = __builtin_amdgcn_mfma_f32_32x32x16_bf16(a1, b1, acc[1][1], 0, 0, 0); }
        float* dsp = F.DS + ((size_t)(bh * 64 + c) * 128 + 64 * vhalf) * 64 + r;
#pragma unroll
        for (int vb = 0; vb < 2; ++vb)
#pragma unroll
            for (int kb = 0; kb < 2; ++kb)
#pragma unroll
                for (int i = 0; i < 16; ++i) dsp[(size_t)(32 * vb + crow(i, hh)) * 64 + 32 * kb] = acc[vb][kb][i];
        asm volatile("" ::: "memory");
    }
}
__device__ __forceinline__ void gla_pass_b(Frame& F) {
    const int gt = F.gw * 64 + F.lane, NGT = F.NGW * 64;
    for (int e = gt; e < BATCH * GH * 8192; e += NGT) {
        const int bh = e >> 13, rem = e & 8191, k = rem & 63;
        float S = 0.f;
#pragma unroll 8
        for (int c = 0; c < 64; ++c) { const size_t o = ((size_t)(bh * 64 + c) << 13) + rem;
            F.ST[o] = (bf16)f2bf(S); S = F.DEC[(bh * 64 + c) * 64 + k] * S + F.DS[o]; }
    }
}
__device__ __forceinline__ void gla_pass_c(Frame& F) {
    const int lane = F.lane, r = lane & 31, hh = lane >> 5;
    LAS char* KT = (LAS char*)(F.lds + RING_OFF + F.wave * 16384); LAS char* QT = KT + 8192; LAS char* VV = KT + 12288;
    for (int unit = F.gw; unit < BATCH * GH * 64 * 2; unit += F.NGW) {
        const int thalf = unit & 1, c = (unit >> 1) & 63, bh = unit >> 7, b = bh >> 2, h = bh & 3;
        const size_t row0 = (size_t)b * SEQ + c * 64;
        float run = 0.f;
        for (int tb = 0; tb <= thalf; ++tb) {
#pragma unroll
            for (int tt = 0; tt < 32; ++tt) { const int t = 32 * tb + tt;
                run += F.LOGA[(row0 + t) * 256 + h * 64 + lane];
                const float kt = bf2f(F.PROJ[(row0 + t) * NPROJ + COL_GK + h * 64 + lane]) * __expf(-run);
                *(LAS bf16*)(KT + t * 128 + ((lane * 2) ^ ((t & 7) << 4))) = (bf16)f2bf(kt);
                if (tb == thalf) { const float qt = bf2f(F.PROJ[(row0 + t) * NPROJ + COL_GQ + h * 64 + lane]) * __expf(run);
                    *(LAS bf16*)(QT + tt * 128 + ((lane * 2) ^ ((tt & 7) << 4))) = (bf16)f2bf(qt); } }
        }
        asm volatile("" ::: "memory");
        bf16x8 qf[4];
#pragma unroll
        for (int ks = 0; ks < 4; ++ks) qf[ks] = *(const LAS bf16x8*)(QT + r * 128 + ((32 * ks + 16 * hh) ^ ((r & 7) << 4)));
        bf16x8 pa[2][2];
#pragma unroll
        for (int sb = 0; sb < 2; ++sb) {
            if (sb <= thalf) {
                f32x16 P;
#pragma unroll
                for (int i = 0; i < 16; ++i) P[i] = 0.f;
                const int srow = 32 * sb + r;
#pragma unroll
                for (int ks = 0; ks < 4; ++ks) { const bf16x8 kf = *(const LAS bf16x8*)(KT + srow * 128 + ((32 * ks + 16 * hh) ^ ((srow & 7) << 4)));
                    P = __builtin_amdgcn_mfma_f32_32x32x16_bf16(kf, qf[ks], P, 0, 0, 0); }
                float pm[16];
#pragma unroll
                for (int i = 0; i < 16; ++i) pm[i] = (32 * sb + crow(i, hh) <= 32 * thalf + r) ? P[i] : 0.f;
                pa[sb][0] = pack8(pm); pa[sb][1] = pack8(pm + 8);
            } else { pa[sb][0] = (bf16x8){0, 0, 0, 0, 0, 0, 0, 0}; pa[sb][1] = pa[sb][0]; }
        }
        f32x16 o[4];
#pragma unroll
        for (int vb = 0; vb < 4; ++vb) {
#pragma unroll
            for (int i = 0; i < 16; ++i) o[vb][i] = 0.f;
#pragma unroll
            for (int i = 0; i < 4; ++i) { const int ch = i * 64 + lane, sidx = ch >> 2, cc = ch & 3;
                const v4u val = *(const v4u*)(F.PROJ + (row0 + sidx) * NPROJ + COL_GV + h * 128 + 32 * vb + cc * 8);
                *(LAS v4u*)(VV + (sidx >> 3) * 512 + (sidx & 7) * 64 + cc * 16) = val; }
            asm volatile("" ::: "memory");
            const bf16* stp = F.ST + ((size_t)(bh * 64 + c) * 128 + 32 * vb + r) * 64 + 8 * hh;
#pragma unroll
            for (int ks = 0; ks < 4; ++ks) { const bf16x8 sf = *(const bf16x8*)(stp + 16 * ks); o[vb] = __builtin_amdgcn_mfma_f32_32x32x16_bf16(qf[ks], sf, o[vb], 0, 0, 0); }
#pragma unroll
            for (int sb = 0; sb < 2; ++sb) {
                if (sb <= thalf) {
#pragma unroll
                    for (int s2 = 0; s2 < 2; ++s2) { const int ra = 32 * sb + 16 * s2 + 4 * hh, rb = ra + 8;
                        const bf16x8 vf = tr_frag(VV, 1, ra, rb, 0, lane);
                        o[vb] = __builtin_amdgcn_mfma_f32_32x32x16_bf16(pa[sb][s2], vf, o[vb], 0, 0, 0); }
                }
            }
        }
#pragma unroll
        for (int i = 0; i < 16; ++i) {
            float ss = o[0][i] * o[0][i] + o[1][i] * o[1][i] + o[2][i] * o[2][i] + o[3][i] * o[3][i];
            ss += __shfl_xor(ss, 1); ss += __shfl_xor(ss, 2); ss += __shfl_xor(ss, 4); ss += __shfl_xor(ss, 8); ss += __shfl_xor(ss, 16);
            const float inv = 1.0f / sqrtf(ss * (1.0f / GDV) + RMS_EPS);
            const size_t trow = row0 + 32 * thalf + crow(i, hh);
#pragma unroll
            for (int vb = 0; vb < 4; ++vb) { const int col = h * 128 + 32 * vb + r;
                const float gr = bf2f(F.PROJ[trow * NPROJ + COL_GR + col]);
                const float val = o[vb][i] * inv * F.gnorm_g[col] * gr / (1.0f + __expf(-gr));
                F.OMIX[trow * D + 512 + col] = (bf16)f2bf(val); }
        }
        asm volatile("" ::: "memory");
    }
}

__device__ __forceinline__ void p3_gla_base(Frame& F) {
    if (F.gw >= BATCH * GH * 2) return;
    const int b = F.gw / (GH * 2), h = (F.gw / 2) % GH, vc = (F.gw & 1) * 64 + F.lane;
    float S[64];
#pragma unroll
    for (int k = 0; k < 64; ++k) S[k] = 0.f;
    int zero = 0; asm volatile("" : "+v"(zero));
    for (int t = 0; t < SEQ; ++t) {
        const size_t row = (size_t)b * SEQ + t;
        const bf16* pr = F.PROJ + row * NPROJ + zero;
        const float vv = bf2f(pr[COL_GV + h * 128 + vc]);
        const v4u* kp = (const v4u*)(pr + COL_GK + h * 64); const v4u* qp = (const v4u*)(pr + COL_GQ + h * 64);
        const f32x4* lp = (const f32x4*)(F.LOGA + row * 256 + h * 64 + zero);
        float o = 0.f;
#pragma unroll
        for (int j = 0; j < 8; ++j) { const v4u kw = kp[j], qw = qp[j]; const f32x4 l0 = lp[2 * j], l1 = lp[2 * j + 1];
            const float kk[8] = {bflo(kw.x), bfhi(kw.x), bflo(kw.y), bfhi(kw.y), bflo(kw.z), bfhi(kw.z), bflo(kw.w), bfhi(kw.w)};
            const float qq[8] = {bflo(qw.x), bfhi(qw.x), bflo(qw.y), bfhi(qw.y), bflo(qw.z), bfhi(qw.z), bflo(qw.w), bfhi(qw.w)};
            const float ll[8] = {l0.x, l0.y, l0.z, l0.w, l1.x, l1.y, l1.z, l1.w};
#pragma unroll
            for (int i = 0; i < 8; ++i) { const float a = __expf(ll[i]); S[8 * j + i] = a * S[8 * j + i] + kk[i] * vv; o += qq[i] * S[8 * j + i]; } }
        F.OG[row * 512 + h * 128 + vc] = o;
    }
}
__device__ __forceinline__ void p4_gla_out(Frame& F) {
    for (int t = F.gw; t < T; t += F.NGW) {
        const int c0 = F.lane * 8;
        const f32x4* op = (const f32x4*)(F.OG + (size_t)t * 512 + c0); const f32x4 a = op[0], b = op[1];
        float ss = (a.x * a.x + a.y * a.y) + (a.z * a.z + a.w * a.w) + (b.x * b.x + b.y * b.y) + (b.z * b.z + b.w * b.w);
        ss += __shfl_xor(ss, 1); ss += __shfl_xor(ss, 2); ss += __shfl_xor(ss, 4); ss += __shfl_xor(ss, 8);
        const float inv = 1.0f / sqrtf(ss * (1.0f / GDV) + RMS_EPS);
        const f32x4* gp = (const f32x4*)(F.gnorm_g + c0); const f32x4 g0 = gp[0], g1 = gp[1];
        const v4u grw = *(const v4u*)(F.PROJ + (size_t)t * NPROJ + COL_GR + c0);
        const float gr[8] = {bflo(grw.x), bfhi(grw.x), bflo(grw.y), bfhi(grw.y), bflo(grw.z), bfhi(grw.z), bflo(grw.w), bfhi(grw.w)};
        const float ov[8] = {a.x, a.y, a.z, a.w, b.x, b.y, b.z, b.w}; const float gg[8] = {g0.x, g0.y, g0.z, g0.w, g1.x, g1.y, g1.z, g1.w};
        float r[8];
#pragma unroll
        for (int i = 0; i < 8; ++i) { const float sl = gr[i] / (1.0f + __expf(-gr[i])); r[i] = ov[i] * inv * gg[i] * sl; }
        v4u w; w.x = pk2(r[0], r[1]); w.y = pk2(r[2], r[3]); w.z = pk2(r[4], r[5]); w.w = pk2(r[6], r[7]);
        *(v4u*)(F.OMIX + (size_t)t * D + 512 + c0) = w;
    }
}
__device__ __forceinline__ void p5_outproj_base(Frame& F) {
    const int r = F.lane & 31, h = F.lane >> 5;
    constexpr int NT = D / 32, MT = T / 32;
    for (int it = F.gw; it < MT * NT; it += F.NGW) {
        const int mt = it / NT, nt = it % NT;
        const f32x16 acc = tile32(F.OMIX + (size_t)(mt * 32 + r) * D, F.WoutT + (size_t)(nt * 32 + r) * D, D, h);
#pragma unroll
        for (int i = 0; i < 16; ++i) { const size_t idx = (size_t)(mt * 32 + crow(i, h)) * D + nt * 32 + r; F.X1[idx] = F.x[idx] + acc[i]; }
    }
}
__device__ __forceinline__ void p6_route(Frame& F) {
    for (int t = F.gw; t < T; t += F.NGW) {
        const GAS f32x4* xr = (const GAS f32x4*)(F.X1 + (size_t)t * D) + F.lane; const GAS f32x4* gr = (const GAS f32x4*)F.ln2_g + F.lane;
        f32x4 v[4]; float s = 0.f;
#pragma unroll
        for (int j = 0; j < 4; ++j) { v[j] = xr[64 * j]; s += (v[j].x * v[j].x + v[j].y * v[j].y) + (v[j].z * v[j].z + v[j].w * v[j].w); }
        const float inv = 1.0f / sqrtf(wave_sum(s) * (1.f / D) + RMS_EPS);
        GAS unsigned long long* o8 = (GAS unsigned long long*)(F.H2 + (size_t)t * D) + F.lane;
#pragma unroll
        for (int j = 0; j < 4; ++j) { const f32x4 gg = gr[64 * j]; v[j].x = v[j].x * inv * gg.x; v[j].y = v[j].y * inv * gg.y; v[j].z = v[j].z * inv * gg.z; v[j].w = v[j].w * inv * gg.w;
            o8[64 * j] = (unsigned long long)pk2(v[j].x, v[j].y) | ((unsigned long long)pk2(v[j].z, v[j].w) << 32); }
        float lg[NGRP], le[NE];
#pragma unroll
        for (int c = 0; c < NGRP; ++c) lg[c] = 0.f;
#pragma unroll
        for (int c = 0; c < NE; ++c) le[c] = 0.f;
#pragma unroll 1
        for (int jq = 0; jq < 16; ++jq) { const int j = jq >> 2, q = jq & 3;
            const f32x4 vj = j == 0 ? v[0] : (j == 1 ? v[1] : (j == 2 ? v[2] : v[3]));
            const float hv = q == 0 ? vj.x : (q == 1 ? vj.y : (q == 2 ? vj.z : vj.w));
            const int k = 4 * (64 * j + F.lane) + q;
            const f32x4 wg = *(const f32x4*)(F.w_group + (size_t)k * NGRP);
            lg[0] += hv * wg.x; lg[1] += hv * wg.y; lg[2] += hv * wg.z; lg[3] += hv * wg.w;
            const f32x4* we = (const f32x4*)(F.w_expert + (size_t)k * NE);
#pragma unroll
            for (int c4 = 0; c4 < NE / 4; ++c4) { const f32x4 w = we[c4]; le[4 * c4] += hv * w.x; le[4 * c4 + 1] += hv * w.y; le[4 * c4 + 2] += hv * w.z; le[4 * c4 + 3] += hv * w.w; } }
#pragma unroll
        for (int c = 0; c < NGRP; ++c) lg[c] = wave_sum(lg[c]) + F.b_group[c];
#pragma unroll
        for (int c = 0; c < NE; ++c) le[c] = wave_sum(le[c]) + F.b_expert[c];
        int gi = 0; float gm = lg[0];
#pragma unroll
        for (int c = 1; c < NGRP; ++c) if (lg[c] > gm) { gm = lg[c]; gi = c; }
        float gs = 0.f;
#pragma unroll
        for (int c = 0; c < NGRP; ++c) gs += __expf(lg[c] - gm);
        const float gp = 1.0f / gs;
        float sel[EPG];
#pragma unroll
        for (int i = 0; i < EPG; ++i) { sel[i] = le[i];
#pragma unroll
            for (int g = 1; g < NGRP; ++g) sel[i] = (gi == g) ? le[g * EPG + i] : sel[i]; }
        int i1 = 0; float m1 = sel[0];
#pragma unroll
        for (int i = 1; i < EPG; ++i) if (sel[i] > m1) { m1 = sel[i]; i1 = i; }
        int i2 = -1; float m2 = -3.0e38f;
#pragma unroll
        for (int i = 0; i < EPG; ++i) if (i != i1 && sel[i] > m2) { m2 = sel[i]; i2 = i; }
        const float e21 = __expf(m2 - m1); const float w1 = 1.0f / (1.0f + e21), w2 = e21 * w1;
        if (F.lane == 0) {
            const int e1 = gi * EPG + i1, e2 = gi * EPG + i2;
            const int r1 = (int)__hip_atomic_fetch_add(F.cnt + e1, 1u, RLX_AGENT), r2 = (int)__hip_atomic_fetch_add(F.cnt + e2, 1u, RLX_AGENT);
            F.toklist[e1 * CAP + r1] = t; F.toklist[e2 * CAP + r2] = t;
            *(int4*)(F.tokinfo + 8 * t) = make_int4(e1, r1, e2, r2);
            *(int4*)(F.tokinfo + 8 * t + 4) = make_int4(__float_as_int(gp * w1), __float_as_int(gp * w2), 0, 0);
        }
    }
}

typedef float f32x1;
__device__ __forceinline__ void p6_route_fast(Frame& F, unsigned* cntp) {
    const int lane = F.lane, r = lane & 31, hh = lane >> 5;
    const int grp = F.wave >> 2, kq = F.wave & 3;
    LAS float* part = (LAS float*)(F.lds + RING_OFF);
    LAS unsigned* lcnt = (LAS unsigned*)(F.lds + RING_OFF + 49152); LAS unsigned* lbase = lcnt + 32;
    if (F.tid < NE) lcnt[F.tid] = 0u;
    __syncthreads();
    for (int blk0 = F.vcu * 2; blk0 < T / 32; blk0 += F.G * 2) {
        const int blk = blk0 + grp; const bool valid = blk < T / 32;
        const size_t trow = (size_t)(valid ? blk : 0) * 32 + r;
        f32x16 ae, ag;
#pragma unroll
        for (int i = 0; i < 16; ++i) { ae[i] = 0.f; ag[i] = 0.f; }
        float ssq = 0.f;
        const float* xp = F.X1 + trow * D + kq * 256 + 4 * hh;
        const float* bep = F.WrT + (size_t)r * D + kq * 256 + 4 * hh; const float* bgp = F.WrT + (size_t)(32 + r) * D + kq * 256 + 4 * hh;
        f32x4 cx[4], ce[4], cg[4], nx[4], ne_[4], ng[4];
#pragma unroll
        for (int j = 0; j < 4; ++j) { nx[j] = *(const f32x4*)(xp + 8 * j); ne_[j] = *(const f32x4*)(bep + 8 * j); ng[j] = *(const f32x4*)(bgp + 8 * j); }
#pragma unroll 1
        for (int mg = 0; mg < 8; ++mg) {
#pragma unroll
            for (int j = 0; j < 4; ++j) { cx[j] = nx[j]; ce[j] = ne_[j]; cg[j] = ng[j]; }
            const int mn = (mg < 7 ? mg + 1 : mg) * 32;
#pragma unroll
            for (int j = 0; j < 4; ++j) { nx[j] = *(const f32x4*)(xp + mn + 8 * j); ne_[j] = *(const f32x4*)(bep + mn + 8 * j); ng[j] = *(const f32x4*)(bgp + mn + 8 * j); }
#pragma unroll
            for (int j = 0; j < 4; ++j) { const f32x4 xv = cx[j];
                ssq += (xv.x * xv.x + xv.y * xv.y) + (xv.z * xv.z + xv.w * xv.w);
#pragma unroll
                for (int q = 0; q < 4; ++q) { ae = __builtin_amdgcn_mfma_f32_32x32x2f32(xv[q], ce[j][q], ae, 0, 0, 0); ag = __builtin_amdgcn_mfma_f32_32x32x2f32(xv[q], cg[j][q], ag, 0, 0, 0); } }
        }
        ssq += __shfl_xor(ssq, 32);
        LAS float* pe = part + (size_t)((grp * 4 + kq) * 32) * 40;
#pragma unroll
        for (int i = 0; i < 16; ++i) { const int tk = crow(i, hh); pe[tk * 40 + r] = ae[i]; if (r < NGRP) pe[tk * 40 + 32 + r] = ag[i]; }
        if (hh == 0) pe[r * 40 + 36] = ssq;
        __syncthreads();
        const bool router = (kq == 0 && lane < 32 && valid);
        int e1 = 0, e2 = 0, lr1 = 0, lr2 = 0; float gt1 = 0.f, gt2 = 0.f, tinv = 0.f;
        if (router) {
            const LAS float* p0 = part + (size_t)(grp * 4 * 32 + lane) * 40;
            const float ss = (p0[36] + p0[1280 + 36]) + (p0[2560 + 36] + p0[3840 + 36]);
            const float inv = 1.0f / sqrtf(ss * (1.f / D) + RMS_EPS);
            float lg[NGRP];
#pragma unroll
            for (int c = 0; c < NGRP; ++c) lg[c] = ((p0[32 + c] + p0[1280 + 32 + c]) + (p0[2560 + 32 + c] + p0[3840 + 32 + c])) * inv + F.b_group[c];
            int gi = 0; float gm = lg[0];
#pragma unroll
            for (int c = 1; c < NGRP; ++c) if (lg[c] > gm) { gm = lg[c]; gi = c; }
            float gs = 0.f;
#pragma unroll
            for (int c = 0; c < NGRP; ++c) gs += __expf(lg[c] - gm);
            const float gp = 1.0f / gs;
            float sel[EPG];
#pragma unroll
            for (int i = 0; i < EPG; ++i) { const int c = gi * EPG + i; sel[i] = ((p0[c] + p0[1280 + c]) + (p0[2560 + c] + p0[3840 + c])) * inv + F.b_expert[c]; }
            int i1 = 0; float m1 = sel[0];
#pragma unroll
            for (int i = 1; i < EPG; ++i) if (sel[i] > m1) { m1 = sel[i]; i1 = i; }
            int i2 = -1; float m2 = -3.0e38f;
#pragma unroll
            for (int i = 0; i < EPG; ++i) if (i != i1 && sel[i] > m2) { m2 = sel[i]; i2 = i; }
            const float e21 = __expf(m2 - m1); const float w1 = 1.0f / (1.0f + e21), w2 = e21 * w1;
            e1 = gi * EPG + i1; e2 = gi * EPG + i2; gt1 = gp * w1; gt2 = gp * w2; tinv = inv;
            lr1 = (int)__hip_atomic_fetch_add(lcnt + e1, 1u, __ATOMIC_RELAXED, __HIP_MEMORY_SCOPE_WORKGROUP); lr2 = (int)__hip_atomic_fetch_add(lcnt + e2, 1u, __ATOMIC_RELAXED, __HIP_MEMORY_SCOPE_WORKGROUP);
        }
        __syncthreads();
        if (F.tid < NE) { const unsigned n = lcnt[F.tid]; if (n) lbase[F.tid] = __hip_atomic_fetch_add(cntp + CNT_STRIDE * F.tid, n, RLX_AGENT); }
        __syncthreads();
        if (router) {
            const int t = blk * 32 + lane; const int r1 = (int)lbase[e1] + lr1, r2 = (int)lbase[e2] + lr2;
            F.toklist[e1 * CAP + r1] = t; F.toklist[e2 * CAP + r2] = t; F.invlist[e1 * CAP + r1] = tinv; F.invlist[e2 * CAP + r2] = tinv;
            *(int4*)(F.tokinfo + 8 * t) = make_int4(e1, r1, e2, r2);
            *(int4*)(F.tokinfo + 8 * t + 4) = make_int4(__float_as_int(gt1), __float_as_int(gt2), 0, 0);
        }
        __syncthreads();
        if (F.tid < NE) lcnt[F.tid] = 0u;
        __syncthreads();
    }
}

__device__ __forceinline__ void load_emap(Frame& F, int& cnt_l, int& pst_l, int& cend32_l) {
    const int e = F.lane & 31;
    cnt_l = (int)__hip_atomic_load(F.cnt + CNT_STRIDE * e, RLX_AGENT);
    int p = (cnt_l + 255) & ~255, c = (cnt_l + 31) >> 5;
#pragma unroll
    for (int o = 1; o < 32; o <<= 1) { const int pp = __shfl_up(p, o), cc = __shfl_up(c, o); if (e >= o) { p += pp; c += cc; } }
    pst_l = p - ((cnt_l + 255) & ~255); cend32_l = c;
}
__device__ __forceinline__ void p7_gateup_base(Frame& F) {
    const int r = F.lane & 31, h = F.lane >> 5;
    int cnt_l, pst_l, cend_l; load_emap(F, cnt_l, pst_l, cend_l);
    const int total = __shfl(cend_l, 31) * (DFF / 32);
    for (int it = F.gw; it < total; it += F.NGW) {
        const int g = it / (DFF / 32), nt = it % (DFF / 32);
        const int e = __popcll(__ballot(F.lane < 32 && cend_l <= g));
        const int base = e > 0 ? __shfl(cend_l, e - 1) : 0;
        const int mt = g - base; const int n_e = __shfl(cnt_l, e); const int ps = __shfl(pst_l, e);
        const int idx = mt * 32 + r; const int tok = idx < n_e ? F.toklist[e * CAP + idx] : 0;
        const int hc = nt * 32 + r; const size_t brow = (size_t)e * 1024 + (size_t)(hc / 128) * 256 + (hc % 128);
        const f32x16 ag = tile32(F.H2 + (size_t)tok * D, F.WguT + brow * D, D, h);
        const f32x16 au = tile32(F.H2 + (size_t)tok * D, F.WguT + (brow + 128) * D, D, h);
#pragma unroll
        for (int i = 0; i < 16; ++i) { const int rr = mt * 32 + crow(i, h);
            if (rr < n_e) { const float gv = ag[i]; const float hv = gv / (1.0f + __expf(-gv)) * au[i]; F.HBUF[(size_t)(ps + rr) * DFF + hc] = (bf16)f2bf(hv); } }
    }
}
__device__ __forceinline__ void p8_down_base(Frame& F) {
    const int r = F.lane & 31, h = F.lane >> 5;
    int cnt_l, pst_l, cend_l; load_emap(F, cnt_l, pst_l, cend_l);
    const int total = __shfl(cend_l, 31) * (D / 32);
    for (int it = F.gw; it < total; it += F.NGW) {
        const int g = it / (D / 32), nt = it % (D / 32);
        const int e = __popcll(__ballot(F.lane < 32 && cend_l <= g));
        const int base = e > 0 ? __shfl(cend_l, e - 1) : 0;
        const int mt = g - base; const int n_e = __shfl(cnt_l, e); const int ps = __shfl(pst_l, e);
        int idx = mt * 32 + r; if (idx >= n_e) idx = n_e - 1;
        const f32x16 acc = tile32(F.HBUF + (size_t)(ps + idx) * DFF, F.WdT + ((size_t)e * 1024 + nt * 32 + r) * DFF, DFF, h);
#pragma unroll
        for (int i = 0; i < 16; ++i) { const int rr = mt * 32 + crow(i, h);
            if (rr < n_e) F.Y[(size_t)(ps + rr) * D + nt * 32 + r] = (bf16)f2bf(acc[i]); }
    }
}
__device__ __forceinline__ void p9_final(Frame& F, const bool do_store) {
    const int lane = F.lane;
    int cnt_l, pst_l, cend_l; load_emap(F, cnt_l, pst_l, cend_l);
    const int nrow = (T - F.gw + F.NGW - 1) / F.NGW;
    for (int i0 = 0; i0 < nrow; i0 += 32) {
        int4 ti = make_int4(0, 0, 0, 0), tg = make_int4(0, 0, 0, 0);
        { const int i = i0 + (lane & 31); if (i < nrow) { const int t = F.gw + i * F.NGW; ti = *(const int4*)(F.tokinfo + 8 * t); tg = *(const int4*)(F.tokinfo + 8 * t + 4); } }
        const int s1l = __shfl(pst_l, ti.x) + ti.y, s2l = __shfl(pst_l, ti.z) + ti.w;
        const int nloc = (nrow - i0) < 32 ? (nrow - i0) : 32;
        for (int ii = 0; ii < nloc; ii += 2) {
            const bool two = (ii + 1) < nloc;
            f32x4 v[2][4]; v2u ya[2][4], yb[2][4]; float g1[2], g2[2]; GAS f32x4* xr[2];
#pragma unroll
            for (int u = 0; u < 2; ++u) { const int iu = (u == 1 && !two) ? ii : ii + u;
                const int t = F.gw + (i0 + iu) * F.NGW;
                const int s1 = __shfl(s1l, iu), s2 = __shfl(s2l, iu); g1[u] = __int_as_float(__shfl(tg.x, iu)); g2[u] = __int_as_float(__shfl(tg.y, iu));
                xr[u] = (GAS f32x4*)(F.X1 + (size_t)t * D) + lane;
                const GAS v2u* y1 = (const GAS v2u*)(F.Y + (size_t)s1 * D) + lane; const GAS v2u* y2 = (const GAS v2u*)(F.Y + (size_t)s2 * D) + lane;
#pragma unroll
                for (int j = 0; j < 4; ++j) { v[u][j] = xr[u][64 * j]; ya[u][j] = y1[64 * j]; yb[u][j] = y2[64 * j]; } }
#pragma unroll
            for (int u = 0; u < 2; ++u) {
                if (u == 1 && !two) break;
                float s = 0.f;
#pragma unroll
                for (int j = 0; j < 4; ++j) { const v2u a = ya[u][j], b = yb[u][j];
                    v[u][j].x += g1[u] * bflo(a.x) + g2[u] * bflo(b.x); v[u][j].y += g1[u] * bfhi(a.x) + g2[u] * bfhi(b.x); v[u][j].z += g1[u] * bflo(a.y) + g2[u] * bflo(b.y); v[u][j].w += g1[u] * bfhi(a.y) + g2[u] * bfhi(b.y);
                    s += (v[u][j].x * v[u][j].x + v[u][j].y * v[u][j].y) + (v[u][j].z * v[u][j].z + v[u][j].w * v[u][j].w); }
                const float inv = 1.0f / sqrtf(wave_sum(s) * (1.f / D) + RMS_EPS);
                const GAS f32x4* gr = (const GAS f32x4*)F.lnf_g + lane;
#pragma unroll
                for (int j = 0; j < 4; ++j) { const f32x4 gg = gr[64 * j]; f32x4 o; o.x = v[u][j].x * inv * gg.x; o.y = v[u][j].y * inv * gg.y; o.z = v[u][j].z * inv * gg.z; o.w = v[u][j].w * inv * gg.w; if (do_store) xr[u][64 * j] = o; else asm volatile("" :: "v"(o.x), "v"(o.y), "v"(o.z), "v"(o.w)); }
            }
        }
    }
}

__device__ __forceinline__ void load_emap256(Frame& F, int& cnt_l, int& pst_l, int& cend_l) {
    const int e = F.lane & 31;
    cnt_l = (int)__hip_atomic_load(F.cnt + CNT_STRIDE * e, RLX_AGENT);
    int c = (cnt_l + 255) >> 8;
#pragma unroll
    for (int o = 1; o < 32; o <<= 1) { const int cc = __shfl_up(c, o); if (e >= o) c += cc; }
    cend_l = c; pst_l = (c - ((cnt_l + 255) >> 8)) * 256;
}
__device__ __forceinline__ void p1_proj_pg8(Frame& F) {
    pg8::Gemm g{F.XN, F.WinT, T, NPROJ, D}; pg8::StaticOrder S; S.init(T, NPROJ, F.G, (int)blockIdx.x);
    pg8::EpiProj E{F.PROJ};
    pg8::gemm_phase<pg8::EpiProj, pg8::StaticOrder, true, false>(F.lds + RING_OFF, g, S, E);
}
__device__ __forceinline__ void p5_outproj_pg8(Frame& F) {
    pg8::Gemm g{F.OMIX, F.WoutT, T, D, D}; pg8::StaticOrder S; S.init(T, D, F.G, (int)blockIdx.x);
    pg8::EpiResid E{F.x, F.X1, F.ln2_g, F.H2};
    pg8::gemm_phase<pg8::EpiResid, pg8::StaticOrder, false, false>(F.lds + RING_OFF, g, S, E);
}
constexpr int EMAP_OFF = LDSCTL_OFF + 1024;
__device__ __forceinline__ void moe_order_init(Frame& F, pg8::MoeOrder& S) {
    LAS int* tab = (LAS int*)(F.lds + EMAP_OFF);
    if (F.wave == 0) { int cnt_l, pst_l, cend_l; load_emap256(F, cnt_l, pst_l, cend_l); if (F.lane < 32) { tab[F.lane] = cnt_l; tab[32 + F.lane] = pst_l; tab[64 + F.lane] = cend_l; } }
    __syncthreads();
    S.G = F.G; S.c = (int)blockIdx.x; S.toklist = F.toklist; S.tab = tab; S.MT = __builtin_amdgcn_readfirstlane(tab[64 + 31]); S.nwg = S.MT * 4;
}
__device__ __forceinline__ void p7_gateup_pg8(Frame& F) {
    pg8::MoeOrder S; moe_order_init(F, S);
    pg8::Gemm g{F.H2, F.WguT, 0, 0, D}; pg8::EpiGateUp E{F.HBUF, F.invlist};
    pg8::gemm_phase<pg8::EpiGateUp, pg8::MoeOrder, true, true>(F.lds + RING_OFF, g, S, E);
}
__device__ __forceinline__ void p8_down_pg8(Frame& F) {
    pg8::MoeOrder S; moe_order_init(F, S);
    pg8::Gemm g{F.HBUF, F.WdT, 0, 0, DFF}; pg8::EpiY E{F.Y};
    pg8::gemm_phase<pg8::EpiY, pg8::MoeOrder, true, false>(F.lds + RING_OFF, g, S, E);
}

#ifndef REPEAT_PHASE
#define REPEAT_PHASE -1
#endif
#ifndef USE_GLAFAST
#define USE_GLAFAST 1
#endif
#ifndef USE_SBFAST
#define USE_SBFAST 1
#endif
#ifndef USE_PG8
#define USE_PG8 15
#endif
constexpr int NPHASE = 10;
struct Args { const float* in[16]; float* out; unsigned char* ws; int ph_lo, ph_hi, li, pad; };
__global__ void __launch_bounds__(NWAVES * 64, 2) mk_fwd(Args args) {
    extern __shared__ __attribute__((aligned(16))) unsigned char lds[];
    Frame F;
    F.lds = (LAS unsigned char*)lds;
    F.MISC = (volatile LAS unsigned*)(F.lds + MISC_OFF);
    F.tid = threadIdx.x; F.lane = F.tid & 63; F.wave = __builtin_amdgcn_readfirstlane(F.tid >> 6);
    F.G = gridDim.x; { const int bx = blockIdx.x; F.vcu = (F.G % 8 == 0) ? (bx % 8) * (F.G / 8) + bx / 8 : bx; }
    F.gw = F.vcu * NWAVES + F.wave; F.NGW = F.G * NWAVES;
    unsigned char* ws = args.ws; F.ws = ws;
    F.ctl = (gu32*)(ws + WS_CTL);
    F.x = args.in[0]; F.ln1_g = args.in[1]; F.w_in = args.in[2]; F.gate_w2 = args.in[3]; F.gate_b = args.in[4]; F.gnorm_g = args.in[5]; F.w_out = args.in[6]; F.ln2_g = args.in[7];
    F.w_group = args.in[8]; F.b_group = args.in[9]; F.w_expert = args.in[10]; F.b_expert = args.in[11]; F.ew_gate = args.in[12]; F.ew_up = args.in[13]; F.ew_down = args.in[14]; F.lnf_g = args.in[15];
    F.out = args.out;
    F.WinT = (bf16*)(ws + WS_WIN); F.WoutT = (bf16*)(ws + WS_WOUT); F.WguT = (bf16*)(ws + WS_WGU); F.WdT = (bf16*)(ws + WS_WD);
    F.XN = (bf16*)(ws + WS_R1); F.OMIX = (bf16*)(ws + WS_R1); F.H2 = (bf16*)(ws + WS_R2);
    F.PROJ = (bf16*)(ws + WS_R2); F.HBUF = (bf16*)(ws + WS_R2 + 32 * MiB); F.Y = (bf16*)(ws + WS_Y);
    F.GLR = (float*)(ws + WS_GLR); F.LOGA = (float*)((unsigned char*)args.out + DO_LOGA); F.OG = (float*)((unsigned char*)args.out + DO_OG); F.X1 = args.out; F.DS = F.OG; F.DEC = (float*)(ws + WS_DEC); F.WrT = (float*)(ws + WS_WRT); F.ST = (bf16*)((unsigned char*)args.out + DO_ST);
    F.toklist = (int*)(ws + WS_TOKLIST); F.gatelist = (float*)(ws + WS_GATELIST); F.invlist = (float*)(ws + WS_GATELIST); F.tokinfo = (int*)(ws + WS_TOKINFO); F.cnt = (unsigned*)(ws + WS_CTL) + CW_CNT;
    for (int u = F.tid; u < (LDS_BYTES - LDSCTL_OFF) / 4; u += NWAVES * 64) ((LAS unsigned*)(F.lds + LDSCTL_OFF))[u] = 0u;
    __syncthreads();
    XcdBarrier bar = xcd_barrier_post((unsigned*)(F.ctl + CW_BAR) + args.li * XCD_BAR_WORDS, F.MISC + 8);
    const int lo = args.ph_lo, hi = args.ph_hi;
#define IN(k) (lo <= (k) && (k) < hi)
#define SEAM(k) do { if (IN(k) && IN((k) + 1)) xcd_barrier(bar); } while (0)
#define STEP(code, body) do { body; if (REPEAT_PHASE == (code)) { xcd_barrier(bar); body; } } while (0)
    if (IN(0)) { STEP(0, p0_prologue(F)); } SEAM(0);
    if (IN(1)) { STEP(10, p1_proj_pg8(F)); STEP(11, p1_loga(F)); } SEAM(1);
    if (IN(2)) { STEP(20, p2_sb_fast(F)); STEP(21, gla_pass_a(F)); } SEAM(2);
    if (IN(3)) { STEP(30, gla_pass_b(F)); } SEAM(3);
    if (IN(4)) { STEP(40, gla_pass_c(F)); } SEAM(4);
    if (IN(5)) { STEP(50, p5_outproj_pg8(F)); } SEAM(5);
    if (IN(6)) { if (REPEAT_PHASE == 60) { p6_route_fast(F, F.cnt + 1024); xcd_barrier(bar); } p6_route_fast(F, F.cnt); } SEAM(6);
    if (IN(7)) { STEP(70, p7_gateup_pg8(F)); } SEAM(7);
    if (IN(8)) { STEP(80, p8_down_pg8(F)); } SEAM(8);
    if (IN(9)) { if (REPEAT_PHASE == 90) { p9_final(F, false); xcd_barrier(bar); } if (REPEAT_PHASE == 99) { for (int i = 0; i < 10; ++i) xcd_barrier(bar); } p9_final(F, true); }
#undef STEP
#undef IN
#undef SEAM
}

#ifndef MK_ONE_LAUNCH
#define MK_ONE_LAUNCH 1
#endif
extern "C" void kernel_launch(void* const* d_in, const int* in_sizes, int n_in, void* d_out, int out_size, void* d_ws, size_t ws_size, hipStream_t stream) {
    static int grid = 0;
    if (grid == 0) {
        if (n_in != 16 || in_sizes[0] != T * D || out_size != T * D || ws_size < WS_END) {
            fprintf(stderr, "kernel_launch: unexpected shapes / workspace (n_in %d, in0 %d, out %d, ws %zu, need %zu); nothing launched\n", n_in, n_in > 0 ? in_sizes[0] : -1, out_size, ws_size, (size_t)WS_END); grid = -1; return; }
        int dev = 0, cus = 0, per_cu = 0;
        if (hipGetDevice(&dev) != hipSuccess || hipDeviceGetAttribute(&cus, hipDeviceAttributeMultiprocessorCount, dev) != hipSuccess) { grid = -1; return; }
        if (hipFuncSetAttribute((const void*)mk_fwd, hipFuncAttributeMaxDynamicSharedMemorySize, LDS_BYTES) != hipSuccess) { fprintf(stderr, "kernel_launch: hipFuncSetAttribute failed\n"); grid = -1; return; }
        if (hipOccupancyMaxActiveBlocksPerMultiprocessor(&per_cu, (const void*)mk_fwd, NWAVES * 64, LDS_BYTES) != hipSuccess || per_cu < 1) { fprintf(stderr, "kernel_launch: occupancy query says %d\n", per_cu); per_cu = 1; }
        (void)hipGetLastError();
        grid = cus;
    }
    if (grid < 0) return;
    (void)hipMemsetAsync((char*)d_ws + WS_CTL, 0, CTL_ZERO_BYTES, stream);
    Args a{};
    for (int i = 0; i < 16; ++i) a.in[i] = (const float*)d_in[i];
    a.out = (float*)d_out; a.ws = (unsigned char*)d_ws;
#if MK_ONE_LAUNCH
    a.ph_lo = 0; a.ph_hi = NPHASE; a.li = 0;
    { void* kargs[] = {&a}; hipError_t e = hipLaunchCooperativeKernel((const void*)mk_fwd, dim3(grid), dim3(NWAVES * 64), kargs, LDS_BYTES, stream);
      if (e != hipSuccess) fprintf(stderr, "kernel_launch: cooperative launch failed: %s\n", hipGetErrorString(e)); }
#else
    for (int p = 0; p < NPHASE; ++p) { a.ph_lo = p; a.ph_hi = p + 1; a.li = 0; hipLaunchKernelGGL(mk_fwd, dim3(grid), dim3(NWAVES * 64), LDS_BYTES, stream, a); }
#endif
}
```

```cpp
#include <hip/hip_runtime.h>
#include <cstdio>
#include <cstdint>

#define GAS __attribute__((address_space(1)))
#define LAS __attribute__((address_space(3)))
typedef unsigned short bf16;
typedef short bf16x8 __attribute__((ext_vector_type(8)));
typedef float f32x4 __attribute__((ext_vector_type(4)));
typedef float f32x16 __attribute__((ext_vector_type(16)));
typedef unsigned v4u __attribute__((ext_vector_type(4)));
typedef unsigned v2u __attribute__((ext_vector_type(2)));
typedef GAS unsigned gu32;
#define RLX_AGENT __ATOMIC_RELAXED, __HIP_MEMORY_SCOPE_AGENT
#define LDS_WAIT() asm volatile("s_waitcnt lgkmcnt(0)" ::: "memory")
#define VM_WAIT() asm volatile("s_waitcnt vmcnt(0)" ::: "memory")

constexpr int BATCH = 4, SEQ = 4096, T = BATCH * SEQ, D = 1024, DIN = 3088, NPROJ = 3072;
constexpr int SBH = 8, SBD = 64, GH = 4, GDK = 64, GDV = 128, GRANK = 16;
constexpr int NE = 32, EPG = 8, NGRP = 4, DFF = 512;
constexpr int COL_SBQ = 0, COL_SBK = 512, COL_SBV = 1024, COL_GQ = 1536, COL_GK = 1792, COL_GV = 2048, COL_GR = 2560, COL_GLR = 3072;
constexpr float RMS_EPS = 1e-6f;
constexpr float LOG2E = 1.4426950408889634f;
constexpr float SBQ_SCALE = 0.125f * LOG2E;
constexpr float GQ_SCALE = 0.125f;
constexpr int NWAVES = 8;
constexpr int CAP = T;

constexpr size_t MiB = 1u << 20;
constexpr size_t WS_CTL = 0, CTL_ZERO_BYTES = 1 * MiB;
constexpr size_t WS_TOKLIST = 1 * MiB;
constexpr size_t WS_GATELIST = 3 * MiB;
constexpr size_t WS_TOKINFO = 5 * MiB;
constexpr size_t WS_GLR = 6 * MiB;
constexpr size_t WS_WRT = 7 * MiB + 512 * 1024;
constexpr size_t WS_DEC = 7 * MiB;
constexpr size_t WS_WIN = 8 * MiB;
constexpr size_t WS_WOUT = 15 * MiB;
constexpr size_t WS_WD = 17 * MiB;
constexpr size_t WS_WGU = 49 * MiB;
constexpr size_t WS_R1 = 113 * MiB;
constexpr size_t WS_R2 = 153 * MiB;
constexpr size_t WS_Y = WS_WGU;
constexpr size_t WS_END = 249 * MiB;
constexpr size_t DO_LOGA = 0;
constexpr size_t DO_OG = 16 * MiB;
constexpr size_t DO_ST = 48 * MiB;
constexpr int CW_TMO = 0, CW_CODE = 1;
constexpr int CW_CNT = 1024, CNT_STRIDE = 32;
constexpr int CW_BAR = 4096;

constexpr int RING_OFF = 0, RING_BYTES = 131072;
constexpr int WAVE_LDS = 18432;
constexpr int LDSCTL_OFF = 8 * WAVE_LDS, MISC_OFF = LDSCTL_OFF + 320;
constexpr int LDS_BYTES = LDSCTL_OFF + 4096;

__device__ __forceinline__ unsigned f2bf(float f) { unsigned u = __builtin_bit_cast(unsigned, f); return (u + 0x7fffu + ((u >> 16) & 1u)) >> 16; }
__device__ __forceinline__ unsigned pk2(float lo, float hi) { return f2bf(lo) | (f2bf(hi) << 16); }
__device__ __forceinline__ float bf2f(unsigned b) { return __builtin_bit_cast(float, b << 16); }
__device__ __forceinline__ float bflo(unsigned w) { return __builtin_bit_cast(float, w << 16); }
__device__ __forceinline__ float bfhi(unsigned w) { return __builtin_bit_cast(float, w & 0xffff0000u); }
__device__ __forceinline__ int crow(int r, int hi) { return (r & 3) + 8 * (r >> 2) + 4 * hi; }
__device__ __forceinline__ float wave_sum(float v) {
#pragma unroll
    for (int o = 1; o < 64; o <<= 1) v += __shfl_xor(v, o);
    return v;
}

#define XB_TMO      128
#define XB_XCNT(j)  (256  + 64 * (j))
#define XB_XSUB(j)  (1280 + 64 * (j))
#define XB_XGEN(j)  (2304 + 64 * (j))
#define XB_TOP      3328
#define XB_TOPGEN   3392
#define XCD_BAR_WORDS 3456
#define XB_SPIN_CAP (1u << 18)
__device__ __forceinline__ unsigned xb_ld(unsigned* p)              { return __hip_atomic_load(p, __ATOMIC_RELAXED, __HIP_MEMORY_SCOPE_AGENT); }
__device__ __forceinline__ unsigned xb_add(unsigned* p, unsigned v) { return __hip_atomic_fetch_add(p, v, __ATOMIC_RELAXED, __HIP_MEMORY_SCOPE_AGENT); }
__device__ __forceinline__ unsigned xb_xcc_id() { return (unsigned)__builtin_amdgcn_s_getreg((3 << 11) | 20) & 0xFu; }
#define XB_SPIN(cond, bar) do { unsigned _sp = 0; while (cond) { __builtin_amdgcn_s_sleep(1); \
    if ((++_sp & 255u) == 0u) { if (xb_ld(&(bar)[XB_TMO])) break; if (_sp > XB_SPIN_CAP) { atomicAdd(&(bar)[XB_TMO], 1u); break; } } } } while (0)
struct XcdBarrier { unsigned* bar; unsigned x; volatile LAS unsigned* st; };
__device__ __forceinline__ XcdBarrier xcd_barrier_post(unsigned* bar, volatile LAS unsigned* st) {
    XcdBarrier b; b.bar = bar; b.x = xb_xcc_id(); b.st = st;
    if (threadIdx.x == 0) (void)xb_add(&bar[XB_XCNT(b.x)], 1u);
    return b;
}
__device__ __forceinline__ void xcd_barrier_complete(unsigned* bar, unsigned x, unsigned& nloc, unsigned& nx) {
    const unsigned G = gridDim.x * gridDim.y * gridDim.z;
    unsigned sum, cnt, mine, sp = 0u;
    for (;;) {
        sum = 0u; cnt = 0u; mine = 0u;
#pragma unroll
        for (unsigned j = 0; j < 16; ++j) { const unsigned c = xb_ld(&bar[XB_XCNT(j)]); sum += c; cnt += (c > 0u) ? 1u : 0u; mine = (j == x) ? c : mine; }
        if (sum == G) break;
        __builtin_amdgcn_s_sleep(1);
        if ((++sp & 255u) == 0u) { if (xb_ld(&bar[XB_TMO])) break; if (sp > XB_SPIN_CAP) { atomicAdd(&bar[XB_TMO], 1u); break; } }
    }
    nloc = mine > 0u ? mine : 1u; nx = cnt > 0u ? cnt : 1u;
}
__device__ __forceinline__ void xcd_barrier(const XcdBarrier& b) {
    asm volatile("s_waitcnt vmcnt(0)" ::: "memory");
    __syncthreads();
    if (threadIdx.x == 0) {
        unsigned* bar = b.bar;
        __builtin_amdgcn_s_waitcnt(0);
        unsigned nloc = b.st[0], nx = b.st[1];
        if (nloc == 0u) { xcd_barrier_complete(bar, b.x, nloc, nx); b.st[0] = nloc; b.st[1] = nx; }
        const unsigned old = xb_add(&bar[XB_XSUB(b.x)], 1u);
        const unsigned gen = old / nloc;
        if (old + 1u == (gen + 1u) * nloc) {
            __builtin_amdgcn_fence(__ATOMIC_RELEASE, "agent");
            asm volatile("s_waitcnt vmcnt(0)" ::: "memory");
            const unsigned og = xb_add(&bar[XB_TOP], 1u);
            const unsigned tg = og / nx;
            if (og + 1u == (tg + 1u) * nx) xb_add(&bar[XB_TOPGEN], 1u);
            else XB_SPIN(xb_ld(&bar[XB_TOPGEN]) == tg, bar);
            __builtin_amdgcn_fence(__ATOMIC_ACQUIRE, "agent");
            xb_add(&bar[XB_XGEN(b.x)], 1u);
            asm volatile("s_waitcnt vmcnt(0)" ::: "memory");
        } else {
            XB_SPIN(xb_ld(&bar[XB_XGEN(b.x)]) == gen, bar);
            __builtin_amdgcn_fence(__ATOMIC_ACQUIRE, "agent");
            asm volatile("s_waitcnt vmcnt(0)" ::: "memory");
        }
    }
    __syncthreads();
}


namespace pg8 {
#define PG8_LAS __attribute__((address_space(3)))
typedef unsigned short bf16_t;
typedef unsigned u32x4 __attribute__((ext_vector_type(4)));
constexpr int BM = 256, BK = 64, HALF = 128, HTB = HALF * BK * 2, STAGE_BYTES = 8 * HTB, NXCD = 8, WGM = 8;
__host__ __device__ __forceinline__ int lds_byte(int r, int c) { const int st = (r >> 4) * 2 + (c >> 5), rr = r & 15, cc = c & 31, ob = rr * 64 + cc * 2; return st * 1024 + (ob ^ (((ob >> 9) & 1) << 5)); }
__host__ __device__ __forceinline__ void stage_rc(int b, int& R, int& C) { const int st = b / 1024, sb = b % 1024, swz = sb ^ (((sb >> 9) & 1) << 5); R = (st >> 1) * 16 + swz / 64; C = (st & 1) * 32 + (swz % 64) / 2; }
__host__ __device__ __forceinline__ int perm32(int rho) { const int n = rho >> 4, i = rho & 15; return 8 * (i >> 2) + 4 * n + (i & 3); }
struct Unit { int pm, pn, e, r0, ne; };
struct Gemm { const bf16_t* A; const bf16_t* Bt; int M, N, K; };
struct StaticOrder {
    int nM, nN, nwg, G, c;
    __device__ void init(int M, int N, int G_, int c_) { nM = M / BM; nN = N / BM; nwg = nM * nN; G = G_; c = c_; }
    __device__ __forceinline__ bool next(int i, Unit& u) const {
        const long L = (long)i * G + c; if (L >= nwg) return false;
        int wgid = (int)L; { const int q = nwg / NXCD, r = nwg % NXCD, xcd = wgid % NXCD, off = wgid / NXCD; wgid = (xcd < r ? xcd * (q + 1) : r * (q + 1) + (xcd - r) * q) + off; }
        const int nig = WGM * nN, gid = wgid / nig, fm = gid * WGM, gsz = (nM - fm) < WGM ? (nM - fm) : WGM;
        u.pm = fm + ((wgid % nig) % gsz); u.pn = (wgid % nig) / gsz; u.e = 0; u.r0 = 0; u.ne = 0; return true;
    }
    __device__ __forceinline__ int src_row(const Unit& u, int R) const { return u.pm * BM + R; }
};
__device__ __forceinline__ unsigned cvt_pk_bf16(float lo, float hi) { unsigned r; asm volatile("v_cvt_pk_bf16_f32 %0, %1, %2" : "=v"(r) : "v"(lo), "v"(hi)); return r; }

template <class Epi, class Sched, bool ALIGN_EPI, bool GATHER>
__device__ __forceinline__ void gemm_phase(PG8_LAS unsigned char* lds, const Gemm g, const Sched& S, const Epi& E) {
    const int tid = threadIdx.x, wid = __builtin_amdgcn_readfirstlane(tid >> 6), lane = tid & 63, wr = wid >> 2, wc = wid & 3, fr = lane & 15, fq = lane >> 4;
    const int K = g.K, nt = K / BK;
    int RA[2], CA[2]; unsigned voffB[2];
#pragma unroll
    for (int i = 0; i < 2; ++i) { int R, C; stage_rc(tid * 16 + i * 8192, R, C); const int Rb = Epi::PERM ? ((R & ~31) + perm32(R & 31)) : R;
        RA[i] = R; CA[i] = C; voffB[i] = (unsigned)(Rb * K + C) * 2u; }
    const size_t kstep = (size_t)(BK * 2);
    const size_t hstep = (size_t)HALF * K * 2;
    const size_t tstep = 2 * hstep;
    const unsigned ldsw = (unsigned)wid * 1024u;
    const int aoff = lds_byte(wr * 64 + fr, fq * 8), boff = lds_byte(wc * 32 + fr, fq * 8);
#define PG8_SA(b, h) (((b) * 2 + (h)) * HTB)
#define PG8_SB(b, h) ((4 + (b) * 2 + (h)) * HTB)
#define PG8_STAGE(bufoff, gbase, voff) do { _Pragma("unroll") for (int _i = 0; _i < 2; ++_i) \
        __builtin_amdgcn_global_load_lds((const unsigned*)((const char*)(gbase) + (voff)[_i]), (PG8_LAS unsigned*)(lds + (bufoff) + ldsw + _i * 8192), 16, 0, 0); } while (0)
#define PG8_LDA(dst, b, h) do { _Pragma("unroll") for (int m = 0; m < 4; ++m) _Pragma("unroll") for (int k = 0; k < 2; ++k) dst[m][k] = *(const PG8_LAS bf16x8*)(lds + PG8_SA(b, h) + aoff + m * 2048 + k * 1024); } while (0)
#define PG8_LDB(dst, b, h) do { _Pragma("unroll") for (int n = 0; n < 2; ++n) _Pragma("unroll") for (int k = 0; k < 2; ++k) dst[n][k] = *(const PG8_LAS bf16x8*)(lds + PG8_SB(b, h) + boff + n * 2048 + k * 1024); } while (0)
#define PG8_MMA(ai, bj, At, Bt) do { __builtin_amdgcn_s_setprio(1); _Pragma("unroll") for (int m = 0; m < 4; ++m) _Pragma("unroll") for (int n = 0; n < 2; ++n) _Pragma("unroll") for (int k = 0; k < 2; ++k) \
        acc[ai][bj][m][n] = __builtin_amdgcn_mfma_f32_16x16x32_bf16(Bt[n][k], At[m][k], acc[ai][bj][m][n], 0, 0, 0); __builtin_amdgcn_s_setprio(0); } while (0)
#define PG8_WAIT_V(n) asm volatile("s_waitcnt vmcnt(" #n ")" ::: "memory")
#define PG8_WAIT_L(n) asm volatile("s_waitcnt lgkmcnt(" #n ")" ::: "memory")
#define PG8_BAR __builtin_amdgcn_s_barrier()
#define PG8_SCHED __builtin_amdgcn_sched_barrier(0)
#define PG8_CALC_VA(dst, u) do { _Pragma("unroll") for (int _h = 0; _h < 2; ++_h) _Pragma("unroll") for (int _i = 0; _i < 2; ++_i) { \
        if constexpr (GATHER) dst[_h][_i] = (unsigned)(S.src_row(u, _h * HALF + RA[_i]) * K + CA[_i]) * 2u; \
        else dst[_h][_i] = (unsigned)((_h * HALF + RA[_i]) * K + CA[_i]) * 2u; } } while (0)
    Unit cur, nxt; int ui = 0;
    if (!S.next(0, cur)) return;
    f32x4 acc[2][2][4][2];
#pragma unroll
    for (int a = 0; a < 2; ++a)
#pragma unroll
        for (int b = 0; b < 2; ++b)
#pragma unroll
            for (int m = 0; m < 4; ++m)
#pragma unroll
                for (int n = 0; n < 2; ++n) acc[a][b][m][n] = (f32x4){0.f, 0.f, 0.f, 0.f};
    bf16x8 At[4][2], B0[2][2], B1[2][2];
    unsigned vA[2][2], vAn[2][2];
    PG8_CALC_VA(vA, cur);
    const char* cA = (const char*)g.A + (GATHER ? (size_t)0 : (size_t)cur.pm * tstep); const char* cB = (const char*)g.Bt + (size_t)cur.pn * tstep;
    PG8_STAGE(PG8_SB(0, 0), cB, voffB); PG8_STAGE(PG8_SB(0, 1), cB + hstep, voffB); PG8_STAGE(PG8_SA(0, 0), cA, vA[0]); PG8_STAGE(PG8_SA(0, 1), cA, vA[1]);
    if (wr == 1) PG8_BAR;
    PG8_WAIT_V(2); PG8_BAR;
    PG8_STAGE(PG8_SB(1, 0), cB + kstep, voffB); PG8_STAGE(PG8_SA(1, 0), cA + kstep, vA[0]); PG8_STAGE(PG8_SB(1, 1), cB + hstep + kstep, voffB);
    PG8_WAIT_V(6); PG8_BAR;
    for (;;) {
        const bool has_next = S.next(ui + 1, nxt);
        if (!has_next) nxt = cur;
        const char* nA = (const char*)g.A + (GATHER ? (size_t)0 : (size_t)nxt.pm * tstep); const char* nB = (const char*)g.Bt + (size_t)nxt.pn * tstep;
        if (has_next) { PG8_CALC_VA(vAn, nxt); } else {
#pragma unroll
            for (int _h = 0; _h < 2; ++_h)
#pragma unroll
                for (int _i = 0; _i < 2; ++_i) vAn[_h][_i] = vA[_h][_i]; }
        for (int t = 0; t < nt; t += 2) {
            const bool last = (t == nt - 2);
            const char* a1 = cA + (size_t)(t + 1) * kstep;
            const char* a2 = last ? nA : cA + (size_t)(t + 2) * kstep; const char* b2 = last ? nB : cB + (size_t)(t + 2) * kstep;
            const char* a3 = a2 + kstep; const char* b3 = b2 + kstep;
            unsigned w0[2], w1[2];
#pragma unroll
            for (int _i = 0; _i < 2; ++_i) { w0[_i] = last ? vAn[0][_i] : vA[0][_i]; w1[_i] = last ? vAn[1][_i] : vA[1][_i]; }
            PG8_LDB(B0, 0, 0); PG8_LDB(B1, 0, 1); PG8_SCHED; PG8_LDA(At, 0, 0); PG8_STAGE(PG8_SA(1, 1), a1, vA[1]);
            PG8_WAIT_V(8); PG8_WAIT_L(0); PG8_BAR; PG8_MMA(0, 0, At, B0); PG8_MMA(0, 1, At, B1); PG8_BAR; PG8_SCHED;
            PG8_LDA(At, 0, 1); PG8_STAGE(PG8_SB(0, 0), b2, voffB); PG8_STAGE(PG8_SB(0, 1), b2 + hstep, voffB); PG8_STAGE(PG8_SA(0, 0), a2, w0);
            PG8_WAIT_V(8); PG8_WAIT_L(0); PG8_BAR; PG8_MMA(1, 0, At, B0); PG8_MMA(1, 1, At, B1); PG8_BAR; PG8_SCHED;
            PG8_LDB(B0, 1, 0); PG8_LDB(B1, 1, 1); PG8_SCHED; PG8_LDA(At, 1, 0); PG8_STAGE(PG8_SA(0, 1), a2, w1);
            PG8_WAIT_V(8); PG8_WAIT_L(0); PG8_BAR; PG8_MMA(0, 0, At, B0); PG8_MMA(0, 1, At, B1); PG8_BAR; PG8_SCHED;
            PG8_LDA(At, 1, 1); PG8_STAGE(PG8_SB(1, 0), b3, voffB); PG8_STAGE(PG8_SB(1, 1), b3 + hstep, voffB); PG8_STAGE(PG8_SA(1, 0), a3, w0);
            PG8_WAIT_V(8); PG8_WAIT_L(0); PG8_BAR; PG8_MMA(1, 0, At, B0); PG8_MMA(1, 1, At, B1); PG8_BAR; PG8_SCHED;
        }
        if constexpr (ALIGN_EPI) { if (wr == 0) PG8_BAR; }
        E(acc, cur, wr, wc, fr, fq);
        if (!has_next) break;
#pragma unroll
        for (int a = 0; a < 2; ++a)
#pragma unroll
            for (int b = 0; b < 2; ++b)
#pragma unroll
                for (int m = 0; m < 4; ++m)
#pragma unroll
                    for (int n = 0; n < 2; ++n) acc[a][b][m][n] = (f32x4){0.f, 0.f, 0.f, 0.f};
        cur = nxt; cA = nA; cB = nB; ++ui;
#pragma unroll
        for (int _h = 0; _h < 2; ++_h)
#pragma unroll
            for (int _i = 0; _i < 2; ++_i) vA[_h][_i] = vAn[_h][_i];
        if constexpr (ALIGN_EPI) { if (wr == 1) PG8_BAR; }
    }
    PG8_WAIT_V(0);
    if constexpr (!ALIGN_EPI) { if (wr == 0) PG8_BAR; }
    PG8_BAR;
#undef PG8_SA
#undef PG8_SB
#undef PG8_STAGE
#undef PG8_LDA
#undef PG8_LDB
#undef PG8_MMA
#undef PG8_WAIT_V
#undef PG8_WAIT_L
#undef PG8_BAR
#undef PG8_SCHED
#undef PG8_CALC_VA
}

struct EpiProj {
    static constexpr bool PERM = true;
    bf16_t* O;
    __device__ __forceinline__ void operator()(const f32x4 (&acc)[2][2][4][2], const Unit& u, int wr, int wc, int fr, int fq) const {
        const int row0 = u.pm * BM + wr * 64 + fr; const int col0 = u.pn * BM + wc * 32 + 8 * fq;
        const float sc = u.pn < 2 ? SBQ_SCALE : (u.pn == 6 ? GQ_SCALE : 1.0f);
#pragma unroll
        for (int ai = 0; ai < 2; ++ai)
#pragma unroll
            for (int m = 0; m < 4; ++m) { bf16_t* rowp = O + (size_t)(row0 + ai * HALF + m * 16) * NPROJ + col0;
#pragma unroll
                for (int bj = 0; bj < 2; ++bj) { const f32x4 v0 = acc[ai][bj][m][0] * sc, v1 = acc[ai][bj][m][1] * sc;
                    u32x4 w; w.x = cvt_pk_bf16(v0[0], v0[1]); w.y = cvt_pk_bf16(v0[2], v0[3]); w.z = cvt_pk_bf16(v1[0], v1[1]); w.w = cvt_pk_bf16(v1[2], v1[3]);
                    *(u32x4*)(rowp + bj * HALF) = w; } }
    }
};
struct EpiResid {
    static constexpr bool PERM = false;
    const float* X; float* C; const float* G; bf16_t* H2;
    __device__ __forceinline__ void operator()(const f32x4 (&acc)[2][2][4][2], const Unit& u, int wr, int wc, int fr, int fq) const {
        const int row0 = u.pm * BM + wr * 64 + fr, col0 = u.pn * BM + wc * 32 + 4 * fq;
        f32x4 gv[2][2];
#pragma unroll
        for (int bj = 0; bj < 2; ++bj)
#pragma unroll
            for (int n = 0; n < 2; ++n) gv[bj][n] = *(const f32x4*)(G + col0 + bj * HALF + n * 16);
#pragma unroll
        for (int ai = 0; ai < 2; ++ai)
#pragma unroll
            for (int m = 0; m < 4; ++m) { const size_t off = (size_t)(row0 + ai * HALF + m * 16) * D + col0;
#pragma unroll
                for (int bj = 0; bj < 2; ++bj)
#pragma unroll
                    for (int n = 0; n < 2; ++n) { const f32x4 v = *(const f32x4*)(X + off + bj * HALF + n * 16) + acc[ai][bj][m][n]; *(f32x4*)(C + off + bj * HALF + n * 16) = v;
                        const f32x4 hv = v * gv[bj][n]; v2u w; w.x = cvt_pk_bf16(hv[0], hv[1]); w.y = cvt_pk_bf16(hv[2], hv[3]); *(v2u*)(H2 + off + bj * HALF + n * 16) = w; } }
    }
};
struct EpiGateUp {
    static constexpr bool PERM = true;
    bf16_t* H; const float* invlist;
    __device__ __forceinline__ void operator()(const f32x4 (&acc)[2][2][4][2], const Unit& u, int wr, int wc, int fr, int fq) const {
        const int row0 = u.pm * BM + wr * 64 + fr; const int col0 = (u.pn & 3) * HALF + wc * 32 + 8 * fq;
#pragma unroll
        for (int ai = 0; ai < 2; ++ai)
#pragma unroll
            for (int m = 0; m < 4; ++m) { float hv[8]; const int row = row0 + ai * HALF + m * 16; const int idx = row - u.r0;
                const float inv = idx < u.ne ? invlist[u.e * CAP + idx] : 0.f;
#pragma unroll
                for (int n = 0; n < 2; ++n)
#pragma unroll
                    for (int j = 0; j < 4; ++j) { const float gv = acc[ai][0][m][n][j] * inv, uv = acc[ai][1][m][n][j] * inv; hv[4 * n + j] = gv * __builtin_amdgcn_rcpf(1.0f + __expf(-gv)) * uv; }
                u32x4 w; w.x = cvt_pk_bf16(hv[0], hv[1]); w.y = cvt_pk_bf16(hv[2], hv[3]); w.z = cvt_pk_bf16(hv[4], hv[5]); w.w = cvt_pk_bf16(hv[6], hv[7]);
                *(u32x4*)(H + (size_t)row * DFF + col0) = w; }
    }
};
struct EpiY {
    static constexpr bool PERM = true;
    bf16_t* Y;
    __device__ __forceinline__ void operator()(const f32x4 (&acc)[2][2][4][2], const Unit& u, int wr, int wc, int fr, int fq) const {
        const int row0 = u.pm * BM + wr * 64 + fr; const int col0 = (u.pn & 3) * BM + wc * 32 + 8 * fq;
#pragma unroll
        for (int ai = 0; ai < 2; ++ai)
#pragma unroll
            for (int m = 0; m < 4; ++m) { bf16_t* rowp = Y + (size_t)(row0 + ai * HALF + m * 16) * D + col0;
#pragma unroll
                for (int bj = 0; bj < 2; ++bj) { const f32x4 v0 = acc[ai][bj][m][0], v1 = acc[ai][bj][m][1];
                    u32x4 w; w.x = cvt_pk_bf16(v0[0], v0[1]); w.y = cvt_pk_bf16(v0[2], v0[3]); w.z = cvt_pk_bf16(v1[0], v1[1]); w.w = cvt_pk_bf16(v1[2], v1[3]);
                    *(u32x4*)(rowp + bj * HALF) = w; } }
    }
};
struct MoeOrder {
    int G, c, MT, nwg; const PG8_LAS int* tab;
    const int* toklist;
    __device__ __forceinline__ bool next(int i, Unit& u) const {
        const long L = (long)i * G + c; if (L >= nwg) return false;
        int wgid = (int)L; { const int q = nwg / NXCD, r = nwg % NXCD, xcd = wgid % NXCD, off = wgid / NXCD; wgid = (xcd < r ? xcd * (q + 1) : r * (q + 1) + (xcd - r) * q) + off; }
        const int st = wgid >> 2, ntl = wgid & 3;
        const int ln = threadIdx.x & 31;
        const int e = __popcll(__ballot(tab[64 + ln] <= st)) >> 1;
        u.pm = st; u.pn = e * 4 + ntl; u.e = e; u.r0 = __builtin_amdgcn_readfirstlane(tab[32 + e]); u.ne = __builtin_amdgcn_readfirstlane(tab[e]); return true;
    }
    __device__ __forceinline__ int src_row(const Unit& u, int R) const { const int idx = u.pm * BM + R - u.r0; return idx < u.ne ? toklist[u.e * CAP + idx] : 0; }
};
}

struct Frame {
    LAS unsigned char* lds;
    volatile LAS unsigned* MISC;
    gu32* ctl;
    int tid, lane, wave;
    int vcu, G;
    int gw, NGW;
    const float *x, *ln1_g, *w_in, *gate_w2, *gate_b, *gnorm_g, *w_out, *ln2_g, *w_group, *b_group, *w_expert, *b_expert, *ew_gate, *ew_up, *ew_down, *lnf_g;
    float* out;
    unsigned char* ws;
    bf16 *WinT, *WoutT, *WguT, *WdT, *XN, *OMIX, *H2, *HBUF, *PROJ, *Y;
    float *GLR, *LOGA, *OG, *X1, *DS, *DEC, *WrT; bf16* ST;
    int* toklist; float* gatelist; float* invlist; int* tokinfo; unsigned* cnt;
};

__device__ __forceinline__ void p0_transpose_item(const float* W, int ldw, int K, int k0, int n0, bf16* WT, size_t dst_row0, LAS float* scr, int lane) {
#pragma unroll 8
    for (int i = 0; i < 32; ++i) { const int kk = 2 * i + (lane >> 5); scr[kk * 33 + (lane & 31)] = W[(size_t)(k0 + kk) * ldw + n0 + (lane & 31)]; }
    LDS_WAIT(); asm volatile("" ::: "memory");
    const int c = lane & 7;
#pragma unroll
    for (int j = 0; j < 4; ++j) { const int n = (lane >> 3) + 8 * j; const LAS float* s = scr + (8 * c) * 33 + n;
        v4u o; o.x = pk2(s[0 * 33], s[1 * 33]); o.y = pk2(s[2 * 33], s[3 * 33]); o.z = pk2(s[4 * 33], s[5 * 33]); o.w = pk2(s[6 * 33], s[7 * 33]);
        *(GAS v4u*)(WT + (dst_row0 + n) * K + k0 + 8 * c) = o; }
    LDS_WAIT(); asm volatile("" ::: "memory");
}
__device__ __forceinline__ void rms_row_to_bf16(int lane, const float* xrow, const float* g, bf16* orow) {
    const GAS f32x4* xr = (const GAS f32x4*)xrow + lane; const GAS f32x4* gr = (const GAS f32x4*)g + lane;
    f32x4 v[4]; float s = 0.f;
#pragma unroll
    for (int j = 0; j < 4; ++j) { v[j] = xr[64 * j]; s += (v[j].x * v[j].x + v[j].y * v[j].y) + (v[j].z * v[j].z + v[j].w * v[j].w); }
    const float inv = 1.0f / sqrtf(wave_sum(s) * (1.f / D) + RMS_EPS);
    GAS unsigned long long* o8 = (GAS unsigned long long*)orow + lane;
#pragma unroll
    for (int j = 0; j < 4; ++j) { const f32x4 gg = gr[64 * j];
        o8[64 * j] = (unsigned long long)pk2(v[j].x * inv * gg.x, v[j].y * inv * gg.y) | ((unsigned long long)pk2(v[j].z * inv * gg.z, v[j].w * inv * gg.w) << 32); }
}
__device__ __forceinline__ void p0_prologue(Frame& F) {
    LAS float* scr = (LAS float*)(F.lds + RING_OFF + F.wave * WAVE_LDS);
    constexpr int I_IN = (D / 64) * (NPROJ / 32);
    constexpr int I_OUT = (D / 64) * (D / 32);
    constexpr int I_G1 = (D / 64) * (DFF / 32);
    constexpr int I_D1 = (DFF / 64) * (D / 32);
    constexpr int NITEMS = I_IN + I_OUT + NE * (2 * I_G1 + I_D1);
    for (int it = F.gw; it < NITEMS; it += F.NGW) {
        int r = it;
        if (r < I_IN) { const int kb = r / (NPROJ / 32), nb = r % (NPROJ / 32); p0_transpose_item(F.w_in, DIN, D, 64 * kb, 32 * nb, F.WinT, (size_t)32 * nb, scr, F.lane); continue; } r -= I_IN;
        if (r < I_OUT) { const int kb = r / (D / 32), nb = r % (D / 32); p0_transpose_item(F.w_out, D, D, 64 * kb, 32 * nb, F.WoutT, (size_t)32 * nb, scr, F.lane); continue; } r -= I_OUT;
        const int e = r / (2 * I_G1 + I_D1); r -= e * (2 * I_G1 + I_D1);
        if (r < 2 * I_G1) { const int up = r / I_G1; r -= up * I_G1; const int kb = r / (DFF / 32), nb = r % (DFF / 32); const int n0 = 32 * nb;
            const float* W = (up ? F.ew_up : F.ew_gate) + (size_t)e * D * DFF;
            const size_t drow = (size_t)e * 1024 + (size_t)(n0 / 128) * 256 + (n0 % 128) + (up ? 128 : 0);
            p0_transpose_item(W, DFF, D, 64 * kb, n0, F.WguT, drow, scr, F.lane); continue; }
        r -= 2 * I_G1;
        { const int kb = r / (D / 32), nb = r % (D / 32);
          p0_transpose_item(F.ew_down + (size_t)e * DFF * D, D, DFF, 64 * kb, 32 * nb, F.WdT, (size_t)e * 1024 + 32 * nb, scr, F.lane); }
    }
    { const int gt = F.gw * 64 + F.lane, NGT = F.NGW * 64;
      for (int i = gt; i < GRANK * D; i += NGT) { const int j = i / D, k = i % D; F.WinT[(size_t)(NPROJ + j) * D + k] = (bf16)f2bf(F.w_in[(size_t)k * DIN + NPROJ + j]); } }
    { const int gt = F.gw * 64 + F.lane, NGT = F.NGW * 64;
      for (int i = gt; i < 64 * D; i += NGT) { const int j = i / D, k = i % D;
          const float w = j < NE ? F.w_expert[(size_t)k * NE + j] : (j < NE + NGRP ? F.w_group[(size_t)k * NGRP + (j - NE)] : 0.f);
          F.WrT[i] = w * F.ln2_g[k]; } }
    for (int m = F.gw; m < T; m += F.NGW) rms_row_to_bf16(F.lane, F.x + (size_t)m * D, F.ln1_g, F.XN + (size_t)m * D);
}

__device__ __forceinline__ f32x16 tile32(const bf16* pa, const bf16* pb, int K, int h) {
    f32x16 acc;
#pragma unroll
    for (int i = 0; i < 16; ++i) acc[i] = 0.f;
    const bf16x8* a8 = (const bf16x8*)(pa + 8 * h); const bf16x8* b8 = (const bf16x8*)(pb + 8 * h);
#pragma unroll 4
    for (int k = 0; k < K / 16; ++k) acc = __builtin_amdgcn_mfma_f32_32x32x16_bf16(a8[2 * k], b8[2 * k], acc, 0, 0, 0);
    return acc;
}

__device__ __forceinline__ void p1_proj_base(Frame& F) {
    const int r = F.lane & 31, h = F.lane >> 5;
    constexpr int NT = NPROJ / 32, MT = T / 32;
    for (int it = F.gw; it < MT * NT; it += F.NGW) {
        const int mt = it / NT, nt = it % NT;
        const f32x16 acc = tile32(F.XN + (size_t)(mt * 32 + r) * D, F.WinT + (size_t)(nt * 32 + r) * D, D, h);
        const int col = nt * 32 + r;
        const float sc = col < COL_SBK ? SBQ_SCALE : ((col >= COL_GQ && col < COL_GK) ? GQ_SCALE : 1.0f);
#pragma unroll
        for (int i = 0; i < 16; ++i) F.PROJ[(size_t)(mt * 32 + crow(i, h)) * NPROJ + col] = (bf16)f2bf(acc[i] * sc);
    }
}
__device__ __forceinline__ void p1_glr(Frame& F) {
    const int gt = F.gw * 64 + F.lane, NGT = F.NGW * 64;
    for (int i = gt; i < T * GRANK; i += NGT) { const int t = i / GRANK, j = i % GRANK;
        const v4u* a = (const v4u*)(F.XN + (size_t)t * D); const v4u* b = (const v4u*)(F.WinT + (size_t)(NPROJ + j) * D);
        float s = 0.f;
        for (int k = 0; k < D / 8; ++k) { const v4u av = a[k], bv = b[k];
            s += bflo(av.x) * bflo(bv.x) + bfhi(av.x) * bfhi(bv.x) + bflo(av.y) * bflo(bv.y) + bfhi(av.y) * bfhi(bv.y)
               + bflo(av.z) * bflo(bv.z) + bfhi(av.z) * bfhi(bv.z) + bflo(av.w) * bflo(bv.w) + bfhi(av.w) * bfhi(bv.w); }
        F.GLR[i] = s; }
}

__device__ __forceinline__ void p2_loga(Frame& F) {
    const int gt = F.gw * 64 + F.lane, NGT = F.NGW * 64;
    for (int i = gt; i < T * 256; i += NGT) { const int t = i >> 8, c = i & 255;
        float s = F.gate_b[c];
#pragma unroll
        for (int j = 0; j < GRANK; ++j) s += F.GLR[t * GRANK + j] * F.gate_w2[j * 256 + c];
        const float ls = fminf(s, 0.f) - log1pf(expf(-fabsf(s)));
        F.LOGA[i] = ls * (1.0f / 16.0f); }
}
__device__ __forceinline__ void p2_sb_base(Frame& F) {
    for (int it = F.gw; it < BATCH * SBH * (SEQ / 64); it += F.NGW) {
        const int qb = it % (SEQ / 64), h = (it / (SEQ / 64)) % SBH, b = it / ((SEQ / 64) * SBH);
        const int t = qb * 64 + F.lane; const size_t row = (size_t)b * SEQ + t;
        float q[64], o[64];
        { const v4u* qp = (const v4u*)(F.PROJ + row * NPROJ + COL_SBQ + h * 64);
#pragma unroll
          for (int j = 0; j < 8; ++j) { const v4u w = qp[j]; q[8 * j] = bflo(w.x); q[8 * j + 1] = bfhi(w.x); q[8 * j + 2] = bflo(w.y); q[8 * j + 3] = bfhi(w.y);
              q[8 * j + 4] = bflo(w.z); q[8 * j + 5] = bfhi(w.z); q[8 * j + 6] = bflo(w.w); q[8 * j + 7] = bfhi(w.w); } }
#pragma unroll
        for (int d = 0; d < 64; ++d) o[d] = 0.f;
        float R = 0.f;
        int zero = 0; asm volatile("" : "+v"(zero));
        for (int s = qb * 64 + 62; s >= 0; --s) {
            const bf16* kv = F.PROJ + ((size_t)b * SEQ + s) * NPROJ + h * 64 + zero;
            const v4u* kp = (const v4u*)(kv + COL_SBK); const v4u* vp = (const v4u*)(kv + COL_SBV);
            float z = 0.f;
#pragma unroll
            for (int j = 0; j < 8; ++j) { const v4u w = kp[j];
                z += q[8 * j] * bflo(w.x) + q[8 * j + 1] * bfhi(w.x) + q[8 * j + 2] * bflo(w.y) + q[8 * j + 3] * bfhi(w.y)
                   + q[8 * j + 4] * bflo(w.z) + q[8 * j + 5] * bfhi(w.z) + q[8 * j + 6] * bflo(w.w) + q[8 * j + 7] * bfhi(w.w); }
            const float lb = fminf(z, 0.f) - __log2f(1.0f + exp2f(-fabsf(z)));
            const float wgt = (s < t) ? exp2f(lb + R) : 0.f;
            if (s < t) R += lb - z;
#pragma unroll
            for (int j = 0; j < 8; ++j) { const v4u w = vp[j];
                o[8 * j] += wgt * bflo(w.x); o[8 * j + 1] += wgt * bfhi(w.x); o[8 * j + 2] += wgt * bflo(w.y); o[8 * j + 3] += wgt * bfhi(w.y);
                o[8 * j + 4] += wgt * bflo(w.z); o[8 * j + 5] += wgt * bfhi(w.z); o[8 * j + 6] += wgt * bflo(w.w); o[8 * j + 7] += wgt * bfhi(w.w); }
        }
        v4u* op = (v4u*)(F.OMIX + row * D + h * 64);
#pragma unroll
        for (int j = 0; j < 8; ++j) { v4u w; w.x = pk2(o[8 * j], o[8 * j + 1]); w.y = pk2(o[8 * j + 2], o[8 * j + 3]); w.z = pk2(o[8 * j + 4], o[8 * j + 5]); w.w = pk2(o[8 * j + 6], o[8 * j + 7]); op[j] = w; }
    }
}

typedef short s16x4 __attribute__((ext_vector_type(4)));
typedef short v4i16_t __attribute__((ext_vector_type(4)));
typedef float f32x2_t __attribute__((ext_vector_type(2))); typedef __bf16 bf16x2_t __attribute__((ext_vector_type(2)));
__device__ __forceinline__ unsigned cvtpk_s(float lo, float hi) { f32x2_t v = {lo, hi}; bf16x2_t b = __builtin_convertvector(v, bf16x2_t); return __builtin_bit_cast(unsigned, b); }
__device__ __forceinline__ s16x4 vtr(const LAS char* p) { return __builtin_bit_cast(s16x4, __builtin_amdgcn_ds_read_tr16_b64_v4i16((LAS v4i16_t*)p)); }
__device__ __forceinline__ bf16x8 pack8(const float* x) { v4u p; p.x = cvtpk_s(x[0], x[1]); p.y = cvtpk_s(x[2], x[3]); p.z = cvtpk_s(x[4], x[5]); p.w = cvtpk_s(x[6], x[7]); return __builtin_bit_cast(bf16x8, p); }
constexpr float SB_STOP = -152.0f;
__device__ __forceinline__ void gload16(v4u& d, const void* p) { asm volatile("global_load_dwordx4 %0, %1, off" : "=v"(d) : "v"(p) : "memory"); }
#define SB_WAIT(N, K, V) asm volatile("s_waitcnt vmcnt(" #N ")" : "+v"(K[0]), "+v"(K[1]), "+v"(K[2]), "+v"(K[3]), "+v"(V[0]), "+v"(V[1]), "+v"(V[2]), "+v"(V[3]) :: "memory")
struct SbState { f32x16 O0, O1; float R; };
__device__ __forceinline__ bool sb_tile(SbState& st, const v4u (&kreg)[4], const v4u (&vreg)[4], const bf16x8 (&qf)[4], const bf16x8 U0, const bf16x8 U1, LAS char* vl, const LAS char* vbase, const bool diag, const int lane) {
    const int r = lane & 31, hh = lane >> 5;
#pragma unroll
    for (int i = 0; i < 4; ++i) { const int key = 8 * i + (lane >> 3), dch = lane & 7;
        *(LAS v4u*)(vl + ((key >> 3) * 2 + (dch >> 2)) * 512 + (key & 7) * 64 + (dch & 3) * 16) = vreg[i]; }
    f32x16 S;
#pragma unroll
    for (int i = 0; i < 16; ++i) S[i] = 0.f;
#pragma unroll
    for (int ks = 0; ks < 4; ++ks) S = __builtin_amdgcn_mfma_f32_32x32x16_bf16(__builtin_bit_cast(bf16x8, kreg[ks]), qf[ks], S, 0, 0, 0);
    float lom[16]; f32x16 C; float rs = 0.f;
#pragma unroll
    for (int i = 0; i < 16; ++i) { const float z = S[i];
        const float l = __builtin_amdgcn_logf(1.0f + __builtin_amdgcn_exp2f(-fabsf(z)));
        const float lbv = fminf(z, 0.f) - l; float lm = lbv - z;
        if (diag && !(crow(i, hh) < r)) lm = 0.f;
        lom[i] = lm; rs += lm; C[i] = lbv + st.R; }
    rs += __shfl_xor(rs, 32);
    const bf16x8 pb0 = pack8(lom), pb1 = pack8(lom + 8);
    C = __builtin_amdgcn_mfma_f32_32x32x16_bf16(U0, pb0, C, 0, 0, 0);
    C = __builtin_amdgcn_mfma_f32_32x32x16_bf16(U1, pb1, C, 0, 0, 0);
    float w[16];
#pragma unroll
    for (int i = 0; i < 16; ++i) { float wv = __builtin_amdgcn_exp2f(C[i]); if (diag && !(crow(i, hh) < r)) wv = 0.f; w[i] = wv; }
    const bf16x8 pa0 = pack8(w), pa1 = pack8(w + 8);
    asm volatile("" ::: "memory");
#pragma unroll
    for (int nb = 0; nb < 2; ++nb) {
        const s16x4 l0 = vtr(vbase + (0 * 2 + nb) * 512), h0 = vtr(vbase + (1 * 2 + nb) * 512), l1 = vtr(vbase + (2 * 2 + nb) * 512), h1 = vtr(vbase + (3 * 2 + nb) * 512);
        const bf16x8 v0 = (bf16x8){l0[0], l0[1], l0[2], l0[3], h0[0], h0[1], h0[2], h0[3]}, v1 = (bf16x8){l1[0], l1[1], l1[2], l1[3], h1[0], h1[1], h1[2], h1[3]};
        if (nb == 0) { st.O0 = __builtin_amdgcn_mfma_f32_32x32x16_bf16(pa0, v0, st.O0, 0, 0, 0); st.O0 = __builtin_amdgcn_mfma_f32_32x32x16_bf16(pa1, v1, st.O0, 0, 0, 0); }
        else { st.O1 = __builtin_amdgcn_mfma_f32_32x32x16_bf16(pa0, v0, st.O1, 0, 0, 0); st.O1 = __builtin_amdgcn_mfma_f32_32x32x16_bf16(pa1, v1, st.O1, 0, 0, 0); }
    }
    asm volatile("" ::: "memory");
    st.R += rs;
    return __all(st.R < SB_STOP);
}
__device__ __forceinline__ void p2_sb_fast(Frame& F) {
    const int lane = F.lane, r = lane & 31, hh = lane >> 5;
    LAS char* vl = (LAS char*)(F.lds + RING_OFF + F.wave * WAVE_LDS);
    const LAS char* vbase = vl + (4 * hh + ((lane & 15) >> 2)) * 64 + ((lane >> 4) & 1) * 32 + (lane & 3) * 8;
    bf16x8 U0, U1;
#pragma unroll
    for (int j = 0; j < 8; ++j) { const int k0 = 8 * (j >> 2) + 4 * hh + (j & 3); U0[j] = (k0 > r) ? (short)0x3F80 : (short)0; U1[j] = (16 + k0 > r) ? (short)0x3F80 : (short)0; }
    constexpr int NQB = SEQ / 32;
    for (int unit = F.gw; unit < BATCH * SBH * NQB; unit += F.NGW) {
        const int qb = unit % NQB, head = (unit / NQB) % SBH, b = unit / (NQB * SBH);
        const size_t rowbase = (size_t)b * SEQ; const int t0 = qb * 32;
        bf16x8 qf[4];
        { const bf16* Qp = F.PROJ + (rowbase + t0 + r) * NPROJ + COL_SBQ + head * 64 + 8 * hh;
#pragma unroll
          for (int ks = 0; ks < 4; ++ks) qf[ks] = *(const bf16x8*)(Qp + 16 * ks); }
        SbState st;
#pragma unroll
        for (int i = 0; i < 16; ++i) { st.O0[i] = 0.f; st.O1[i] = 0.f; }
        st.R = 0.f;
        const bf16* Kp0 = F.PROJ + (rowbase + r) * NPROJ + COL_SBK + head * 64 + 8 * hh;
        const bf16* Vp0 = F.PROJ + (rowbase + (lane >> 3)) * NPROJ + COL_SBV + head * 64 + 8 * (lane & 7);
        v4u kA[4], vA[4], kB[4], vB[4];
#define SB_FETCH(K, V, tile) do { const size_t so_ = (size_t)(tile) * 32 * NPROJ; \
            _Pragma("unroll") for (int q_ = 0; q_ < 4; ++q_) gload16(K[q_], Kp0 + so_ + 16 * q_); \
            _Pragma("unroll") for (int q_ = 0; q_ < 4; ++q_) gload16(V[q_], Vp0 + so_ + (size_t)(8 * q_) * NPROJ); } while (0)
        SB_FETCH(kA, vA, qb);
        int kt = qb;
        for (;;) {
            SB_FETCH(kB, vB, kt > 0 ? kt - 1 : 0);
            SB_WAIT(8, kA, vA);
            bool done = sb_tile(st, kA, vA, qf, U0, U1, vl, vbase, kt == qb, lane);
            if (done || kt == 0) break;
            --kt;
            SB_FETCH(kA, vA, kt > 0 ? kt - 1 : 0);
            SB_WAIT(8, kB, vB);
            done = sb_tile(st, kB, vB, qf, U0, U1, vl, vbase, false, lane);
            if (done || kt == 0) break;
            --kt;
        }
        SB_WAIT(0, kA, vA); SB_WAIT(0, kB, vB);
#undef SB_FETCH
        bf16* Op = F.OMIX + (rowbase + t0) * D + head * 64 + r;
#pragma unroll
        for (int i = 0; i < 16; ++i) { const int tr = crow(i, hh); Op[(size_t)tr * D] = (bf16)f2bf(st.O0[i]); Op[(size_t)tr * D + 32] = (bf16)f2bf(st.O1[i]); }
    }
}

typedef float f32x4v __attribute__((ext_vector_type(4)));
__device__ __forceinline__ void p1_loga(Frame& F) {
    const int lane = F.lane, rw = lane & 15, kq = lane >> 4;
    LAS float* gl = (LAS float*)(F.lds + RING_OFF + F.wave * WAVE_LDS);
    const int uw = F.wave * F.G + F.vcu, NU = F.G * NWAVES;
    if (uw >= T / 16) return;
    f32x4 w2r[GRANK]; const f32x4 bias = *(const f32x4*)(F.gate_b + 4 * lane);
#pragma unroll
    for (int j = 0; j < GRANK; ++j) w2r[j] = *(const f32x4*)(F.gate_w2 + j * 256 + 4 * lane);
    for (int unit = uw; unit < T / 16; unit += NU) {
        const int t0 = unit * 16;
        const bf16* ap = F.XN + (size_t)(t0 + rw) * D + 8 * kq; const bf16* bp = F.WinT + (size_t)(NPROJ + rw) * D + 8 * kq;
        f32x4 acc = {0.f, 0.f, 0.f, 0.f};
#pragma unroll 8
        for (int ks = 0; ks < D / 32; ++ks) acc = __builtin_amdgcn_mfma_f32_16x16x32_bf16(*(const bf16x8*)(ap + 32 * ks), *(const bf16x8*)(bp + 32 * ks), acc, 0, 0, 0);
#pragma unroll
        for (int q = 0; q < 4; ++q) gl[(4 * kq + q) * 16 + rw] = acc[q];
        asm volatile("" ::: "memory");
#pragma unroll 4
        for (int tk = 0; tk < 16; ++tk) {
            const LAS f32x4* gp = (const LAS f32x4*)(gl + tk * 16);
            f32x4 a = bias;
#pragma unroll
            for (int j4 = 0; j4 < 4; ++j4) { const f32x4 g4 = gp[j4];
#pragma unroll
                for (int q = 0; q < 4; ++q) a += w2r[4 * j4 + q] * g4[q]; }
            f32x4 o;
#pragma unroll
            for (int q = 0; q < 4; ++q) { const float sv = a[q]; o[q] = (fminf(sv, 0.f) - __logf(1.0f + __expf(-fabsf(sv)))) * (1.0f / 16.0f); }
            *(f32x4*)(F.LOGA + (size_t)(t0 + tk) * 256 + 4 * lane) = o;
        }
        asm volatile("" ::: "memory");
    }
}
__device__ __forceinline__ bf16x8 tr_frag(const LAS char* img, int ncb, int ra, int rb, int cb, int lane) {
    const int q = (lane & 15) >> 2, p = lane & 3, g16 = (lane >> 4) & 1;
    const s16x4 lo = vtr(img + ((ra >> 3) * ncb + cb) * 512 + ((ra & 7) + q) * 64 + g16 * 32 + p * 8);
    const s16x4 hi = vtr(img + ((rb >> 3) * ncb + cb) * 512 + ((rb & 7) + q) * 64 + g16 * 32 + p * 8);
    return (bf16x8){lo[0], lo[1], lo[2], lo[3], hi[0], hi[1], hi[2], hi[3]};
}
#define SCHED_FENCE() __builtin_amdgcn_sched_barrier(0)
__device__ __forceinline__ void gla_pass_a(Frame& F) {
    const int lane = F.lane, r = lane & 31, hh = lane >> 5;
    LAS char* KD = (LAS char*)(F.lds + RING_OFF + F.wave * WAVE_LDS); LAS char* VV = KD + 8192;
    for (int unit = F.gw; unit < BATCH * GH * 64 * 2; unit += F.NGW) {
        const int vhalf = unit & 1, c = (unit >> 1) & 63, bh = unit >> 7, b = bh >> 2, h = bh & 3;
        const size_t row0 = (size_t)b * SEQ + c * 64;
        const float* gp = F.LOGA + row0 * 256 + h * 64; const bf16* kp = F.PROJ + row0 * NPROJ + COL_GK + h * 64;
        float gA[16], gB[16]; unsigned short kA[16], kB[16]; v4u vr[8];
#define GA_LOAD(G, K, bi) do { _Pragma("unroll") for (int t_ = 0; t_ < 16; ++t_) { G[t_] = (gp + (size_t)(16 * (bi) + t_) * 256)[lane]; K[t_] = (kp + (size_t)(16 * (bi) + t_) * NPROJ)[lane]; } } while (0)
#define GA_PROC(G, K, bi) do { _Pragma("unroll") for (int t_ = 0; t_ < 16; ++t_) { const int t = 16 * (bi) + t_; run += G[t_]; \
            const float kd_ = bf2f(K[t_]) * __expf(-run); \
            *(LAS bf16*)(KD + ((t >> 3) * 2 + (lane >> 5)) * 512 + (t & 7) * 64 + (lane & 31) * 2) = (bf16)f2bf(kd_); } } while (0)
        float run = 0.f;
        GA_LOAD(gA, kA, 0);
#pragma unroll
        for (int i = 0; i < 8; ++i) { const int ch = i * 64 + lane, t = ch >> 3, cc = ch & 7; vr[i] = *(const v4u*)(F.PROJ + (row0 + t) * NPROJ + COL_GV + h * 128 + vhalf * 64 + cc * 8); }
        GA_LOAD(gB, kB, 1); SCHED_FENCE(); GA_PROC(gA, kA, 0); SCHED_FENCE();
        GA_LOAD(gA, kA, 2); SCHED_FENCE(); GA_PROC(gB, kB, 1); SCHED_FENCE();
        GA_LOAD(gB, kB, 3); SCHED_FENCE(); GA_PROC(gA, kA, 2); SCHED_FENCE();
        GA_PROC(gB, kB, 3);
#undef GA_LOAD
#undef GA_PROC
        const float etot = __expf(run);
        if (vhalf == 0) F.DEC[(bh * 64 + c) * 64 + lane] = etot;
#pragma unroll
        for (int i = 0; i < 8; ++i) { const int ch = i * 64 + lane, t = ch >> 3, cc = ch & 7;
            *(LAS v4u*)(VV + ((t >> 3) * 2 + (cc >> 2)) * 512 + (t & 7) * 64 + (cc & 3) * 16) = vr[i]; }
        asm volatile("" ::: "memory");
        f32x16 acc[2][2];
#pragma unroll
        for (int a = 0; a < 2; ++a)
#pragma unroll
            for (int bb = 0; bb < 2; ++bb)
#pragma unroll
                for (int i = 0; i < 16; ++i) acc[a][bb][i] = 0.f;
#pragma unroll
        for (int ks = 0; ks < 4; ++ks) { const int ra = 16 * ks + 8 * hh, rb = ra + 4;
            const bf16x8 a0 = tr_frag(VV, 2, ra, rb, 0, lane), a1 = tr_frag(VV, 2, ra, rb, 1, lane);
            const bf16x8 b0 = tr_frag(KD, 2, ra, rb, 0, lane), b1 = tr_frag(KD, 2, ra, rb, 1, lane);
            acc[0][0] = __builtin_amdgcn_mfma_f32_32x32x16_bf16(a0, b0, acc[0][0], 0, 0, 0); acc[0][1] = __builtin_amdgcn_mfma_f32_32x32x16_bf16(a0, b1, acc[0][1], 0, 0, 0);
            acc[1][0] = __builtin_amdgcn_mfma_f32_32x32x16_bf16(a1, b0, acc[1][0], 0, 0, 0); acc[1][1] = __builtin_amdgcn_mfma_f32_32x32x16_bf16(a1, b1, acc[1][1], 0, 0, 0); }
        const float e0 = __shfl(etot, r), e1 = __shfl(etot, 32 + r);
        float* dsp = F.DS + ((size_t)(bh * 64 + c) * 128 + 64 * vhalf) * 64 + r;
#pragma unroll
        for (int vb = 0; vb < 2; ++vb)
#pragma unroll
            for (int kb = 0; kb < 2; ++kb)
#pragma unroll
                for (int i = 0; i < 16; ++i) dsp[(size_t)(32 * vb + crow(i, hh)) * 64 + 32 * kb] = acc[vb][kb][i] * (kb ? e1 : e0);
        asm volatile("" ::: "memory");
    }
}
__device__ __forceinline__ void gla_pass_b(Frame& F) {
    const int gt = F.gw * 64 + F.lane, NGT = F.NGW * 64;
    for (int e = gt; e < BATCH * GH * 8192; e += NGT) {
        const int bh = e >> 13, rem = e & 8191, k = rem & 63;
        float S = 0.f;
#pragma unroll 8
        for (int c = 0; c < 64; ++c) { const size_t o = ((size_t)(bh * 64 + c) << 13) + rem;
            F.ST[o] = (bf16)f2bf(S); S = F.DEC[(bh * 64 + c) * 64 + k] * S + F.DS[o]; }
    }
}
template <int THALF> __device__ __forceinline__ void gla_pass_c_unit(Frame& F, const int c, const int bh) {
    const int lane = F.lane, r = lane & 31, hh = lane >> 5;
    LAS char* KT = (LAS char*)(F.lds + RING_OFF + F.wave * WAVE_LDS); LAS char* QT = KT + 8192; LAS char* VV = KT;
    const int b = bh >> 2, h = bh & 3;
    const size_t row0 = (size_t)b * SEQ + c * 64;
    const float* gp = F.LOGA + row0 * 256 + h * 64; const bf16* kp = F.PROJ + row0 * NPROJ + COL_GK + h * 64;
    float gA[16], gB[16]; unsigned short kA[16], kB[16], qA[16], qB[16];
#define GC_LOAD(G, K, Q, bi) do { _Pragma("unroll") for (int t_ = 0; t_ < 16; ++t_) { G[t_] = (gp + (size_t)(16 * (bi) + t_) * 256)[lane]; K[t_] = (kp + (size_t)(16 * (bi) + t_) * NPROJ)[lane]; \
            if ((bi) >= 2 * THALF) Q[t_] = (kp + (size_t)(16 * (bi) + t_) * NPROJ + (COL_GQ - COL_GK))[lane]; } } while (0)
#define GC_PROC(G, K, Q, bi) do { _Pragma("unroll") for (int t_ = 0; t_ < 16; ++t_) { const int t = 16 * (bi) + t_; run += G[t_]; \
            const float kt_ = bf2f(K[t_]) * __expf(-run); \
            *(LAS bf16*)(KT + t * 128 + ((lane * 2) ^ ((t & 7) << 4))) = (bf16)f2bf(kt_); \
            if ((bi) >= 2 * THALF) { const int tt = t - 32 * THALF; const float qt_ = bf2f(Q[t_]) * __expf(run); \
                *(LAS bf16*)(QT + tt * 128 + ((lane * 2) ^ ((tt & 7) << 4))) = (bf16)f2bf(qt_); } } } while (0)
    float run = 0.f;
    GC_LOAD(gA, kA, qA, 0);
    constexpr int NVR = 8 * (THALF + 1);
    v4u vr[NVR];
#pragma unroll
    for (int i = 0; i < NVR; ++i) { const int sidx = 4 * i + (lane >> 4), cc = lane & 15; vr[i] = *(const v4u*)(F.PROJ + (row0 + sidx) * NPROJ + COL_GV + h * 128 + cc * 8); }
    GC_LOAD(gB, kB, qB, 1); SCHED_FENCE(); GC_PROC(gA, kA, qA, 0); SCHED_FENCE();
    if (THALF) {
        GC_LOAD(gA, kA, qA, 2); SCHED_FENCE(); GC_PROC(gB, kB, qB, 1); SCHED_FENCE();
        GC_LOAD(gB, kB, qB, 3); SCHED_FENCE(); GC_PROC(gA, kA, qA, 2); SCHED_FENCE();
        GC_PROC(gB, kB, qB, 3);
    } else {
        GC_PROC(gB, kB, qB, 1);
    }
#undef GC_LOAD
#undef GC_PROC
    asm volatile("" ::: "memory");
    bf16x8 qf[4];
#pragma unroll
    for (int ks = 0; ks < 4; ++ks) qf[ks] = *(const LAS bf16x8*)(QT + r * 128 + ((32 * ks + 16 * hh) ^ ((r & 7) << 4)));
    bf16x8 pa[2][2];
#pragma unroll
    for (int sb = 0; sb <= THALF; ++sb) {
        f32x16 P;
#pragma unroll
        for (int i = 0; i < 16; ++i) P[i] = 0.f;
        const int srow = 32 * sb + r;
#pragma unroll
        for (int ks = 0; ks < 4; ++ks) { const bf16x8 kf = *(const LAS bf16x8*)(KT + srow * 128 + ((32 * ks + 16 * hh) ^ ((srow & 7) << 4)));
            P = __builtin_amdgcn_mfma_f32_32x32x16_bf16(kf, qf[ks], P, 0, 0, 0); }
        float pm[16];
#pragma unroll
        for (int i = 0; i < 16; ++i) pm[i] = (32 * sb + crow(i, hh) <= 32 * THALF + r) ? P[i] : 0.f;
        pa[sb][0] = pack8(pm); pa[sb][1] = pack8(pm + 8);
    }
    asm volatile("" ::: "memory");
#pragma unroll
    for (int i = 0; i < NVR; ++i) { const int sidx = 4 * i + (lane >> 4), cc = lane & 15;
        *(LAS v4u*)(VV + ((sidx >> 3) * 4 + (cc >> 2)) * 512 + (sidx & 7) * 64 + (cc & 3) * 16) = vr[i]; }
    asm volatile("" ::: "memory");
    bf16x8 sf[4][4];
#pragma unroll
    for (int vb = 0; vb < 4; ++vb) { const bf16* stp = F.ST + ((size_t)(bh * 64 + c) * 128 + 32 * vb + r) * 64 + 8 * hh;
#pragma unroll
        for (int ks = 0; ks < 4; ++ks) sf[vb][ks] = *(const bf16x8*)(stp + 16 * ks); }
    SCHED_FENCE();
    f32x16 o[4];
#pragma unroll
    for (int vb = 0; vb < 4; ++vb) {
#pragma unroll
        for (int i = 0; i < 16; ++i) o[vb][i] = 0.f;
#pragma unroll
        for (int sb = 0; sb <= THALF; ++sb)
#pragma unroll
            for (int s2 = 0; s2 < 2; ++s2) { const int ra = 32 * sb + 16 * s2 + 4 * hh, rb = ra + 8;
                const bf16x8 vf = tr_frag(VV, 4, ra, rb, vb, lane);
                o[vb] = __builtin_amdgcn_mfma_f32_32x32x16_bf16(pa[sb][s2], vf, o[vb], 0, 0, 0); }
#pragma unroll
        for (int ks = 0; ks < 4; ++ks) o[vb] = __builtin_amdgcn_mfma_f32_32x32x16_bf16(qf[ks], sf[vb][ks], o[vb], 0, 0, 0);
    }
    asm volatile("" ::: "memory");
    v4u grv[8];
    { const bf16* grp = F.PROJ + (row0 + 32 * THALF + (lane >> 1)) * NPROJ + COL_GR + h * 128 + 64 * (lane & 1);
#pragma unroll
      for (int jj = 0; jj < 8; ++jj) grv[jj] = *(const v4u*)(grp + 8 * jj); }
    SCHED_FENCE();
    LAS char* OL = KT;
#pragma unroll
    for (int vb = 0; vb < 4; ++vb)
#pragma unroll
        for (int i = 0; i < 16; ++i) { const int t = crow(i, hh); const int chunk = 8 * vb + (r >> 2);
            *(LAS float*)(OL + t * 528 + chunk * 16 + (r & 3) * 4) = o[vb][i]; }
    asm volatile("" ::: "memory");
    const int t2 = lane >> 1, hf = lane & 1;
    float ss = 0.f;
#pragma unroll
    for (int j = 0; j < 16; ++j) { const f32x4 x = *(const LAS f32x4*)(OL + t2 * 528 + (16 * hf + j) * 16); ss += (x.x * x.x + x.y * x.y) + (x.z * x.z + x.w * x.w); }
    ss += __shfl_xor(ss, 1);
    const float inv = 1.0f / sqrtf(ss * (1.0f / GDV) + RMS_EPS);
    const size_t trow = row0 + 32 * THALF + t2;
    const float* gnp = F.gnorm_g + h * 128 + 64 * hf;
    bf16* outp = F.OMIX + trow * D + 512 + h * 128 + 64 * hf;
#pragma unroll
    for (int jj = 0; jj < 8; ++jj) {
        const f32x4 x0 = *(const LAS f32x4*)(OL + t2 * 528 + (16 * hf + 2 * jj) * 16), x1 = *(const LAS f32x4*)(OL + t2 * 528 + (16 * hf + 2 * jj + 1) * 16);
        const f32x4 g0 = *(const f32x4*)(gnp + 8 * jj), g1 = *(const f32x4*)(gnp + 8 * jj + 4);
        const v4u gw = grv[jj];
        const float gr[8] = {bflo(gw.x), bfhi(gw.x), bflo(gw.y), bfhi(gw.y), bflo(gw.z), bfhi(gw.z), bflo(gw.w), bfhi(gw.w)};
        const float xv[8] = {x0.x, x0.y, x0.z, x0.w, x1.x, x1.y, x1.z, x1.w}; const float gg[8] = {g0.x, g0.y, g0.z, g0.w, g1.x, g1.y, g1.z, g1.w};
        float res[8];
#pragma unroll
        for (int q = 0; q < 8; ++q) res[q] = xv[q] * inv * gg[q] * gr[q] * __builtin_amdgcn_rcpf(1.0f + __expf(-gr[q]));
        v4u w; w.x = cvtpk_s(res[0], res[1]); w.y = cvtpk_s(res[2], res[3]); w.z = cvtpk_s(res[4], res[5]); w.w = cvtpk_s(res[6], res[7]);
        *(v4u*)(outp + 8 * jj) = w;
    }
    asm volatile("" ::: "memory");
}
__device__ __forceinline__ void gla_pass_c(Frame& F) {
    for (int unit = F.gw; unit < BATCH * GH * 64 * 2; unit += F.NGW) {
        const int thalf = unit & 1, c = (unit >> 1) & 63, bh = unit >> 7;
        if (thalf) gla_pass_c_unit<1>(F, c, bh); else gla_pass_c_unit<0>(F, c, bh);
    }
}

__device__ __forceinline__ void p3_gla_base(Frame& F) {
    if (F.gw >= BATCH * GH * 2) return;
    const int b = F.gw / (GH * 2), h = (F.gw / 2) % GH, vc = (F.gw & 1) * 64 + F.lane;
    float S[64];
#pragma unroll
    for (int k = 0; k < 64; ++k) S[k] = 0.f;
    int zero = 0; asm volatile("" : "+v"(zero));
    for (int t = 0; t < SEQ; ++t) {
        const size_t row = (size_t)b * SEQ + t;
        const bf16* pr = F.PROJ + row * NPROJ + zero;
        const float vv = bf2f(pr[COL_GV + h * 128 + vc]);
        const v4u* kp = (const v4u*)(pr + COL_GK + h * 64); const v4u* qp = (const v4u*)(pr + COL_GQ + h * 64);
        const f32x4* lp = (const f32x4*)(F.LOGA + row * 256 + h * 64 + zero);
        float o = 0.f;
#pragma unroll
        for (int j = 0; j < 8; ++j) { const v4u kw = kp[j], qw = qp[j]; const f32x4 l0 = lp[2 * j], l1 = lp[2 * j + 1];
            const float kk[8] = {bflo(kw.x), bfhi(kw.x), bflo(kw.y), bfhi(kw.y), bflo(kw.z), bfhi(kw.z), bflo(kw.w), bfhi(kw.w)};
            const float qq[8] = {bflo(qw.x), bfhi(qw.x), bflo(qw.y), bfhi(qw.y), bflo(qw.z), bfhi(qw.z), bflo(qw.w), bfhi(qw.w)};
            const float ll[8] = {l0.x, l0.y, l0.z, l0.w, l1.x, l1.y, l1.z, l1.w};
#pragma unroll
            for (int i = 0; i < 8; ++i) { const float a = __expf(ll[i]); S[8 * j + i] = a * S[8 * j + i] + kk[i] * vv; o += qq[i] * S[8 * j + i]; } }
        F.OG[row * 512 + h * 128 + vc] = o;
    }
}
__device__ __forceinline__ void p4_gla_out(Frame& F) {
    for (int t = F.gw; t < T; t += F.NGW) {
        const int c0 = F.lane * 8;
        const f32x4* op = (const f32x4*)(F.OG + (size_t)t * 512 + c0); const f32x4 a = op[0], b = op[1];
        float ss = (a.x * a.x + a.y * a.y) + (a.z * a.z + a.w * a.w) + (b.x * b.x + b.y * b.y) + (b.z * b.z + b.w * b.w);
        ss += __shfl_xor(ss, 1); ss += __shfl_xor(ss, 2); ss += __shfl_xor(ss, 4); ss += __shfl_xor(ss, 8);
        const float inv = 1.0f / sqrtf(ss * (1.0f / GDV) + RMS_EPS);
        const f32x4* gp = (const f32x4*)(F.gnorm_g + c0); const f32x4 g0 = gp[0], g1 = gp[1];
        const v4u grw = *(const v4u*)(F.PROJ + (size_t)t * NPROJ + COL_GR + c0);
        const float gr[8] = {bflo(grw.x), bfhi(grw.x), bflo(grw.y), bfhi(grw.y), bflo(grw.z), bfhi(grw.z), bflo(grw.w), bfhi(grw.w)};
        const float ov[8] = {a.x, a.y, a.z, a.w, b.x, b.y, b.z, b.w}; const float gg[8] = {g0.x, g0.y, g0.z, g0.w, g1.x, g1.y, g1.z, g1.w};
        float r[8];
#pragma unroll
        for (int i = 0; i < 8; ++i) { const float sl = gr[i] / (1.0f + __expf(-gr[i])); r[i] = ov[i] * inv * gg[i] * sl; }
        v4u w; w.x = pk2(r[0], r[1]); w.y = pk2(r[2], r[3]); w.z = pk2(r[4], r[5]); w.w = pk2(r[6], r[7]);
        *(v4u*)(F.OMIX + (size_t)t * D + 512 + c0) = w;
    }
}
__device__ __forceinline__ void p5_outproj_base(Frame& F) {
    const int r = F.lane & 31, h = F.lane >> 5;
    constexpr int NT = D / 32, MT = T / 32;
    for (int it = F.gw; it < MT * NT; it += F.NGW) {
        const int mt = it / NT, nt = it % NT;
        const f32x16 acc = tile32(F.OMIX + (size_t)(mt * 32 + r) * D, F.WoutT + (size_t)(nt * 32 + r) * D, D, h);
#pragma unroll
        for (int i = 0; i < 16; ++i) { const size_t idx = (size_t)(mt * 32 + crow(i, h)) * D + nt * 32 + r; F.X1[idx] = F.x[idx] + acc[i]; }
    }
}
__device__ __forceinline__ void p6_route(Frame& F) {
    for (int t = F.gw; t < T; t += F.NGW) {
        const GAS f32x4* xr = (const GAS f32x4*)(F.X1 + (size_t)t * D) + F.lane; const GAS f32x4* gr = (const GAS f32x4*)F.ln2_g + F.lane;
        f32x4 v[4]; float s = 0.f;
#pragma unroll
        for (int j = 0; j < 4; ++j) { v[j] = xr[64 * j]; s += (v[j].x * v[j].x + v[j].y * v[j].y) + (v[j].z * v[j].z + v[j].w * v[j].w); }
        const float inv = 1.0f / sqrtf(wave_sum(s) * (1.f / D) + RMS_EPS);
        GAS unsigned long long* o8 = (GAS unsigned long long*)(F.H2 + (size_t)t * D) + F.lane;
#pragma unroll
        for (int j = 0; j < 4; ++j) { const f32x4 gg = gr[64 * j]; v[j].x = v[j].x * inv * gg.x; v[j].y = v[j].y * inv * gg.y; v[j].z = v[j].z * inv * gg.z; v[j].w = v[j].w * inv * gg.w;
            o8[64 * j] = (unsigned long long)pk2(v[j].x, v[j].y) | ((unsigned long long)pk2(v[j].z, v[j].w) << 32); }
        float lg[NGRP], le[NE];
#pragma unroll
        for (int c = 0; c < NGRP; ++c) lg[c] = 0.f;
#pragma unroll
        for (int c = 0; c < NE; ++c) le[c] = 0.f;
#pragma unroll 1
        for (int jq = 0; jq < 16; ++jq) { const int j = jq >> 2, q = jq & 3;
            const f32x4 vj = j == 0 ? v[0] : (j == 1 ? v[1] : (j == 2 ? v[2] : v[3]));
            const float hv = q == 0 ? vj.x : (q == 1 ? vj.y : (q == 2 ? vj.z : vj.w));
            const int k = 4 * (64 * j + F.lane) + q;
            const f32x4 wg = *(const f32x4*)(F.w_group + (size_t)k * NGRP);
            lg[0] += hv * wg.x; lg[1] += hv * wg.y; lg[2] += hv * wg.z; lg[3] += hv * wg.w;
            const f32x4* we = (const f32x4*)(F.w_expert + (size_t)k * NE);
#pragma unroll
            for (int c4 = 0; c4 < NE / 4; ++c4) { const f32x4 w = we[c4]; le[4 * c4] += hv * w.x; le[4 * c4 + 1] += hv * w.y; le[4 * c4 + 2] += hv * w.z; le[4 * c4 + 3] += hv * w.w; } }
#pragma unroll
        for (int c = 0; c < NGRP; ++c) lg[c] = wave_sum(lg[c]) + F.b_group[c];
#pragma unroll
        for (int c = 0; c < NE; ++c) le[c] = wave_sum(le[c]) + F.b_expert[c];
        int gi = 0; float gm = lg[0];
#pragma unroll
        for (int c = 1; c < NGRP; ++c) if (lg[c] > gm) { gm = lg[c]; gi = c; }
        float gs = 0.f;
#pragma unroll
        for (int c = 0; c < NGRP; ++c) gs += __expf(lg[c] - gm);
        const float gp = 1.0f / gs;
        float sel[EPG];
#pragma unroll
        for (int i = 0; i < EPG; ++i) { sel[i] = le[i];
#pragma unroll
            for (int g = 1; g < NGRP; ++g) sel[i] = (gi == g) ? le[g * EPG + i] : sel[i]; }
        int i1 = 0; float m1 = sel[0];
#pragma unroll
        for (int i = 1; i < EPG; ++i) if (sel[i] > m1) { m1 = sel[i]; i1 = i; }
        int i2 = -1; float m2 = -3.0e38f;
#pragma unroll
        for (int i = 0; i < EPG; ++i) if (i != i1 && sel[i] > m2) { m2 = sel[i]; i2 = i; }
        const float e21 = __expf(m2 - m1); const float w1 = 1.0f / (1.0f + e21), w2 = e21 * w1;
        if (F.lane == 0) {
            const int e1 = gi * EPG + i1, e2 = gi * EPG + i2;
            const int r1 = (int)__hip_atomic_fetch_add(F.cnt + e1, 1u, RLX_AGENT), r2 = (int)__hip_atomic_fetch_add(F.cnt + e2, 1u, RLX_AGENT);
            F.toklist[e1 * CAP + r1] = t; F.toklist[e2 * CAP + r2] = t;
            *(int4*)(F.tokinfo + 8 * t) = make_int4(e1, r1, e2, r2);
            *(int4*)(F.tokinfo + 8 * t + 4) = make_int4(__float_as_int(gp * w1), __float_as_int(gp * w2), 0, 0);
        }
    }
}

typedef float f32x1;
__device__ __forceinline__ void p6_route_fast(Frame& F, unsigned* cntp) {
    const int lane = F.lane, r = lane & 31, hh = lane >> 5;
    const int grp = F.wave >> 2, kq = F.wave & 3;
    LAS float* part = (LAS float*)(F.lds + RING_OFF);
    LAS unsigned* lcnt = (LAS unsigned*)(F.lds + RING_OFF + 49152); LAS unsigned* lbase = lcnt + 32;
    if (F.tid < NE) lcnt[F.tid] = 0u;
    __syncthreads();
    for (int blk0 = F.vcu * 2; blk0 < T / 32; blk0 += F.G * 2) {
        const int blk = blk0 + grp; const bool valid = blk < T / 32;
        const size_t trow = (size_t)(valid ? blk : 0) * 32 + r;
        f32x16 ae, ag;
#pragma unroll
        for (int i = 0; i < 16; ++i) { ae[i] = 0.f; ag[i] = 0.f; }
        float ssq = 0.f;
        const float* xp = F.X1 + trow * D + kq * 256 + 4 * hh;
        const float* bep = F.WrT + (size_t)r * D + kq * 256 + 4 * hh; const float* bgp = F.WrT + (size_t)(32 + r) * D + kq * 256 + 4 * hh;
        f32x4 cx[4], ce[4], cg[4], nx[4], ne_[4], ng[4];
#pragma unroll
        for (int j = 0; j < 4; ++j) { nx[j] = *(const f32x4*)(xp + 8 * j); ne_[j] = *(const f32x4*)(bep + 8 * j); ng[j] = *(const f32x4*)(bgp + 8 * j); }
#pragma unroll 1
        for (int mg = 0; mg < 8; ++mg) {
#pragma unroll
            for (int j = 0; j < 4; ++j) { cx[j] = nx[j]; ce[j] = ne_[j]; cg[j] = ng[j]; }
            const int mn = (mg < 7 ? mg + 1 : mg) * 32;
#pragma unroll
            for (int j = 0; j < 4; ++j) { nx[j] = *(const f32x4*)(xp + mn + 8 * j); ne_[j] = *(const f32x4*)(bep + mn + 8 * j); ng[j] = *(const f32x4*)(bgp + mn + 8 * j); }
#pragma unroll
            for (int j = 0; j < 4; ++j) { const f32x4 xv = cx[j];
                ssq += (xv.x * xv.x + xv.y * xv.y) + (xv.z * xv.z + xv.w * xv.w);
#pragma unroll
                for (int q = 0; q < 4; ++q) { ae = __builtin_amdgcn_mfma_f32_32x32x2f32(xv[q], ce[j][q], ae, 0, 0, 0); ag = __builtin_amdgcn_mfma_f32_32x32x2f32(xv[q], cg[j][q], ag, 0, 0, 0); } }
        }
        ssq += __shfl_xor(ssq, 32);
        LAS float* pe = part + (size_t)((grp * 4 + kq) * 32) * 40;
#pragma unroll
        for (int i = 0; i < 16; ++i) { const int tk = crow(i, hh); pe[tk * 40 + r] = ae[i]; if (r < NGRP) pe[tk * 40 + 32 + r] = ag[i]; }
        if (hh == 0) pe[r * 40 + 36] = ssq;
        __syncthreads();
        const bool router = (kq == 0 && lane < 32 && valid);
        int e1 = 0, e2 = 0, lr1 = 0, lr2 = 0; float gt1 = 0.f, gt2 = 0.f, tinv = 0.f;
        if (router) {
            const LAS float* p0 = part + (size_t)(grp * 4 * 32 + lane) * 40;
            const float ss = (p0[36] + p0[1280 + 36]) + (p0[2560 + 36] + p0[3840 + 36]);
            const float inv = 1.0f / sqrtf(ss * (1.f / D) + RMS_EPS);
            float lg[NGRP];
#pragma unroll
            for (int c = 0; c < NGRP; ++c) lg[c] = ((p0[32 + c] + p0[1280 + 32 + c]) + (p0[2560 + 32 + c] + p0[3840 + 32 + c])) * inv + F.b_group[c];
            int gi = 0; float gm = lg[0];
#pragma unroll
            for (int c = 1; c < NGRP; ++c) if (lg[c] > gm) { gm = lg[c]; gi = c; }
            float gs = 0.f;
#pragma unroll
            for (int c = 0; c < NGRP; ++c) gs += __expf(lg[c] - gm);
            const float gp = 1.0f / gs;
            float sel[EPG];
#pragma unroll
            for (int i = 0; i < EPG; ++i) { const int c = gi * EPG + i; sel[i] = ((p0[c] + p0[1280 + c]) + (p0[2560 + c] + p0[3840 + c])) * inv + F.b_expert[c]; }
            int i1 = 0; float m1 = sel[0];
#pragma unroll
            for (int i = 1; i < EPG; ++i) if (sel[i] > m1) { m1 = sel[i]; i1 = i; }
            int i2 = -1; float m2 = -3.0e38f;
#pragma unroll
            for (int i = 0; i < EPG; ++i) if (i != i1 && sel[i] > m2) { m2 = sel[i]; i2 = i; }
            const float e21 = __expf(m2 - m1); const float w1 = 1.0f / (1.0f + e21), w2 = e21 * w1;
            e1 = gi * EPG + i1; e2 = gi * EPG + i2; gt1 = gp * w1; gt2 = gp * w2; tinv = inv;
            lr1 = (int)__hip_atomic_fetch_add(lcnt + e1, 1u, __ATOMIC_RELAXED, __HIP_MEMORY_SCOPE_WORKGROUP); lr2 = (int)__hip_atomic_fetch_add(lcnt + e2, 1u, __ATOMIC_RELAXED, __HIP_MEMORY_SCOPE_WORKGROUP);
        }
        __syncthreads();
        if (F.tid < NE) { const unsigned n = lcnt[F.tid]; if (n) lbase[F.tid] = __hip_atomic_fetch_add(cntp + CNT_STRIDE * F.tid, n, RLX_AGENT); }
        __syncthreads();
        if (router) {
            const int t = blk * 32 + lane; const int r1 = (int)lbase[e1] + lr1, r2 = (int)lbase[e2] + lr2;
            F.toklist[e1 * CAP + r1] = t; F.toklist[e2 * CAP + r2] = t; F.invlist[e1 * CAP + r1] = tinv; F.invlist[e2 * CAP + r2] = tinv;
            *(int4*)(F.tokinfo + 8 * t) = make_int4(e1, r1, e2, r2);
            *(int4*)(F.tokinfo + 8 * t + 4) = make_int4(__float_as_int(gt1), __float_as_int(gt2), 0, 0);
        }
        __syncthreads();
        if (F.tid < NE) lcnt[F.tid] = 0u;
        __syncthreads();
    }
}

__device__ __forceinline__ void load_emap(Frame& F, int& cnt_l, int& pst_l, int& cend32_l) {
    const int e = F.lane & 31;
    cnt_l = (int)__hip_atomic_load(F.cnt + CNT_STRIDE * e, RLX_AGENT);
    int p = (cnt_l + 255) & ~255, c = (cnt_l + 31) >> 5;
#pragma unroll
    for (int o = 1; o < 32; o <<= 1) { const int pp = __shfl_up(p, o), cc = __shfl_up(c, o); if (e >= o) { p += pp; c += cc; } }
    pst_l = p - ((cnt_l + 255) & ~255); cend32_l = c;
}
__device__ __forceinline__ void p7_gateup_base(Frame& F) {
    const int r = F.lane & 31, h = F.lane >> 5;
    int cnt_l, pst_l, cend_l; load_emap(F, cnt_l, pst_l, cend_l);
    const int total = __shfl(cend_l, 31) * (DFF / 32);
    for (int it = F.gw; it < total; it += F.NGW) {
        const int g = it / (DFF / 32), nt = it % (DFF / 32);
        const int e = __popcll(__ballot(F.lane < 32 && cend_l <= g));
        const int base = e > 0 ? __shfl(cend_l, e - 1) : 0;
        const int mt = g - base; const int n_e = __shfl(cnt_l, e); const int ps = __shfl(pst_l, e);
        const int idx = mt * 32 + r; const int tok = idx < n_e ? F.toklist[e * CAP + idx] : 0;
        const int hc = nt * 32 + r; const size_t brow = (size_t)e * 1024 + (size_t)(hc / 128) * 256 + (hc % 128);
        const f32x16 ag = tile32(F.H2 + (size_t)tok * D, F.WguT + brow * D, D, h);
        const f32x16 au = tile32(F.H2 + (size_t)tok * D, F.WguT + (brow + 128) * D, D, h);
#pragma unroll
        for (int i = 0; i < 16; ++i) { const int rr = mt * 32 + crow(i, h);
            if (rr < n_e) { const float gv = ag[i]; const float hv = gv / (1.0f + __expf(-gv)) * au[i]; F.HBUF[(size_t)(ps + rr) * DFF + hc] = (bf16)f2bf(hv); } }
    }
}
__device__ __forceinline__ void p8_down_base(Frame& F) {
    const int r = F.lane & 31, h = F.lane >> 5;
    int cnt_l, pst_l, cend_l; load_emap(F, cnt_l, pst_l, cend_l);
    const int total = __shfl(cend_l, 31) * (D / 32);
    for (int it = F.gw; it < total; it += F.NGW) {
        const int g = it / (D / 32), nt = it % (D / 32);
        const int e = __popcll(__ballot(F.lane < 32 && cend_l <= g));
        const int base = e > 0 ? __shfl(cend_l, e - 1) : 0;
        const int mt = g - base; const int n_e = __shfl(cnt_l, e); const int ps = __shfl(pst_l, e);
        int idx = mt * 32 + r; if (idx >= n_e) idx = n_e - 1;
        const f32x16 acc = tile32(F.HBUF + (size_t)(ps + idx) * DFF, F.WdT + ((size_t)e * 1024 + nt * 32 + r) * DFF, DFF, h);
#pragma unroll
        for (int i = 0; i < 16; ++i) { const int rr = mt * 32 + crow(i, h);
            if (rr < n_e) F.Y[(size_t)(ps + rr) * D + nt * 32 + r] = (bf16)f2bf(acc[i]); }
    }
}
__device__ __forceinline__ void p9_final(Frame& F, const bool do_store) {
    const int lane = F.lane;
    int cnt_l, pst_l, cend_l; load_emap(F, cnt_l, pst_l, cend_l);
    const int nrow = (T - F.gw + F.NGW - 1) / F.NGW;
    for (int i0 = 0; i0 < nrow; i0 += 32) {
        int4 ti = make_int4(0, 0, 0, 0), tg = make_int4(0, 0, 0, 0);
        { const int i = i0 + (lane & 31); if (i < nrow) { const int t = F.gw + i * F.NGW; ti = *(const int4*)(F.tokinfo + 8 * t); tg = *(const int4*)(F.tokinfo + 8 * t + 4); } }
        const int s1l = __shfl(pst_l, ti.x) + ti.y, s2l = __shfl(pst_l, ti.z) + ti.w;
        const int nloc = (nrow - i0) < 32 ? (nrow - i0) : 32;
        for (int ii = 0; ii < nloc; ii += 2) {
            const bool two = (ii + 1) < nloc;
            f32x4 v[2][4]; v2u ya[2][4], yb[2][4]; float g1[2], g2[2]; GAS f32x4* xr[2];
#pragma unroll
            for (int u = 0; u < 2; ++u) { const int iu = (u == 1 && !two) ? ii : ii + u;
                const int t = F.gw + (i0 + iu) * F.NGW;
                const int s1 = __shfl(s1l, iu), s2 = __shfl(s2l, iu); g1[u] = __int_as_float(__shfl(tg.x, iu)); g2[u] = __int_as_float(__shfl(tg.y, iu));
                xr[u] = (GAS f32x4*)(F.X1 + (size_t)t * D) + lane;
                const GAS v2u* y1 = (const GAS v2u*)(F.Y + (size_t)s1 * D) + lane; const GAS v2u* y2 = (const GAS v2u*)(F.Y + (size_t)s2 * D) + lane;
#pragma unroll
                for (int j = 0; j < 4; ++j) { v[u][j] = xr[u][64 * j]; ya[u][j] = y1[64 * j]; yb[u][j] = y2[64 * j]; } }
#pragma unroll
            for (int u = 0; u < 2; ++u) {
                if (u == 1 && !two) break;
                float s = 0.f;
#pragma unroll
                for (int j = 0; j < 4; ++j) { const v2u a = ya[u][j], b = yb[u][j];
                    v[u][j].x += g1[u] * bflo(a.x) + g2[u] * bflo(b.x); v[u][j].y += g1[u] * bfhi(a.x) + g2[u] * bfhi(b.x); v[u][j].z += g1[u] * bflo(a.y) + g2[u] * bflo(b.y); v[u][j].w += g1[u] * bfhi(a.y) + g2[u] * bfhi(b.y);
                    s += (v[u][j].x * v[u][j].x + v[u][j].y * v[u][j].y) + (v[u][j].z * v[u][j].z + v[u][j].w * v[u][j].w); }
                const float inv = 1.0f / sqrtf(wave_sum(s) * (1.f / D) + RMS_EPS);
                const GAS f32x4* gr = (const GAS f32x4*)F.lnf_g + lane;
#pragma unroll
                for (int j = 0; j < 4; ++j) { const f32x4 gg = gr[64 * j]; f32x4 o; o.x = v[u][j].x * inv * gg.x; o.y = v[u][j].y * inv * gg.y; o.z = v[u][j].z * inv * gg.z; o.w = v[u][j].w * inv * gg.w; if (do_store) xr[u][64 * j] = o; else asm volatile("" :: "v"(o.x), "v"(o.y), "v"(o.z), "v"(o.w)); }
            }
        }
    }
}

__device__ __forceinline__ void load_emap256(Frame& F, int& cnt_l, int& pst_l, int& cend_l) {
    const int e = F.lane & 31;
    cnt_l = (int)__hip_atomic_load(F.cnt + CNT_STRIDE * e, RLX_AGENT);
    int c = (cnt_l + 255) >> 8;
#pragma unroll
    for (int o = 1; o < 32; o <<= 1) { const int cc = __shfl_up(c, o); if (e >= o) c += cc; }
    cend_l = c; pst_l = (c - ((cnt_l + 255) >> 8)) * 256;
}
__device__ __forceinline__ void p1_proj_pg8(Frame& F) {
    pg8::Gemm g{F.XN, F.WinT, T, NPROJ, D}; pg8::StaticOrder S; S.init(T, NPROJ, F.G, (int)blockIdx.x);
    pg8::EpiProj E{F.PROJ};
    pg8::gemm_phase<pg8::EpiProj, pg8::StaticOrder, true, false>(F.lds + RING_OFF, g, S, E);
}
__device__ __forceinline__ void p5_outproj_pg8(Frame& F) {
    pg8::Gemm g{F.OMIX, F.WoutT, T, D, D}; pg8::StaticOrder S; S.init(T, D, F.G, (int)blockIdx.x);
    pg8::EpiResid E{F.x, F.X1, F.ln2_g, F.H2};
    pg8::gemm_phase<pg8::EpiResid, pg8::StaticOrder, false, false>(F.lds + RING_OFF, g, S, E);
}
constexpr int EMAP_OFF = LDSCTL_OFF + 1024;
__device__ __forceinline__ void moe_order_init(Frame& F, pg8::MoeOrder& S) {
    LAS int* tab = (LAS int*)(F.lds + EMAP_OFF);
    if (F.wave == 0) { int cnt_l, pst_l, cend_l; load_emap256(F, cnt_l, pst_l, cend_l); if (F.lane < 32) { tab[F.lane] = cnt_l; tab[32 + F.lane] = pst_l; tab[64 + F.lane] = cend_l; } }
    __syncthreads();
    S.G = F.G; S.c = (int)blockIdx.x; S.toklist = F.toklist; S.tab = tab; S.MT = __builtin_amdgcn_readfirstlane(tab[64 + 31]); S.nwg = S.MT * 4;
}
__device__ __forceinline__ void p7_gateup_pg8(Frame& F) {
    pg8::MoeOrder S; moe_order_init(F, S);
    pg8::Gemm g{F.H2, F.WguT, 0, 0, D}; pg8::EpiGateUp E{F.HBUF, F.invlist};
    pg8::gemm_phase<pg8::EpiGateUp, pg8::MoeOrder, true, true>(F.lds + RING_OFF, g, S, E);
}
__device__ __forceinline__ void p8_down_pg8(Frame& F) {
    pg8::MoeOrder S; moe_order_init(F, S);
    pg8::Gemm g{F.HBUF, F.WdT, 0, 0, DFF}; pg8::EpiY E{F.Y};
    pg8::gemm_phase<pg8::EpiY, pg8::MoeOrder, true, false>(F.lds + RING_OFF, g, S, E);
}

#ifndef REPEAT_PHASE
#define REPEAT_PHASE -1
#endif
#ifndef USE_GLAFAST
#define USE_GLAFAST 1
#endif
#ifndef USE_SBFAST
#define USE_SBFAST 1
#endif
#ifndef USE_PG8
#define USE_PG8 15
#endif
constexpr int NPHASE = 10;
struct Args { const float* in[16]; float* out; unsigned char* ws; int ph_lo, ph_hi, li, pad; };
__global__ void __launch_bounds__(NWAVES * 64, 2) mk_fwd(Args args) {
    extern __shared__ __attribute__((aligned(16))) unsigned char lds[];
    Frame F;
    F.lds = (LAS unsigned char*)lds;
    F.MISC = (volatile LAS unsigned*)(F.lds + MISC_OFF);
    F.tid = threadIdx.x; F.lane = F.tid & 63; F.wave = __builtin_amdgcn_readfirstlane(F.tid >> 6);
    F.G = gridDim.x; { const int bx = blockIdx.x; F.vcu = (F.G % 8 == 0) ? (bx % 8) * (F.G / 8) + bx / 8 : bx; }
    F.gw = F.vcu * NWAVES + F.wave; F.NGW = F.G * NWAVES;
    unsigned char* ws = args.ws; F.ws = ws;
    F.ctl = (gu32*)(ws + WS_CTL);
    F.x = args.in[0]; F.ln1_g = args.in[1]; F.w_in = args.in[2]; F.gate_w2 = args.in[3]; F.gate_b = args.in[4]; F.gnorm_g = args.in[5]; F.w_out = args.in[6]; F.ln2_g = args.in[7];
    F.w_group = args.in[8]; F.b_group = args.in[9]; F.w_expert = args.in[10]; F.b_expert = args.in[11]; F.ew_gate = args.in[12]; F.ew_up = args.in[13]; F.ew_down = args.in[14]; F.lnf_g = args.in[15];
    F.out = args.out;
    F.WinT = (bf16*)(ws + WS_WIN); F.WoutT = (bf16*)(ws + WS_WOUT); F.WguT = (bf16*)(ws + WS_WGU); F.WdT = (bf16*)(ws + WS_WD);
    F.XN = (bf16*)(ws + WS_R1); F.OMIX = (bf16*)(ws + WS_R1); F.H2 = (bf16*)(ws + WS_R2);
    F.PROJ = (bf16*)(ws + WS_R2); F.HBUF = (bf16*)(ws + WS_R2 + 32 * MiB); F.Y = (bf16*)(ws + WS_Y);
    F.GLR = (float*)(ws + WS_GLR); F.LOGA = (float*)((unsigned char*)args.out + DO_LOGA); F.OG = (float*)((unsigned char*)args.out + DO_OG); F.X1 = args.out; F.DS = F.OG; F.DEC = (float*)(ws + WS_DEC); F.WrT = (float*)(ws + WS_WRT); F.ST = (bf16*)((unsigned char*)args.out + DO_ST);
    F.toklist = (int*)(ws + WS_TOKLIST); F.gatelist = (float*)(ws + WS_GATELIST); F.invlist = (float*)(ws + WS_GATELIST); F.tokinfo = (int*)(ws + WS_TOKINFO); F.cnt = (unsigned*)(ws + WS_CTL) + CW_CNT;
    for (int u = F.tid; u < (LDS_BYTES - LDSCTL_OFF) / 4; u += NWAVES * 64) ((LAS unsigned*)(F.lds + LDSCTL_OFF))[u] = 0u;
    __syncthreads();
    XcdBarrier bar = xcd_barrier_post((unsigned*)(F.ctl + CW_BAR) + args.li * XCD_BAR_WORDS, F.MISC + 8);
    const int lo = args.ph_lo, hi = args.ph_hi;
#define IN(k) (lo <= (k) && (k) < hi)
#define SEAM(k) do { if (IN(k) && IN((k) + 1)) xcd_barrier(bar); } while (0)
#define STEP(code, body) do { body; if (REPEAT_PHASE == (code)) { xcd_barrier(bar); body; } } while (0)
    if (IN(0)) { STEP(0, p0_prologue(F)); } SEAM(0);
    if (IN(1)) { STEP(10, p1_proj_pg8(F)); STEP(11, p1_loga(F)); } SEAM(1);
    if (IN(2)) { STEP(20, p2_sb_fast(F)); STEP(21, gla_pass_a(F)); } SEAM(2);
    if (IN(3)) { STEP(30, gla_pass_b(F)); } SEAM(3);
    if (IN(4)) { STEP(40, gla_pass_c(F)); } SEAM(4);
    if (IN(5)) { STEP(50, p5_outproj_pg8(F)); } SEAM(5);
    if (IN(6)) { if (REPEAT_PHASE == 60) { p6_route_fast(F, F.cnt + 1024); xcd_barrier(bar); } p6_route_fast(F, F.cnt); } SEAM(6);
    if (IN(7)) { STEP(70, p7_gateup_pg8(F)); } SEAM(7);
    if (IN(8)) { STEP(80, p8_down_pg8(F)); } SEAM(8);
    if (IN(9)) { if (REPEAT_PHASE == 90) { p9_final(F, false); xcd_barrier(bar); } if (REPEAT_PHASE == 99) { for (int i = 0; i < 10; ++i) xcd_barrier(bar); } p9_final(F, true); }
#undef STEP
#undef IN
#undef SEAM
}

#ifndef MK_ONE_LAUNCH
#define MK_ONE_LAUNCH 1
#endif
extern "C" void kernel_launch(void* const* d_in, const int* in_sizes, int n_in, void* d_out, int out_size, void* d_ws, size_t ws_size, hipStream_t stream) {
    static int grid = 0;
    if (grid == 0) {
        if (n_in != 16 || in_sizes[0] != T * D || out_size != T * D || ws_size < WS_END) {
            fprintf(stderr, "kernel_launch: unexpected shapes / workspace (n_in %d, in0 %d, out %d, ws %zu, need %zu); nothing launched\n", n_in, n_in > 0 ? in_sizes[0] : -1, out_size, ws_size, (size_t)WS_END); grid = -1; return; }
        int dev = 0, cus = 0, per_cu = 0;
        if (hipGetDevice(&dev) != hipSuccess || hipDeviceGetAttribute(&cus, hipDeviceAttributeMultiprocessorCount, dev) != hipSuccess) { grid = -1; return; }
        if (hipFuncSetAttribute((const void*)mk_fwd, hipFuncAttributeMaxDynamicSharedMemorySize, LDS_BYTES) != hipSuccess) { fprintf(stderr, "kernel_launch: hipFuncSetAttribute failed\n"); grid = -1; return; }
        if (hipOccupancyMaxActiveBlocksPerMultiprocessor(&per_cu, (const void*)mk_fwd, NWAVES * 64, LDS_BYTES) != hipSuccess || per_cu < 1) { fprintf(stderr, "kernel_launch: occupancy query says %d\n", per_cu); per_cu = 1; }
        (void)hipGetLastError();
        grid = cus;
    }
    if (grid < 0) return;
    (void)hipMemsetAsync((char*)d_ws + WS_CTL, 0, CTL_ZERO_BYTES, stream);
    Args a{};
    for (int i = 0; i < 16; ++i) a.in[i] = (const float*)d_in[i];
    a.out = (float*)d_out; a.ws = (unsigned char*)d_ws;
#if MK_ONE_LAUNCH
    a.ph_lo = 0; a.ph_hi = NPHASE; a.li = 0;
    { void* kargs[] = {&a}; hipError_t e = hipLaunchCooperativeKernel((const void*)mk_fwd, dim3(grid), dim3(NWAVES * 64), kargs, LDS_BYTES, stream);
      if (e != hipSuccess) fprintf(stderr, "kernel_launch: cooperative launch failed: %s\n", hipGetErrorString(e)); }
#else
    for (int p = 0; p < NPHASE; ++p) { a.ph_lo = p; a.ph_hi = p + 1; a.li = 0; hipLaunchKernelGGL(mk_fwd, dim3(grid), dim3(NWAVES * 64), LDS_BYTES, stream, a); }
#endif
}
```

```cpp
#include <hip/hip_runtime.h>
#include <cstdio>
#include <cstdint>

#define GAS __attribute__((address_space(1)))
#define LAS __attribute__((address_space(3)))
typedef unsigned short bf16;
typedef short bf16x8 __attribute__((ext_vector_type(8)));
typedef float f32x4 __attribute__((ext_vector_type(4)));
typedef float f32x16 __attribute__((ext_vector_type(16)));
typedef unsigned v4u __attribute__((ext_vector_type(4)));
typedef unsigned v2u __attribute__((ext_vector_type(2)));
typedef GAS unsigned gu32;
#define RLX_AGENT __ATOMIC_RELAXED, __HIP_MEMORY_SCOPE_AGENT
#define LDS_WAIT() asm volatile("s_waitcnt lgkmcnt(0)" ::: "memory")
#define VM_WAIT() asm volatile("s_waitcnt vmcnt(0)" ::: "memory")

constexpr int BATCH = 4, SEQ = 4096, T = BATCH * SEQ, D = 1024, DIN = 3088, NPROJ = 3072;
constexpr int SBH = 8, SBD = 64, GH = 4, GDK = 64, GDV = 128, GRANK = 16;
constexpr int NE = 32, EPG = 8, NGRP = 4, DFF = 512;
constexpr int COL_SBQ = 0, COL_SBK = 512, COL_SBV = 1024, COL_GQ = 1536, COL_GK = 1792, COL_GV = 2048, COL_GR = 2560, COL_GLR = 3072;
constexpr float RMS_EPS = 1e-6f;
constexpr float LOG2E = 1.4426950408889634f;
constexpr float SBQ_SCALE = 0.125f * LOG2E;
constexpr float GQ_SCALE = 0.125f;
constexpr int NWAVES = 8;
constexpr int CAP = T;

constexpr size_t MiB = 1u << 20;
constexpr size_t WS_CTL = 0, CTL_ZERO_BYTES = 1 * MiB;
constexpr size_t WS_TOKLIST = 1 * MiB;
constexpr size_t WS_GATELIST = 3 * MiB;
constexpr size_t WS_TOKINFO = 5 * MiB;
constexpr size_t WS_GLR = 6 * MiB;
constexpr size_t WS_WRT = 7 * MiB + 512 * 1024;
constexpr size_t WS_DEC = 7 * MiB;
constexpr size_t WS_WIN = 8 * MiB;
constexpr size_t WS_WOUT = 15 * MiB;
constexpr size_t WS_WD = 17 * MiB;
constexpr size_t WS_WGU = 49 * MiB;
constexpr size_t WS_R1 = 113 * MiB;
constexpr size_t WS_R2 = 153 * MiB;
constexpr size_t WS_Y = WS_WGU;
constexpr size_t WS_END = 249 * MiB;
constexpr size_t DO_LOGA = 0;
constexpr size_t DO_OG = 16 * MiB;
constexpr size_t DO_ST = 48 * MiB;
constexpr int CW_TMO = 0, CW_CODE = 1;
constexpr int CW_CNT = 1024, CNT_STRIDE = 32;
constexpr int CW_BAR = 4096;

constexpr int RING_OFF = 0, RING_BYTES = 131072;
constexpr int WAVE_LDS = 18432;
constexpr int LDSCTL_OFF = 8 * WAVE_LDS, MISC_OFF = LDSCTL_OFF + 320;
constexpr int LDS_BYTES = LDSCTL_OFF + 4096;

__device__ __forceinline__ unsigned f2bf(float f) { unsigned u = __builtin_bit_cast(unsigned, f); return (u + 0x7fffu + ((u >> 16) & 1u)) >> 16; }
__device__ __forceinline__ unsigned pk2(float lo, float hi) { return f2bf(lo) | (f2bf(hi) << 16); }
__device__ __forceinline__ float bf2f(unsigned b) { return __builtin_bit_cast(float, b << 16); }
__device__ __forceinline__ float bflo(unsigned w) { return __builtin_bit_cast(float, w << 16); }
__device__ __forceinline__ float bfhi(unsigned w) { return __builtin_bit_cast(float, w & 0xffff0000u); }
__device__ __forceinline__ int crow(int r, int hi) { return (r & 3) + 8 * (r >> 2) + 4 * hi; }
__device__ __forceinline__ float wave_sum(float v) {
#pragma unroll
    for (int o = 1; o < 64; o <<= 1) v += __shfl_xor(v, o);
    return v;
}

#define XB_TMO      128
#define XB_XCNT(j)  (256  + 64 * (j))
#define XB_XSUB(j)  (1280 + 64 * (j))
#define XB_XGEN(j)  (2304 + 64 * (j))
#define XB_TOP      3328
#define XB_TOPGEN   3392
#define XCD_BAR_WORDS 3456
#define XB_SPIN_CAP (1u << 18)
__device__ __forceinline__ unsigned xb_ld(unsigned* p)              { return __hip_atomic_load(p, __ATOMIC_RELAXED, __HIP_MEMORY_SCOPE_AGENT); }
__device__ __forceinline__ unsigned xb_add(unsigned* p, unsigned v) { return __hip_atomic_fetch_add(p, v, __ATOMIC_RELAXED, __HIP_MEMORY_SCOPE_AGENT); }
__device__ __forceinline__ unsigned xb_xcc_id() { return (unsigned)__builtin_amdgcn_s_getreg((3 << 11) | 20) & 0xFu; }
#define XB_SPIN(cond, bar) do { unsigned _sp = 0; while (cond) { __builtin_amdgcn_s_sleep(1); \
    if ((++_sp & 255u) == 0u) { if (xb_ld(&(bar)[XB_TMO])) break; if (_sp > XB_SPIN_CAP) { atomicAdd(&(bar)[XB_TMO], 1u); break; } } } } while (0)
struct XcdBarrier { unsigned* bar; unsigned x; volatile LAS unsigned* st; };
__device__ __forceinline__ XcdBarrier xcd_barrier_post(unsigned* bar, volatile LAS unsigned* st) {
    XcdBarrier b; b.bar = bar; b.x = xb_xcc_id(); b.st = st;
    if (threadIdx.x == 0) (void)xb_add(&bar[XB_XCNT(b.x)], 1u);
    return b;
}
__device__ __forceinline__ void xcd_barrier_complete(unsigned* bar, unsigned x, unsigned& nloc, unsigned& nx) {
    const unsigned G = gridDim.x * gridDim.y * gridDim.z;
    unsigned sum, cnt, mine, sp = 0u;
    for (;;) {
        sum = 0u; cnt = 0u; mine = 0u;
#pragma unroll
        for (unsigned j = 0; j < 16; ++j) { const unsigned c = xb_ld(&bar[XB_XCNT(j)]); sum += c; cnt += (c > 0u) ? 1u : 0u; mine = (j == x) ? c : mine; }
        if (sum == G) break;
        __builtin_amdgcn_s_sleep(1);
        if ((++sp & 255u) == 0u) { if (xb_ld(&bar[XB_TMO])) break; if (sp > XB_SPIN_CAP) { atomicAdd(&bar[XB_TMO], 1u); break; } }
    }
    nloc = mine > 0u ? mine : 1u; nx = cnt > 0u ? cnt : 1u;
}
__device__ __forceinline__ void xcd_barrier(const XcdBarrier& b) {
    asm volatile("s_waitcnt vmcnt(0)" ::: "memory");
    __syncthreads();
    if (threadIdx.x == 0) {
        unsigned* bar = b.bar;
        __builtin_amdgcn_s_waitcnt(0);
        unsigned nloc = b.st[0], nx = b.st[1];
        if (nloc == 0u) { xcd_barrier_complete(bar, b.x, nloc, nx); b.st[0] = nloc; b.st[1] = nx; }
        const unsigned old = xb_add(&bar[XB_XSUB(b.x)], 1u);
        const unsigned gen = old / nloc;
        if (old + 1u == (gen + 1u) * nloc) {
            __builtin_amdgcn_fence(__ATOMIC_RELEASE, "agent");
            asm volatile("s_waitcnt vmcnt(0)" ::: "memory");
            const unsigned og = xb_add(&bar[XB_TOP], 1u);
            const unsigned tg = og / nx;
            if (og + 1u == (tg + 1u) * nx) xb_add(&bar[XB_TOPGEN], 1u);
            else XB_SPIN(xb_ld(&bar[XB_TOPGEN]) == tg, bar);
            __builtin_amdgcn_fence(__ATOMIC_ACQUIRE, "agent");
            xb_add(&bar[XB_XGEN(b.x)], 1u);
            asm volatile("s_waitcnt vmcnt(0)" ::: "memory");
        } else {
            XB_SPIN(xb_ld(&bar[XB_XGEN(b.x)]) == gen, bar);
            __builtin_amdgcn_fence(__ATOMIC_ACQUIRE, "agent");
            asm volatile("s_waitcnt vmcnt(0)" ::: "memory");
        }
    }
    __syncthreads();
}


namespace pg8 {
#define PG8_LAS __attribute__((address_space(3)))
typedef unsigned short bf16_t;
typedef unsigned u32x4 __attribute__((ext_vector_type(4)));
constexpr int BM = 256, BK = 64, HALF = 128, HTB = HALF * BK * 2, STAGE_BYTES = 8 * HTB, NXCD = 8, WGM = 8;
__host__ __device__ __forceinline__ int lds_byte(int r, int c) { const int st = (r >> 4) * 2 + (c >> 5), rr = r & 15, cc = c & 31, ob = rr * 64 + cc * 2; return st * 1024 + (ob ^ (((ob >> 9) & 1) << 5)); }
__host__ __device__ __forceinline__ void stage_rc(int b, int& R, int& C) { const int st = b / 1024, sb = b % 1024, swz = sb ^ (((sb >> 9) & 1) << 5); R = (st >> 1) * 16 + swz / 64; C = (st & 1) * 32 + (swz % 64) / 2; }
__host__ __device__ __forceinline__ int perm32(int rho) { const int n = rho >> 4, i = rho & 15; return 8 * (i >> 2) + 4 * n + (i & 3); }
struct Unit { int pm, pn, e, r0, ne; };
struct Gemm { const bf16_t* A; const bf16_t* Bt; int M, N, K; };
struct StaticOrder {
    int nM, nN, nwg, G, c;
    __device__ void init(int M, int N, int G_, int c_) { nM = M / BM; nN = N / BM; nwg = nM * nN; G = G_; c = c_; }
    __device__ __forceinline__ bool next(int i, Unit& u) const {
        const long L = (long)i * G + c; if (L >= nwg) return false;
        int wgid = (int)L; { const int q = nwg / NXCD, r = nwg % NXCD, xcd = wgid % NXCD, off = wgid / NXCD; wgid = (xcd < r ? xcd * (q + 1) : r * (q + 1) + (xcd - r) * q) + off; }
        const int nig = WGM * nN, gid = wgid / nig, fm = gid * WGM, gsz = (nM - fm) < WGM ? (nM - fm) : WGM;
        u.pm = fm + ((wgid % nig) % gsz); u.pn = (wgid % nig) / gsz; u.e = 0; u.r0 = 0; u.ne = 0; return true;
    }
    __device__ __forceinline__ int src_row(const Unit& u, int R) const { return u.pm * BM + R; }
};
__device__ __forceinline__ unsigned cvt_pk_bf16(float lo, float hi) { unsigned r; asm volatile("v_cvt_pk_bf16_f32 %0, %1, %2" : "=v"(r) : "v"(lo), "v"(hi)); return r; }

template <class Epi, class Sched, bool ALIGN_EPI, bool GATHER>
__device__ __forceinline__ void gemm_phase(PG8_LAS unsigned char* lds, const Gemm g, const Sched& S, const Epi& E) {
    const int tid = threadIdx.x, wid = __builtin_amdgcn_readfirstlane(tid >> 6), lane = tid & 63, wr = wid >> 2, wc = wid & 3, fr = lane & 15, fq = lane >> 4;
    const int K = g.K, nt = K / BK;
    int RA[2], CA[2]; unsigned voffB[2];
#pragma unroll
    for (int i = 0; i < 2; ++i) { int R, C; stage_rc(tid * 16 + i * 8192, R, C); const int Rb = Epi::PERM ? ((R & ~31) + perm32(R & 31)) : R;
        RA[i] = R; CA[i] = C; voffB[i] = (unsigned)(Rb * K + C) * 2u; }
    const size_t kstep = (size_t)(BK * 2);
    const size_t hstep = (size_t)HALF * K * 2;
    const size_t tstep = 2 * hstep;
    const unsigned ldsw = (unsigned)wid * 1024u;
    const int aoff = lds_byte(wr * 64 + fr, fq * 8), boff = lds_byte(wc * 32 + fr, fq * 8);
#define PG8_SA(b, h) (((b) * 2 + (h)) * HTB)
#define PG8_SB(b, h) ((4 + (b) * 2 + (h)) * HTB)
#define PG8_STAGE(bufoff, gbase, voff) do { _Pragma("unroll") for (int _i = 0; _i < 2; ++_i) \
        __builtin_amdgcn_global_load_lds((const unsigned*)((const char*)(gbase) + (voff)[_i]), (PG8_LAS unsigned*)(lds + (bufoff) + ldsw + _i * 8192), 16, 0, 0); } while (0)
#define PG8_LDA(dst, b, h) do { _Pragma("unroll") for (int m = 0; m < 4; ++m) _Pragma("unroll") for (int k = 0; k < 2; ++k) dst[m][k] = *(const PG8_LAS bf16x8*)(lds + PG8_SA(b, h) + aoff + m * 2048 + k * 1024); } while (0)
#define PG8_LDB(dst, b, h) do { _Pragma("unroll") for (int n = 0; n < 2; ++n) _Pragma("unroll") for (int k = 0; k < 2; ++k) dst[n][k] = *(const PG8_LAS bf16x8*)(lds + PG8_SB(b, h) + boff + n * 2048 + k * 1024); } while (0)
#define PG8_MMA(ai, bj, At, Bt) do { __builtin_amdgcn_s_setprio(1); _Pragma("unroll") for (int m = 0; m < 4; ++m) _Pragma("unroll") for (int n = 0; n < 2; ++n) _Pragma("unroll") for (int k = 0; k < 2; ++k) \
        acc[ai][bj][m][n] = __builtin_amdgcn_mfma_f32_16x16x32_bf16(Bt[n][k], At[m][k], acc[ai][bj][m][n], 0, 0, 0); __builtin_amdgcn_s_setprio(0); } while (0)
#define PG8_WAIT_V(n) asm volatile("s_waitcnt vmcnt(" #n ")" ::: "memory")
#define PG8_WAIT_L(n) asm volatile("s_waitcnt lgkmcnt(" #n ")" ::: "memory")
#define PG8_BAR __builtin_amdgcn_s_barrier()
#define PG8_SCHED __builtin_amdgcn_sched_barrier(0)
#define PG8_CALC_VA(dst, u) do { _Pragma("unroll") for (int _h = 0; _h < 2; ++_h) _Pragma("unroll") for (int _i = 0; _i < 2; ++_i) { \
        if constexpr (GATHER) dst[_h][_i] = (unsigned)(S.src_row(u, _h * HALF + RA[_i]) * K + CA[_i]) * 2u; \
        else dst[_h][_i] = (unsigned)((_h * HALF + RA[_i]) * K + CA[_i]) * 2u; } } while (0)
    Unit cur, nxt; int ui = 0;
    if (!S.next(0, cur)) return;
    f32x4 acc[2][2][4][2];
    E.init(acc, cur, wr, wc, fr, fq);
    bf16x8 At[4][2], B0[2][2], B1[2][2];
    unsigned vA[2][2], vAn[2][2];
    PG8_CALC_VA(vA, cur);
    const char* cA = (const char*)g.A + (GATHER ? (size_t)0 : (size_t)cur.pm * tstep); const char* cB = (const char*)g.Bt + (size_t)cur.pn * tstep;
    PG8_STAGE(PG8_SB(0, 0), cB, voffB); PG8_STAGE(PG8_SB(0, 1), cB + hstep, voffB); PG8_STAGE(PG8_SA(0, 0), cA, vA[0]); PG8_STAGE(PG8_SA(0, 1), cA, vA[1]);
    if (wr == 1) PG8_BAR;
    PG8_WAIT_V(2); PG8_BAR;
    PG8_STAGE(PG8_SB(1, 0), cB + kstep, voffB); PG8_STAGE(PG8_SA(1, 0), cA + kstep, vA[0]); PG8_STAGE(PG8_SB(1, 1), cB + hstep + kstep, voffB);
    PG8_WAIT_V(6); PG8_BAR;
    for (;;) {
        const bool has_next = S.next(ui + 1, nxt);
        if (!has_next) nxt = cur;
        const char* nA = (const char*)g.A + (GATHER ? (size_t)0 : (size_t)nxt.pm * tstep); const char* nB = (const char*)g.Bt + (size_t)nxt.pn * tstep;
        if (has_next) { PG8_CALC_VA(vAn, nxt); } else {
#pragma unroll
            for (int _h = 0; _h < 2; ++_h)
#pragma unroll
                for (int _i = 0; _i < 2; ++_i) vAn[_h][_i] = vA[_h][_i]; }
        for (int t = 0; t < nt; t += 2) {
            const bool last = (t == nt - 2);
            const char* a1 = cA + (size_t)(t + 1) * kstep;
            const char* a2 = last ? nA : cA + (size_t)(t + 2) * kstep; const char* b2 = last ? nB : cB + (size_t)(t + 2) * kstep;
            const char* a3 = a2 + kstep; const char* b3 = b2 + kstep;
            unsigned w0[2], w1[2];
#pragma unroll
            for (int _i = 0; _i < 2; ++_i) { w0[_i] = last ? vAn[0][_i] : vA[0][_i]; w1[_i] = last ? vAn[1][_i] : vA[1][_i]; }
            PG8_LDB(B0, 0, 0); PG8_LDB(B1, 0, 1); PG8_SCHED; PG8_LDA(At, 0, 0); PG8_STAGE(PG8_SA(1, 1), a1, vA[1]);
            PG8_WAIT_V(8); PG8_WAIT_L(0); PG8_BAR; PG8_MMA(0, 0, At, B0); PG8_MMA(0, 1, At, B1); PG8_BAR; PG8_SCHED;
            PG8_LDA(At, 0, 1); PG8_STAGE(PG8_SB(0, 0), b2, voffB); PG8_STAGE(PG8_SB(0, 1), b2 + hstep, voffB); PG8_STAGE(PG8_SA(0, 0), a2, w0);
            PG8_WAIT_V(8); PG8_WAIT_L(0); PG8_BAR; PG8_MMA(1, 0, At, B0); PG8_MMA(1, 1, At, B1); PG8_BAR; PG8_SCHED;
            PG8_LDB(B0, 1, 0); PG8_LDB(B1, 1, 1); PG8_SCHED; PG8_LDA(At, 1, 0); PG8_STAGE(PG8_SA(0, 1), a2, w1);
            PG8_WAIT_V(8); PG8_WAIT_L(0); PG8_BAR; PG8_MMA(0, 0, At, B0); PG8_MMA(0, 1, At, B1); PG8_BAR; PG8_SCHED;
            PG8_LDA(At, 1, 1); PG8_STAGE(PG8_SB(1, 0), b3, voffB); PG8_STAGE(PG8_SB(1, 1), b3 + hstep, voffB); PG8_STAGE(PG8_SA(1, 0), a3, w0);
            PG8_WAIT_V(8); PG8_WAIT_L(0); PG8_BAR; PG8_MMA(1, 0, At, B0); PG8_MMA(1, 1, At, B1); PG8_BAR; PG8_SCHED;
        }
        if constexpr (ALIGN_EPI) { if (wr == 0) PG8_BAR; }
        E(acc, cur, wr, wc, fr, fq);
        if (!has_next) break;
        E.init(acc, nxt, wr, wc, fr, fq);
        cur = nxt; cA = nA; cB = nB; ++ui;
#pragma unroll
        for (int _h = 0; _h < 2; ++_h)
#pragma unroll
            for (int _i = 0; _i < 2; ++_i) vA[_h][_i] = vAn[_h][_i];
        if constexpr (ALIGN_EPI) { if (wr == 1) PG8_BAR; }
    }
    PG8_WAIT_V(0);
    if constexpr (!ALIGN_EPI) { if (wr == 0) PG8_BAR; }
    PG8_BAR;
#undef PG8_SA
#undef PG8_SB
#undef PG8_STAGE
#undef PG8_LDA
#undef PG8_LDB
#undef PG8_MMA
#undef PG8_WAIT_V
#undef PG8_WAIT_L
#undef PG8_BAR
#undef PG8_SCHED
#undef PG8_CALC_VA
}

struct EpiProj {
    static constexpr bool PERM = true;
    bf16_t* O;
    __device__ __forceinline__ void init(f32x4 (&acc)[2][2][4][2], const Unit&, int, int, int, int) const {
#pragma unroll
        for (int a = 0; a < 2; ++a)
#pragma unroll
            for (int b = 0; b < 2; ++b)
#pragma unroll
                for (int m = 0; m < 4; ++m)
#pragma unroll
                    for (int n = 0; n < 2; ++n) acc[a][b][m][n] = (f32x4){0.f, 0.f, 0.f, 0.f};
    }
    __device__ __forceinline__ void operator()(const f32x4 (&acc)[2][2][4][2], const Unit& u, int wr, int wc, int fr, int fq) const {
        const int row0 = u.pm * BM + wr * 64 + fr; const int col0 = u.pn * BM + wc * 32 + 8 * fq;
        const float sc = u.pn < 2 ? SBQ_SCALE : (u.pn == 6 ? GQ_SCALE : 1.0f);
#pragma unroll
        for (int ai = 0; ai < 2; ++ai)
#pragma unroll
            for (int m = 0; m < 4; ++m) { bf16_t* rowp = O + (size_t)(row0 + ai * HALF + m * 16) * NPROJ + col0;
#pragma unroll
                for (int bj = 0; bj < 2; ++bj) { const f32x4 v0 = acc[ai][bj][m][0] * sc, v1 = acc[ai][bj][m][1] * sc;
                    u32x4 w; w.x = cvt_pk_bf16(v0[0], v0[1]); w.y = cvt_pk_bf16(v0[2], v0[3]); w.z = cvt_pk_bf16(v1[0], v1[1]); w.w = cvt_pk_bf16(v1[2], v1[3]);
                    *(u32x4*)(rowp + bj * HALF) = w; } }
    }
};
struct EpiResid {
    static constexpr bool PERM = false;
    const float* X; float* C; const float* G; bf16_t* H2;
    __device__ __forceinline__ void init(f32x4 (&acc)[2][2][4][2], const Unit& u, int wr, int wc, int fr, int fq) const {
        const int row0 = u.pm * BM + wr * 64 + fr, col0 = u.pn * BM + wc * 32 + 4 * fq;
#pragma unroll
        for (int ai = 0; ai < 2; ++ai)
#pragma unroll
            for (int m = 0; m < 4; ++m) { const size_t off = (size_t)(row0 + ai * HALF + m * 16) * D + col0;
#pragma unroll
                for (int bj = 0; bj < 2; ++bj)
#pragma unroll
                    for (int n = 0; n < 2; ++n) acc[ai][bj][m][n] = *(const f32x4*)(X + off + bj * HALF + n * 16); }
    }
    __device__ __forceinline__ void operator()(const f32x4 (&acc)[2][2][4][2], const Unit& u, int wr, int wc, int fr, int fq) const {
        const int row0 = u.pm * BM + wr * 64 + fr, col0 = u.pn * BM + wc * 32 + 4 * fq;
        f32x4 gv[2][2];
#pragma unroll
        for (int bj = 0; bj < 2; ++bj)
#pragma unroll
            for (int n = 0; n < 2; ++n) gv[bj][n] = *(const f32x4*)(G + col0 + bj * HALF + n * 16);
#pragma unroll
        for (int ai = 0; ai < 2; ++ai)
#pragma unroll
            for (int m = 0; m < 4; ++m) { const size_t off = (size_t)(row0 + ai * HALF + m * 16) * D + col0;
#pragma unroll
                for (int bj = 0; bj < 2; ++bj)
#pragma unroll
                    for (int n = 0; n < 2; ++n) { const f32x4 v = acc[ai][bj][m][n]; *(f32x4*)(C + off + bj * HALF + n * 16) = v;
                        const f32x4 hv = v * gv[bj][n]; v2u w; w.x = cvt_pk_bf16(hv[0], hv[1]); w.y = cvt_pk_bf16(hv[2], hv[3]); *(v2u*)(H2 + off + bj * HALF + n * 16) = w; } }
    }
};
struct EpiGateUp {
    static constexpr bool PERM = true;
    bf16_t* H; const float* invlist;
    __device__ __forceinline__ void init(f32x4 (&acc)[2][2][4][2], const Unit&, int, int, int, int) const {
#pragma unroll
        for (int a = 0; a < 2; ++a)
#pragma unroll
            for (int b = 0; b < 2; ++b)
#pragma unroll
                for (int m = 0; m < 4; ++m)
#pragma unroll
                    for (int n = 0; n < 2; ++n) acc[a][b][m][n] = (f32x4){0.f, 0.f, 0.f, 0.f};
    }
    __device__ __forceinline__ void operator()(const f32x4 (&acc)[2][2][4][2], const Unit& u, int wr, int wc, int fr, int fq) const {
        const int row0 = u.pm * BM + wr * 64 + fr; const int col0 = (u.pn & 3) * HALF + wc * 32 + 8 * fq;
#pragma unroll
        for (int ai = 0; ai < 2; ++ai)
#pragma unroll
            for (int m = 0; m < 4; ++m) { float hv[8]; const int row = row0 + ai * HALF + m * 16; const int idx = row - u.r0;
                const float inv = idx < u.ne ? invlist[u.e * CAP + idx] : 0.f;
#pragma unroll
                for (int n = 0; n < 2; ++n)
#pragma unroll
                    for (int j = 0; j < 4; ++j) { const float gv = acc[ai][0][m][n][j] * inv, uv = acc[ai][1][m][n][j] * inv; hv[4 * n + j] = gv * __builtin_amdgcn_rcpf(1.0f + __expf(-gv)) * uv; }
                u32x4 w; w.x = cvt_pk_bf16(hv[0], hv[1]); w.y = cvt_pk_bf16(hv[2], hv[3]); w.z = cvt_pk_bf16(hv[4], hv[5]); w.w = cvt_pk_bf16(hv[6], hv[7]);
                *(u32x4*)(H + (size_t)row * DFF + col0) = w; }
    }
};
struct EpiY {
    static constexpr bool PERM = true;
    bf16_t* Y;
    __device__ __forceinline__ void init(f32x4 (&acc)[2][2][4][2], const Unit&, int, int, int, int) const {
#pragma unroll
        for (int a = 0; a < 2; ++a)
#pragma unroll
            for (int b = 0; b < 2; ++b)
#pragma unroll
                for (int m = 0; m < 4; ++m)
#pragma unroll
                    for (int n = 0; n < 2; ++n) acc[a][b][m][n] = (f32x4){0.f, 0.f, 0.f, 0.f};
    }
    __device__ __forceinline__ void operator()(const f32x4 (&acc)[2][2][4][2], const Unit& u, int wr, int wc, int fr, int fq) const {
        const int row0 = u.pm * BM + wr * 64 + fr; const int col0 = (u.pn & 3) * BM + wc * 32 + 8 * fq;
#pragma unroll
        for (int ai = 0; ai < 2; ++ai)
#pragma unroll
            for (int m = 0; m < 4; ++m) { bf16_t* rowp = Y + (size_t)(row0 + ai * HALF + m * 16) * D + col0;
#pragma unroll
                for (int bj = 0; bj < 2; ++bj) { const f32x4 v0 = acc[ai][bj][m][0], v1 = acc[ai][bj][m][1];
                    u32x4 w; w.x = cvt_pk_bf16(v0[0], v0[1]); w.y = cvt_pk_bf16(v0[2], v0[3]); w.z = cvt_pk_bf16(v1[0], v1[1]); w.w = cvt_pk_bf16(v1[2], v1[3]);
                    *(u32x4*)(rowp + bj * HALF) = w; } }
    }
};
struct MoeOrder {
    int G, c, MT, nwg; const PG8_LAS int* tab;
    const int* toklist;
    __device__ __forceinline__ bool next(int i, Unit& u) const {
        const long L = (long)i * G + c; if (L >= nwg) return false;
        int wgid = (int)L; { const int q = nwg / NXCD, r = nwg % NXCD, xcd = wgid % NXCD, off = wgid / NXCD; wgid = (xcd < r ? xcd * (q + 1) : r * (q + 1) + (xcd - r) * q) + off; }
        const int st = wgid >> 2, ntl = wgid & 3;
        const int ln = threadIdx.x & 31;
        const int e = __popcll(__ballot(tab[64 + ln] <= st)) >> 1;
        u.pm = st; u.pn = e * 4 + ntl; u.e = e; u.r0 = __builtin_amdgcn_readfirstlane(tab[32 + e]); u.ne = __builtin_amdgcn_readfirstlane(tab[e]); return true;
    }
    __device__ __forceinline__ int src_row(const Unit& u, int R) const { const int idx = u.pm * BM + R - u.r0; return idx < u.ne ? toklist[u.e * CAP + idx] : 0; }
};
}

struct Frame {
    LAS unsigned char* lds;
    volatile LAS unsigned* MISC;
    gu32* ctl;
    int tid, lane, wave;
    int vcu, G;
    int gw, NGW;
    const float *x, *ln1_g, *w_in, *gate_w2, *gate_b, *gnorm_g, *w_out, *ln2_g, *w_group, *b_group, *w_expert, *b_expert, *ew_gate, *ew_up, *ew_down, *lnf_g;
    float* out;
    unsigned char* ws;
    bf16 *WinT, *WoutT, *WguT, *WdT, *XN, *OMIX, *H2, *HBUF, *PROJ, *Y;
    float *GLR, *LOGA, *OG, *X1, *DS, *DEC, *WrT; bf16* ST;
    int* toklist; float* gatelist; float* invlist; int* tokinfo; unsigned* cnt;
};

__device__ __forceinline__ void p0_transpose_item(const float* W, int ldw, int K, int k0, int n0, bf16* WT, size_t dst_row0, LAS float* scr, int lane) {
#pragma unroll 8
    for (int i = 0; i < 32; ++i) { const int kk = 2 * i + (lane >> 5); scr[kk * 33 + (lane & 31)] = W[(size_t)(k0 + kk) * ldw + n0 + (lane & 31)]; }
    LDS_WAIT(); asm volatile("" ::: "memory");
    const int c = lane & 7;
#pragma unroll
    for (int j = 0; j < 4; ++j) { const int n = (lane >> 3) + 8 * j; const LAS float* s = scr + (8 * c) * 33 + n;
        v4u o; o.x = pk2(s[0 * 33], s[1 * 33]); o.y = pk2(s[2 * 33], s[3 * 33]); o.z = pk2(s[4 * 33], s[5 * 33]); o.w = pk2(s[6 * 33], s[7 * 33]);
        *(GAS v4u*)(WT + (dst_row0 + n) * K + k0 + 8 * c) = o; }
    LDS_WAIT(); asm volatile("" ::: "memory");
}
__device__ __forceinline__ void rms_row_to_bf16(int lane, const float* xrow, const float* g, bf16* orow) {
    const GAS f32x4* xr = (const GAS f32x4*)xrow + lane; const GAS f32x4* gr = (const GAS f32x4*)g + lane;
    f32x4 v[4]; float s = 0.f;
#pragma unroll
    for (int j = 0; j < 4; ++j) { v[j] = xr[64 * j]; s += (v[j].x * v[j].x + v[j].y * v[j].y) + (v[j].z * v[j].z + v[j].w * v[j].w); }
    const float inv = 1.0f / sqrtf(wave_sum(s) * (1.f / D) + RMS_EPS);
    GAS unsigned long long* o8 = (GAS unsigned long long*)orow + lane;
#pragma unroll
    for (int j = 0; j < 4; ++j) { const f32x4 gg = gr[64 * j];
        o8[64 * j] = (unsigned long long)pk2(v[j].x * inv * gg.x, v[j].y * inv * gg.y) | ((unsigned long long)pk2(v[j].z * inv * gg.z, v[j].w * inv * gg.w) << 32); }
}
#define SCHED_FENCE_P0() __builtin_amdgcn_sched_barrier(0)
struct TrItem { const float* src; int ldw; bf16* dst; int K; };
constexpr int P0_DENSE_ITEMS = (D / 64) * (NPROJ / 32) + (D / 64) * (D / 32);
constexpr int P0_EXPERT_ITEMS = NE * (2 * (D / 64) * (DFF / 32) + (DFF / 64) * (D / 32));
__device__ __forceinline__ TrItem p0_item(const Frame& F, int it) {
    constexpr int I_IN = (D / 64) * (NPROJ / 32), I_OUT = (D / 64) * (D / 32), I_G1 = (D / 64) * (DFF / 32), I_D1 = (DFF / 64) * (D / 32);
    TrItem t; int r = it;
    if (r < I_IN) { const int kb = r / (NPROJ / 32), nb = r % (NPROJ / 32); t.src = F.w_in + (size_t)(64 * kb) * DIN + 32 * nb; t.ldw = DIN; t.K = D; t.dst = F.WinT + (size_t)(32 * nb) * D + 64 * kb; return t; } r -= I_IN;
    if (r < I_OUT) { const int kb = r / (D / 32), nb = r % (D / 32); t.src = F.w_out + (size_t)(64 * kb) * D + 32 * nb; t.ldw = D; t.K = D; t.dst = F.WoutT + (size_t)(32 * nb) * D + 64 * kb; return t; } r -= I_OUT;
    const int e = r / (2 * I_G1 + I_D1); r -= e * (2 * I_G1 + I_D1);
    if (r < 2 * I_G1) { const int up = r / I_G1; r -= up * I_G1; const int kb = r / (DFF / 32), nb = r % (DFF / 32); const int n0 = 32 * nb;
        t.src = (up ? F.ew_up : F.ew_gate) + (size_t)e * D * DFF + (size_t)(64 * kb) * DFF + n0; t.ldw = DFF; t.K = D;
        t.dst = F.WguT + ((size_t)e * 1024 + (size_t)(n0 / 128) * 256 + (n0 % 128) + (up ? 128 : 0)) * D + 64 * kb; return t; }
    r -= 2 * I_G1;
    { const int kb = r / (D / 32), nb = r % (D / 32); t.src = F.ew_down + (size_t)e * DFF * D + (size_t)(64 * kb) * D + 32 * nb; t.ldw = D; t.K = DFF; t.dst = F.WdT + ((size_t)e * 1024 + 32 * nb) * DFF + 64 * kb; }
    return t;
}
__device__ __forceinline__ void gload16(v4u& d, const void* p) { asm volatile("global_load_dwordx4 %0, %1, off" : "=v"(d) : "v"(p) : "memory"); }
__device__ __forceinline__ void p0_item_flush(const f32x4 (&R)[8], const TrItem& t, LAS float* scr, int lane) {
#pragma unroll
    for (int i = 0; i < 8; ++i) { LAS float* w = scr + (8 * i + (lane >> 3)) * 33 + 4 * (lane & 7);
        w[0] = R[i].x; w[1] = R[i].y; w[2] = R[i].z; w[3] = R[i].w; }
    LDS_WAIT(); asm volatile("" ::: "memory");
    const int c = lane & 7;
#pragma unroll
    for (int j = 0; j < 4; ++j) { const int n = (lane >> 3) + 8 * j; const LAS float* sp = scr + (8 * c) * 33 + n;
        v4u o; o.x = pk2(sp[0 * 33], sp[1 * 33]); o.y = pk2(sp[2 * 33], sp[3 * 33]); o.z = pk2(sp[4 * 33], sp[5 * 33]); o.w = pk2(sp[6 * 33], sp[7 * 33]);
        *(GAS v4u*)(t.dst + (size_t)n * t.K + 8 * c) = o; }
    LDS_WAIT(); asm volatile("" ::: "memory");
}
__device__ __forceinline__ void p0_item_ld(f32x4 (&R)[8], const TrItem& t, int lane) {
    const float* p = t.src + (size_t)(lane >> 3) * t.ldw + 4 * (lane & 7);
#pragma unroll
    for (int i = 0; i < 8; ++i) R[i] = *(const f32x4*)(p + (size_t)(8 * i) * t.ldw);
}
__device__ __forceinline__ void p0_transpose_range(Frame& F, const int first, const int count, const int widx, const int nw) {
    LAS float* scr = (LAS float*)(F.lds + RING_OFF + F.wave * WAVE_LDS);
    for (int it = widx; it < count; it += 4 * nw) {
        f32x4 RA[8], RB[8], RC[8], RD[8];
        const bool hb = it + nw < count, hc = it + 2 * nw < count, hd = it + 3 * nw < count;
        const int ib = hb ? it + nw : it, ic = hc ? it + 2 * nw : it, id = hd ? it + 3 * nw : it;
        p0_item_ld(RA, p0_item(F, first + it), F.lane); p0_item_ld(RB, p0_item(F, first + ib), F.lane);
        p0_item_ld(RC, p0_item(F, first + ic), F.lane); p0_item_ld(RD, p0_item(F, first + id), F.lane);
        SCHED_FENCE_P0();
        p0_item_flush(RA, p0_item(F, first + it), scr, F.lane);
        if (hb) p0_item_flush(RB, p0_item(F, first + ib), scr, F.lane);
        if (hc) p0_item_flush(RC, p0_item(F, first + ic), scr, F.lane);
        if (hd) p0_item_flush(RD, p0_item(F, first + id), scr, F.lane);
    }
}
__device__ __forceinline__ void p0_prologue(Frame& F) {
    p0_transpose_range(F, 0, P0_DENSE_ITEMS, F.gw, F.NGW);
    { const int gt = F.gw * 64 + F.lane, NGT = F.NGW * 64;
      for (int i = gt; i < GRANK * D; i += NGT) { const int j = i / D, k = i % D; F.WinT[(size_t)(NPROJ + j) * D + k] = (bf16)f2bf(F.w_in[(size_t)k * DIN + NPROJ + j]); } }
    { const int gt = F.gw * 64 + F.lane, NGT = F.NGW * 64;
      for (int i = gt; i < 64 * D; i += NGT) { const int j = i / D, k = i % D;
          const float w = j < NE ? F.w_expert[(size_t)k * NE + j] : (j < NE + NGRP ? F.w_group[(size_t)k * NGRP + (j - NE)] : 0.f);
          F.WrT[i] = w * F.ln2_g[k]; } }
    for (int m = F.gw; m < T; m += 2 * F.NGW) {
        const int m2 = (m + F.NGW < T) ? m + F.NGW : m;
        const GAS f32x4* xa = (const GAS f32x4*)(F.x + (size_t)m * D) + F.lane; const GAS f32x4* xb = (const GAS f32x4*)(F.x + (size_t)m2 * D) + F.lane; const GAS f32x4* gr = (const GAS f32x4*)F.ln1_g + F.lane;
        f32x4 va[4], vb[4], gg[4]; float sa = 0.f, sb = 0.f;
#pragma unroll
        for (int j = 0; j < 4; ++j) { va[j] = xa[64 * j]; vb[j] = xb[64 * j]; gg[j] = gr[64 * j]; }
        SCHED_FENCE_P0();
#pragma unroll
        for (int j = 0; j < 4; ++j) { sa += (va[j].x * va[j].x + va[j].y * va[j].y) + (va[j].z * va[j].z + va[j].w * va[j].w); sb += (vb[j].x * vb[j].x + vb[j].y * vb[j].y) + (vb[j].z * vb[j].z + vb[j].w * vb[j].w); }
        const float ia = 1.0f / sqrtf(wave_sum(sa) * (1.f / D) + RMS_EPS), ib = 1.0f / sqrtf(wave_sum(sb) * (1.f / D) + RMS_EPS);
        GAS unsigned long long* oa = (GAS unsigned long long*)(F.XN + (size_t)m * D) + F.lane; GAS unsigned long long* ob = (GAS unsigned long long*)(F.XN + (size_t)m2 * D) + F.lane;
#pragma unroll
        for (int j = 0; j < 4; ++j) {
            oa[64 * j] = (unsigned long long)pk2(va[j].x * ia * gg[j].x, va[j].y * ia * gg[j].y) | ((unsigned long long)pk2(va[j].z * ia * gg[j].z, va[j].w * ia * gg[j].w) << 32);
            ob[64 * j] = (unsigned long long)pk2(vb[j].x * ib * gg[j].x, vb[j].y * ib * gg[j].y) | ((unsigned long long)pk2(vb[j].z * ib * gg[j].z, vb[j].w * ib * gg[j].w) << 32); }
    }
}

__device__ __forceinline__ f32x16 tile32(const bf16* pa, const bf16* pb, int K, int h) {
    f32x16 acc;
#pragma unroll
    for (int i = 0; i < 16; ++i) acc[i] = 0.f;
    const bf16x8* a8 = (const bf16x8*)(pa + 8 * h); const bf16x8* b8 = (const bf16x8*)(pb + 8 * h);
#pragma unroll 4
    for (int k = 0; k < K / 16; ++k) acc = __builtin_amdgcn_mfma_f32_32x32x16_bf16(a8[2 * k], b8[2 * k], acc, 0, 0, 0);
    return acc;
}

__device__ __forceinline__ void p1_proj_base(Frame& F) {
    const int r = F.lane & 31, h = F.lane >> 5;
    constexpr int NT = NPROJ / 32, MT = T / 32;
    for (int it = F.gw; it < MT * NT; it += F.NGW) {
        const int mt = it / NT, nt = it % NT;
        const f32x16 acc = tile32(F.XN + (size_t)(mt * 32 + r) * D, F.WinT + (size_t)(nt * 32 + r) * D, D, h);
        const int col = nt * 32 + r;
        const float sc = col < COL_SBK ? SBQ_SCALE : ((col >= COL_GQ && col < COL_GK) ? GQ_SCALE : 1.0f);
#pragma unroll
        for (int i = 0; i < 16; ++i) F.PROJ[(size_t)(mt * 32 + crow(i, h)) * NPROJ + col] = (bf16)f2bf(acc[i] * sc);
    }
}
__device__ __forceinline__ void p1_glr(Frame& F) {
    const int gt = F.gw * 64 + F.lane, NGT = F.NGW * 64;
    for (int i = gt; i < T * GRANK; i += NGT) { const int t = i / GRANK, j = i % GRANK;
        const v4u* a = (const v4u*)(F.XN + (size_t)t * D); const v4u* b = (const v4u*)(F.WinT + (size_t)(NPROJ + j) * D);
        float s = 0.f;
        for (int k = 0; k < D / 8; ++k) { const v4u av = a[k], bv = b[k];
            s += bflo(av.x) * bflo(bv.x) + bfhi(av.x) * bfhi(bv.x) + bflo(av.y) * bflo(bv.y) + bfhi(av.y) * bfhi(bv.y)
               + bflo(av.z) * bflo(bv.z) + bfhi(av.z) * bfhi(bv.z) + bflo(av.w) * bflo(bv.w) + bfhi(av.w) * bfhi(bv.w); }
        F.GLR[i] = s; }
}

__device__ __forceinline__ void p2_loga(Frame& F) {
    const int gt = F.gw * 64 + F.lane, NGT = F.NGW * 64;
    for (int i = gt; i < T * 256; i += NGT) { const int t = i >> 8, c = i & 255;
        float s = F.gate_b[c];
#pragma unroll
        for (int j = 0; j < GRANK; ++j) s += F.GLR[t * GRANK + j] * F.gate_w2[j * 256 + c];
        const float ls = fminf(s, 0.f) - log1pf(expf(-fabsf(s)));
        F.LOGA[i] = ls * (1.0f / 16.0f); }
}
__device__ __forceinline__ void p2_sb_base(Frame& F) {
    for (int it = F.gw; it < BATCH * SBH * (SEQ / 64); it += F.NGW) {
        const int qb = it % (SEQ / 64), h = (it / (SEQ / 64)) % SBH, b = it / ((SEQ / 64) * SBH);
        const int t = qb * 64 + F.lane; const size_t row = (size_t)b * SEQ + t;
        float q[64], o[64];
        { const v4u* qp = (const v4u*)(F.PROJ + row * NPROJ + COL_SBQ + h * 64);
#pragma unroll
          for (int j = 0; j < 8; ++j) { const v4u w = qp[j]; q[8 * j] = bflo(w.x); q[8 * j + 1] = bfhi(w.x); q[8 * j + 2] = bflo(w.y); q[8 * j + 3] = bfhi(w.y);
              q[8 * j + 4] = bflo(w.z); q[8 * j + 5] = bfhi(w.z); q[8 * j + 6] = bflo(w.w); q[8 * j + 7] = bfhi(w.w); } }
#pragma unroll
        for (int d = 0; d < 64; ++d) o[d] = 0.f;
        float R = 0.f;
        int zero = 0; asm volatile("" : "+v"(zero));
        for (int s = qb * 64 + 62; s >= 0; --s) {
            const bf16* kv = F.PROJ + ((size_t)b * SEQ + s) * NPROJ + h * 64 + zero;
            const v4u* kp = (const v4u*)(kv + COL_SBK); const v4u* vp = (const v4u*)(kv + COL_SBV);
            float z = 0.f;
#pragma unroll
            for (int j = 0; j < 8; ++j) { const v4u w = kp[j];
                z += q[8 * j] * bflo(w.x) + q[8 * j + 1] * bfhi(w.x) + q[8 * j + 2] * bflo(w.y) + q[8 * j + 3] * bfhi(w.y)
                   + q[8 * j + 4] * bflo(w.z) + q[8 * j + 5] * bfhi(w.z) + q[8 * j + 6] * bflo(w.w) + q[8 * j + 7] * bfhi(w.w); }
            const float lb = fminf(z, 0.f) - __log2f(1.0f + exp2f(-fabsf(z)));
            const float wgt = (s < t) ? exp2f(lb + R) : 0.f;
            if (s < t) R += lb - z;
#pragma unroll
            for (int j = 0; j < 8; ++j) { const v4u w = vp[j];
                o[8 * j] += wgt * bflo(w.x); o[8 * j + 1] += wgt * bfhi(w.x); o[8 * j + 2] += wgt * bflo(w.y); o[8 * j + 3] += wgt * bfhi(w.y);
                o[8 * j + 4] += wgt * bflo(w.z); o[8 * j + 5] += wgt * bfhi(w.z); o[8 * j + 6] += wgt * bflo(w.w); o[8 * j + 7] += wgt * bfhi(w.w); }
        }
        v4u* op = (v4u*)(F.OMIX + row * D + h * 64);
#pragma unroll
        for (int j = 0; j < 8; ++j) { v4u w; w.x = pk2(o[8 * j], o[8 * j + 1]); w.y = pk2(o[8 * j + 2], o[8 * j + 3]); w.z = pk2(o[8 * j + 4], o[8 * j + 5]); w.w = pk2(o[8 * j + 6], o[8 * j + 7]); op[j] = w; }
    }
}

typedef short s16x4 __attribute__((ext_vector_type(4)));
typedef short v4i16_t __attribute__((ext_vector_type(4)));
typedef float f32x2_t __attribute__((ext_vector_type(2))); typedef __bf16 bf16x2_t __attribute__((ext_vector_type(2)));
__device__ __forceinline__ unsigned cvtpk_s(float lo, float hi) { f32x2_t v = {lo, hi}; bf16x2_t b = __builtin_convertvector(v, bf16x2_t); return __builtin_bit_cast(unsigned, b); }
__device__ __forceinline__ s16x4 vtr(const LAS char* p) { return __builtin_bit_cast(s16x4, __builtin_amdgcn_ds_read_tr16_b64_v4i16((LAS v4i16_t*)p)); }
__device__ __forceinline__ bf16x8 pack8(const float* x) { v4u p; p.x = cvtpk_s(x[0], x[1]); p.y = cvtpk_s(x[2], x[3]); p.z = cvtpk_s(x[4], x[5]); p.w = cvtpk_s(x[6], x[7]); return __builtin_bit_cast(bf16x8, p); }
constexpr float SB_STOP = -152.0f;
#define SB_WAIT(N, K, V) asm volatile("s_waitcnt vmcnt(" #N ")" : "+v"(K[0]), "+v"(K[1]), "+v"(K[2]), "+v"(K[3]), "+v"(V[0]), "+v"(V[1]), "+v"(V[2]), "+v"(V[3]) :: "memory")
struct SbState { f32x16 O0, O1; float R; };
__device__ __forceinline__ bool sb_tile(SbState& st, const v4u (&kreg)[4], const v4u (&vreg)[4], const bf16x8 (&qf)[4], const bf16x8 U0, const bf16x8 U1, LAS char* vl, const LAS char* vbase, const bool diag, const int lane) {
    const int r = lane & 31, hh = lane >> 5;
#pragma unroll
    for (int i = 0; i < 4; ++i) { const int key = 8 * i + (lane >> 3), dch = lane & 7;
        *(LAS v4u*)(vl + ((key >> 3) * 2 + (dch >> 2)) * 512 + (key & 7) * 64 + (dch & 3) * 16) = vreg[i]; }
    f32x16 S;
#pragma unroll
    for (int i = 0; i < 16; ++i) S[i] = 0.f;
#pragma unroll
    for (int ks = 0; ks < 4; ++ks) S = __builtin_amdgcn_mfma_f32_32x32x16_bf16(__builtin_bit_cast(bf16x8, kreg[ks]), qf[ks], S, 0, 0, 0);
    float lom[16]; f32x16 C; float rs = 0.f;
#pragma unroll
    for (int i = 0; i < 16; ++i) { const float z = S[i];
        const float l = __builtin_amdgcn_logf(1.0f + __builtin_amdgcn_exp2f(-fabsf(z)));
        const float lbv = fminf(z, 0.f) - l; float lm = lbv - z;
        if (diag && !(crow(i, hh) < r)) lm = 0.f;
        lom[i] = lm; rs += lm; C[i] = lbv + st.R; }
    rs += __shfl_xor(rs, 32);
    const bf16x8 pb0 = pack8(lom), pb1 = pack8(lom + 8);
    C = __builtin_amdgcn_mfma_f32_32x32x16_bf16(U0, pb0, C, 0, 0, 0);
    C = __builtin_amdgcn_mfma_f32_32x32x16_bf16(U1, pb1, C, 0, 0, 0);
    float w[16];
#pragma unroll
    for (int i = 0; i < 16; ++i) { float wv = __builtin_amdgcn_exp2f(C[i]); if (diag && !(crow(i, hh) < r)) wv = 0.f; w[i] = wv; }
    const bf16x8 pa0 = pack8(w), pa1 = pack8(w + 8);
    asm volatile("" ::: "memory");
#pragma unroll
    for (int nb = 0; nb < 2; ++nb) {
        const s16x4 l0 = vtr(vbase + (0 * 2 + nb) * 512), h0 = vtr(vbase + (1 * 2 + nb) * 512), l1 = vtr(vbase + (2 * 2 + nb) * 512), h1 = vtr(vbase + (3 * 2 + nb) * 512);
        const bf16x8 v0 = (bf16x8){l0[0], l0[1], l0[2], l0[3], h0[0], h0[1], h0[2], h0[3]}, v1 = (bf16x8){l1[0], l1[1], l1[2], l1[3], h1[0], h1[1], h1[2], h1[3]};
        if (nb == 0) { st.O0 = __builtin_amdgcn_mfma_f32_32x32x16_bf16(pa0, v0, st.O0, 0, 0, 0); st.O0 = __builtin_amdgcn_mfma_f32_32x32x16_bf16(pa1, v1, st.O0, 0, 0, 0); }
        else { st.O1 = __builtin_amdgcn_mfma_f32_32x32x16_bf16(pa0, v0, st.O1, 0, 0, 0); st.O1 = __builtin_amdgcn_mfma_f32_32x32x16_bf16(pa1, v1, st.O1, 0, 0, 0); }
    }
    asm volatile("" ::: "memory");
    st.R += rs;
    return __all(st.R < SB_STOP);
}
__device__ __forceinline__ void p2_sb_fast(Frame& F) {
    const int lane = F.lane, r = lane & 31, hh = lane >> 5;
    LAS char* vl = (LAS char*)(F.lds + RING_OFF + F.wave * WAVE_LDS);
    const LAS char* vbase = vl + (4 * hh + ((lane & 15) >> 2)) * 64 + ((lane >> 4) & 1) * 32 + (lane & 3) * 8;
    bf16x8 U0, U1;
#pragma unroll
    for (int j = 0; j < 8; ++j) { const int k0 = 8 * (j >> 2) + 4 * hh + (j & 3); U0[j] = (k0 > r) ? (short)0x3F80 : (short)0; U1[j] = (16 + k0 > r) ? (short)0x3F80 : (short)0; }
    constexpr int NQB = SEQ / 32;
    for (int unit = F.gw; unit < BATCH * SBH * NQB; unit += F.NGW) {
        const int qb = unit % NQB, head = (unit / NQB) % SBH, b = unit / (NQB * SBH);
        const size_t rowbase = (size_t)b * SEQ; const int t0 = qb * 32;
        bf16x8 qf[4];
        { const bf16* Qp = F.PROJ + (rowbase + t0 + r) * NPROJ + COL_SBQ + head * 64 + 8 * hh;
#pragma unroll
          for (int ks = 0; ks < 4; ++ks) qf[ks] = *(const bf16x8*)(Qp + 16 * ks); }
        SbState st;
#pragma unroll
        for (int i = 0; i < 16; ++i) { st.O0[i] = 0.f; st.O1[i] = 0.f; }
        st.R = 0.f;
        const bf16* Kp0 = F.PROJ + (rowbase + r) * NPROJ + COL_SBK + head * 64 + 8 * hh;
        const bf16* Vp0 = F.PROJ + (rowbase + (lane >> 3)) * NPROJ + COL_SBV + head * 64 + 8 * (lane & 7);
        v4u kA[4], vA[4], kB[4], vB[4];
#define SB_FETCH(K, V, tile) do { const size_t so_ = (size_t)(tile) * 32 * NPROJ; \
            _Pragma("unroll") for (int q_ = 0; q_ < 4; ++q_) gload16(K[q_], Kp0 + so_ + 16 * q_); \
            _Pragma("unroll") for (int q_ = 0; q_ < 4; ++q_) gload16(V[q_], Vp0 + so_ + (size_t)(8 * q_) * NPROJ); } while (0)
        SB_FETCH(kA, vA, qb);
        int kt = qb;
        for (;;) {
            SB_FETCH(kB, vB, kt > 0 ? kt - 1 : 0);
            SB_WAIT(8, kA, vA);
            bool done = sb_tile(st, kA, vA, qf, U0, U1, vl, vbase, kt == qb, lane);
            if (done || kt == 0) break;
            --kt;
            SB_FETCH(kA, vA, kt > 0 ? kt - 1 : 0);
            SB_WAIT(8, kB, vB);
            done = sb_tile(st, kB, vB, qf, U0, U1, vl, vbase, false, lane);
            if (done || kt == 0) break;
            --kt;
        }
        SB_WAIT(0, kA, vA); SB_WAIT(0, kB, vB);
#undef SB_FETCH
        bf16* Op = F.OMIX + (rowbase + t0) * D + head * 64 + r;
#pragma unroll
        for (int i = 0; i < 16; ++i) { const int tr = crow(i, hh); Op[(size_t)tr * D] = (bf16)f2bf(st.O0[i]); Op[(size_t)tr * D + 32] = (bf16)f2bf(st.O1[i]); }
    }
}

typedef float f32x4v __attribute__((ext_vector_type(4)));
__device__ __forceinline__ void p1_loga(Frame& F, const int uw, const int NU) {
    const int lane = F.lane, rw = lane & 15, kq = lane >> 4;
    LAS float* gl = (LAS float*)(F.lds + RING_OFF + F.wave * WAVE_LDS);
    if (uw >= T / 16) return;
    f32x4 w2r[GRANK]; const f32x4 bias = *(const f32x4*)(F.gate_b + 4 * lane);
#pragma unroll
    for (int j = 0; j < GRANK; ++j) w2r[j] = *(const f32x4*)(F.gate_w2 + j * 256 + 4 * lane);
    for (int unit = uw; unit < T / 16; unit += NU) {
        const int t0 = unit * 16;
        const bf16* ap = F.XN + (size_t)(t0 + rw) * D + 8 * kq; const bf16* bp = F.WinT + (size_t)(NPROJ + rw) * D + 8 * kq;
        f32x4 acc = {0.f, 0.f, 0.f, 0.f};
#pragma unroll 8
        for (int ks = 0; ks < D / 32; ++ks) acc = __builtin_amdgcn_mfma_f32_16x16x32_bf16(*(const bf16x8*)(ap + 32 * ks), *(const bf16x8*)(bp + 32 * ks), acc, 0, 0, 0);
#pragma unroll
        for (int q = 0; q < 4; ++q) gl[(4 * kq + q) * 16 + rw] = acc[q];
        asm volatile("" ::: "memory");
#pragma unroll 4
        for (int tk = 0; tk < 16; ++tk) {
            const LAS f32x4* gp = (const LAS f32x4*)(gl + tk * 16);
            f32x4 a = bias;
#pragma unroll
            for (int j4 = 0; j4 < 4; ++j4) { const f32x4 g4 = gp[j4];
#pragma unroll
                for (int q = 0; q < 4; ++q) a += w2r[4 * j4 + q] * g4[q]; }
            f32x4 o;
#pragma unroll
            for (int q = 0; q < 4; ++q) { const float sv = a[q]; o[q] = (fminf(sv, 0.f) - __logf(1.0f + __expf(-fabsf(sv)))) * (1.0f / 16.0f); }
            *(f32x4*)(F.LOGA + (size_t)(t0 + tk) * 256 + 4 * lane) = o;
        }
        asm volatile("" ::: "memory");
    }
}
__device__ __forceinline__ bf16x8 tr_frag(const LAS char* img, int ncb, int ra, int rb, int cb, int lane) {
    const int q = (lane & 15) >> 2, p = lane & 3, g16 = (lane >> 4) & 1;
    const s16x4 lo = vtr(img + ((ra >> 3) * ncb + cb) * 512 + ((ra & 7) + q) * 64 + g16 * 32 + p * 8);
    const s16x4 hi = vtr(img + ((rb >> 3) * ncb + cb) * 512 + ((rb & 7) + q) * 64 + g16 * 32 + p * 8);
    return (bf16x8){lo[0], lo[1], lo[2], lo[3], hi[0], hi[1], hi[2], hi[3]};
}
#define SCHED_FENCE() __builtin_amdgcn_sched_barrier(0)
__device__ __forceinline__ void gla_pass_a(Frame& F) {
    const int lane = F.lane, r = lane & 31, hh = lane >> 5;
    LAS char* KD = (LAS char*)(F.lds + RING_OFF + F.wave * WAVE_LDS); LAS char* VV = KD + 8192;
    for (int unit = F.gw; unit < BATCH * GH * 64 * 2; unit += F.NGW) {
        const int vhalf = unit & 1, c = (unit >> 1) & 63, bh = unit >> 7, b = bh >> 2, h = bh & 3;
        const size_t row0 = (size_t)b * SEQ + c * 64;
        const float* gp = F.LOGA + row0 * 256 + h * 64; const bf16* kp = F.PROJ + row0 * NPROJ + COL_GK + h * 64;
        float gA[16], gB[16]; unsigned short kA[16], kB[16]; v4u vr[8];
#define GA_LOAD(G, K, bi) do { _Pragma("unroll") for (int t_ = 0; t_ < 16; ++t_) { G[t_] = (gp + (size_t)(16 * (bi) + t_) * 256)[lane]; K[t_] = (kp + (size_t)(16 * (bi) + t_) * NPROJ)[lane]; } } while (0)
#define GA_PROC(G, K, bi) do { _Pragma("unroll") for (int t_ = 0; t_ < 16; ++t_) { const int t = 16 * (bi) + t_; run += G[t_]; \
            const float kd_ = bf2f(K[t_]) * __expf(-run); \
            *(LAS bf16*)(KD + ((t >> 3) * 2 + (lane >> 5)) * 512 + (t & 7) * 64 + (lane & 31) * 2) = (bf16)f2bf(kd_); } } while (0)
        float run = 0.f;
        GA_LOAD(gA, kA, 0);
#pragma unroll
        for (int i = 0; i < 8; ++i) { const int ch = i * 64 + lane, t = ch >> 3, cc = ch & 7; vr[i] = *(const v4u*)(F.PROJ + (row0 + t) * NPROJ + COL_GV + h * 128 + vhalf * 64 + cc * 8); }
        GA_LOAD(gB, kB, 1); SCHED_FENCE(); GA_PROC(gA, kA, 0); SCHED_FENCE();
        GA_LOAD(gA, kA, 2); SCHED_FENCE(); GA_PROC(gB, kB, 1); SCHED_FENCE();
        GA_LOAD(gB, kB, 3); SCHED_FENCE(); GA_PROC(gA, kA, 2); SCHED_FENCE();
        GA_PROC(gB, kB, 3);
#undef GA_LOAD
#undef GA_PROC
        const float etot = __expf(run);
        if (vhalf == 0) F.DEC[(bh * 64 + c) * 64 + lane] = etot;
#pragma unroll
        for (int i = 0; i < 8; ++i) { const int ch = i * 64 + lane, t = ch >> 3, cc = ch & 7;
            *(LAS v4u*)(VV + ((t >> 3) * 2 + (cc >> 2)) * 512 + (t & 7) * 64 + (cc & 3) * 16) = vr[i]; }
        asm volatile("" ::: "memory");
        f32x16 acc[2][2];
#pragma unroll
        for (int a = 0; a < 2; ++a)
#pragma unroll
            for (int bb = 0; bb < 2; ++bb)
#pragma unroll
                for (int i = 0; i < 16; ++i) acc[a][bb][i] = 0.f;
#pragma unroll
        for (int ks = 0; ks < 4; ++ks) { const int ra = 16 * ks + 8 * hh, rb = ra + 4;
            const bf16x8 a0 = tr_frag(VV, 2, ra, rb, 0, lane), a1 = tr_frag(VV, 2, ra, rb, 1, lane);
            const bf16x8 b0 = tr_frag(KD, 2, ra, rb, 0, lane), b1 = tr_frag(KD, 2, ra, rb, 1, lane);
            acc[0][0] = __builtin_amdgcn_mfma_f32_32x32x16_bf16(a0, b0, acc[0][0], 0, 0, 0); acc[0][1] = __builtin_amdgcn_mfma_f32_32x32x16_bf16(a0, b1, acc[0][1], 0, 0, 0);
            acc[1][0] = __builtin_amdgcn_mfma_f32_32x32x16_bf16(a1, b0, acc[1][0], 0, 0, 0); acc[1][1] = __builtin_amdgcn_mfma_f32_32x32x16_bf16(a1, b1, acc[1][1], 0, 0, 0); }
        const float e0 = __shfl(etot, r), e1 = __shfl(etot, 32 + r);
        float* dsp = F.DS + ((size_t)(bh * 64 + c) * 128 + 64 * vhalf) * 64 + r;
#pragma unroll
        for (int vb = 0; vb < 2; ++vb)
#pragma unroll
            for (int kb = 0; kb < 2; ++kb)
#pragma unroll
                for (int i = 0; i < 16; ++i) dsp[(size_t)(32 * vb + crow(i, hh)) * 64 + 32 * kb] = acc[vb][kb][i] * (kb ? e1 : e0);
        asm volatile("" ::: "memory");
    }
}
__device__ __forceinline__ void gla_pass_b(Frame& F) {
    const int gt = F.gw * 64 + F.lane, NGT = F.NGW * 64;
    for (int e = gt; e < BATCH * GH * 8192; e += NGT) {
        const int bh = e >> 13, rem = e & 8191, k = rem & 63;
        float S = 0.f;
#pragma unroll 8
        for (int c = 0; c < 64; ++c) { const size_t o = ((size_t)(bh * 64 + c) << 13) + rem;
            F.ST[o] = (bf16)f2bf(S); S = F.DEC[(bh * 64 + c) * 64 + k] * S + F.DS[o]; }
    }
}
template <int THALF> __device__ __forceinline__ void gla_pass_c_unit(Frame& F, const int c, const int bh) {
    const int lane = F.lane, r = lane & 31, hh = lane >> 5;
    LAS char* KT = (LAS char*)(F.lds + RING_OFF + F.wave * WAVE_LDS); LAS char* QT = KT + 8192; LAS char* VV = KT;
    const int b = bh >> 2, h = bh & 3;
    const size_t row0 = (size_t)b * SEQ + c * 64;
    const float* gp = F.LOGA + row0 * 256 + h * 64; const bf16* kp = F.PROJ + row0 * NPROJ + COL_GK + h * 64;
    float gA[16], gB[16]; unsigned short kA[16], kB[16], qA[16], qB[16];
#define GC_LOAD(G, K, Q, bi) do { _Pragma("unroll") for (int t_ = 0; t_ < 16; ++t_) { G[t_] = (gp + (size_t)(16 * (bi) + t_) * 256)[lane]; K[t_] = (kp + (size_t)(16 * (bi) + t_) * NPROJ)[lane]; \
            if ((bi) >= 2 * THALF) Q[t_] = (kp + (size_t)(16 * (bi) + t_) * NPROJ + (COL_GQ - COL_GK))[lane]; } } while (0)
#define GC_PROC(G, K, Q, bi) do { _Pragma("unroll") for (int t_ = 0; t_ < 16; ++t_) { const int t = 16 * (bi) + t_; run += G[t_]; \
            const float kt_ = bf2f(K[t_]) * __expf(-run); \
            *(LAS bf16*)(KT + t * 128 + ((lane * 2) ^ ((t & 7) << 4))) = (bf16)f2bf(kt_); \
            if ((bi) >= 2 * THALF) { const int tt = t - 32 * THALF; const float qt_ = bf2f(Q[t_]) * __expf(run); \
                *(LAS bf16*)(QT + tt * 128 + ((lane * 2) ^ ((tt & 7) << 4))) = (bf16)f2bf(qt_); } } } while (0)
    float run = 0.f;
    GC_LOAD(gA, kA, qA, 0);
    constexpr int NVR = 8 * (THALF + 1);
    v4u vr[NVR];
#pragma unroll
    for (int i = 0; i < NVR; ++i) { const int sidx = 4 * i + (lane >> 4), cc = lane & 15; vr[i] = *(const v4u*)(F.PROJ + (row0 + sidx) * NPROJ + COL_GV + h * 128 + cc * 8); }
    GC_LOAD(gB, kB, qB, 1); SCHED_FENCE(); GC_PROC(gA, kA, qA, 0); SCHED_FENCE();
    if (THALF) {
        GC_LOAD(gA, kA, qA, 2); SCHED_FENCE(); GC_PROC(gB, kB, qB, 1); SCHED_FENCE();
        GC_LOAD(gB, kB, qB, 3); SCHED_FENCE(); GC_PROC(gA, kA, qA, 2); SCHED_FENCE();
        GC_PROC(gB, kB, qB, 3);
    } else {
        GC_PROC(gB, kB, qB, 1);
    }
#undef GC_LOAD
#undef GC_PROC
    asm volatile("" ::: "memory");
    bf16x8 qf[4];
#pragma unroll
    for (int ks = 0; ks < 4; ++ks) qf[ks] = *(const LAS bf16x8*)(QT + r * 128 + ((32 * ks + 16 * hh) ^ ((r & 7) << 4)));
    bf16x8 pa[2][2];
#pragma unroll
    for (int sb = 0; sb <= THALF; ++sb) {
        f32x16 P;
#pragma unroll
        for (int i = 0; i < 16; ++i) P[i] = 0.f;
        const int srow = 32 * sb + r;
#pragma unroll
        for (int ks = 0; ks < 4; ++ks) { const bf16x8 kf = *(const LAS bf16x8*)(KT + srow * 128 + ((32 * ks + 16 * hh) ^ ((srow & 7) << 4)));
            P = __builtin_amdgcn_mfma_f32_32x32x16_bf16(kf, qf[ks], P, 0, 0, 0); }
        float pm[16];
#pragma unroll
        for (int i = 0; i < 16; ++i) pm[i] = (32 * sb + crow(i, hh) <= 32 * THALF + r) ? P[i] : 0.f;
        pa[sb][0] = pack8(pm); pa[sb][1] = pack8(pm + 8);
    }
    asm volatile("" ::: "memory");
#pragma unroll
    for (int i = 0; i < NVR; ++i) { const int sidx = 4 * i + (lane >> 4), cc = lane & 15;
        *(LAS v4u*)(VV + ((sidx >> 3) * 4 + (cc >> 2)) * 512 + (sidx & 7) * 64 + (cc & 3) * 16) = vr[i]; }
    asm volatile("" ::: "memory");
    bf16x8 sf[4][4];
#pragma unroll
    for (int vb = 0; vb < 4; ++vb) { const bf16* stp = F.ST + ((size_t)(bh * 64 + c) * 128 + 32 * vb + r) * 64 + 8 * hh;
#pragma unroll
        for (int ks = 0; ks < 4; ++ks) sf[vb][ks] = *(const bf16x8*)(stp + 16 * ks); }
    SCHED_FENCE();
    f32x16 o[4];
#pragma unroll
    for (int vb = 0; vb < 4; ++vb) {
#pragma unroll
        for (int i = 0; i < 16; ++i) o[vb][i] = 0.f;
#pragma unroll
        for (int sb = 0; sb <= THALF; ++sb)
#pragma unroll
            for (int s2 = 0; s2 < 2; ++s2) { const int ra = 32 * sb + 16 * s2 + 4 * hh, rb = ra + 8;
                const bf16x8 vf = tr_frag(VV, 4, ra, rb, vb, lane);
                o[vb] = __builtin_amdgcn_mfma_f32_32x32x16_bf16(pa[sb][s2], vf, o[vb], 0, 0, 0); }
#pragma unroll
        for (int ks = 0; ks < 4; ++ks) o[vb] = __builtin_amdgcn_mfma_f32_32x32x16_bf16(qf[ks], sf[vb][ks], o[vb], 0, 0, 0);
    }
    asm volatile("" ::: "memory");
    v4u grv[8];
    { const bf16* grp = F.PROJ + (row0 + 32 * THALF + (lane >> 1)) * NPROJ + COL_GR + h * 128 + 64 * (lane & 1);
#pragma unroll
      for (int jj = 0; jj < 8; ++jj) grv[jj] = *(const v4u*)(grp + 8 * jj); }
    SCHED_FENCE();
    LAS char* OL = KT;
#pragma unroll
    for (int vb = 0; vb < 4; ++vb)
#pragma unroll
        for (int i = 0; i < 16; ++i) { const int t = crow(i, hh); const int chunk = 8 * vb + (r >> 2);
            *(LAS float*)(OL + t * 528 + chunk * 16 + (r & 3) * 4) = o[vb][i]; }
    asm volatile("" ::: "memory");
    const int t2 = lane >> 1, hf = lane & 1;
    float ss = 0.f;
#pragma unroll
    for (int j = 0; j < 16; ++j) { const f32x4 x = *(const LAS f32x4*)(OL + t2 * 528 + (16 * hf + j) * 16); ss += (x.x * x.x + x.y * x.y) + (x.z * x.z + x.w * x.w); }
    ss += __shfl_xor(ss, 1);
    const float inv = 1.0f / sqrtf(ss * (1.0f / GDV) + RMS_EPS);
    const size_t trow = row0 + 32 * THALF + t2;
    const float* gnp = F.gnorm_g + h * 128 + 64 * hf;
    bf16* outp = F.OMIX + trow * D + 512 + h * 128 + 64 * hf;
#pragma unroll
    for (int jj = 0; jj < 8; ++jj) {
        const f32x4 x0 = *(const LAS f32x4*)(OL + t2 * 528 + (16 * hf + 2 * jj) * 16), x1 = *(const LAS f32x4*)(OL + t2 * 528 + (16 * hf + 2 * jj + 1) * 16);
        const f32x4 g0 = *(const f32x4*)(gnp + 8 * jj), g1 = *(const f32x4*)(gnp + 8 * jj + 4);
        const v4u gw = grv[jj];
        const float gr[8] = {bflo(gw.x), bfhi(gw.x), bflo(gw.y), bfhi(gw.y), bflo(gw.z), bfhi(gw.z), bflo(gw.w), bfhi(gw.w)};
        const float xv[8] = {x0.x, x0.y, x0.z, x0.w, x1.x, x1.y, x1.z, x1.w}; const float gg[8] = {g0.x, g0.y, g0.z, g0.w, g1.x, g1.y, g1.z, g1.w};
        float res[8];
#pragma unroll
        for (int q = 0; q < 8; ++q) res[q] = xv[q] * inv * gg[q] * gr[q] * __builtin_amdgcn_rcpf(1.0f + __expf(-gr[q]));
        v4u w; w.x = cvtpk_s(res[0], res[1]); w.y = cvtpk_s(res[2], res[3]); w.z = cvtpk_s(res[4], res[5]); w.w = cvtpk_s(res[6], res[7]);
        *(v4u*)(outp + 8 * jj) = w;
    }
    asm volatile("" ::: "memory");
}
__device__ __forceinline__ void gla_pass_c(Frame& F) {
    for (int unit = F.gw; unit < BATCH * GH * 64 * 2; unit += F.NGW) {
        const int thalf = unit & 1, c = (unit >> 1) & 63, bh = unit >> 7;
        if (thalf) gla_pass_c_unit<1>(F, c, bh); else gla_pass_c_unit<0>(F, c, bh);
    }
}

__device__ __forceinline__ void p3_gla_base(Frame& F) {
    if (F.gw >= BATCH * GH * 2) return;
    const int b = F.gw / (GH * 2), h = (F.gw / 2) % GH, vc = (F.gw & 1) * 64 + F.lane;
    float S[64];
#pragma unroll
    for (int k = 0; k < 64; ++k) S[k] = 0.f;
    int zero = 0; asm volatile("" : "+v"(zero));
    for (int t = 0; t < SEQ; ++t) {
        const size_t row = (size_t)b * SEQ + t;
        const bf16* pr = F.PROJ + row * NPROJ + zero;
        const float vv = bf2f(pr[COL_GV + h * 128 + vc]);
        const v4u* kp = (const v4u*)(pr + COL_GK + h * 64); const v4u* qp = (const v4u*)(pr + COL_GQ + h * 64);
        const f32x4* lp = (const f32x4*)(F.LOGA + row * 256 + h * 64 + zero);
        float o = 0.f;
#pragma unroll
        for (int j = 0; j < 8; ++j) { const v4u kw = kp[j], qw = qp[j]; const f32x4 l0 = lp[2 * j], l1 = lp[2 * j + 1];
            const float kk[8] = {bflo(kw.x), bfhi(kw.x), bflo(kw.y), bfhi(kw.y), bflo(kw.z), bfhi(kw.z), bflo(kw.w), bfhi(kw.w)};
            const float qq[8] = {bflo(qw.x), bfhi(qw.x), bflo(qw.y), bfhi(qw.y), bflo(qw.z), bfhi(qw.z), bflo(qw.w), bfhi(qw.w)};
            const float ll[8] = {l0.x, l0.y, l0.z, l0.w, l1.x, l1.y, l1.z, l1.w};
#pragma unroll
            for (int i = 0; i < 8; ++i) { const float a = __expf(ll[i]); S[8 * j + i] = a * S[8 * j + i] + kk[i] * vv; o += qq[i] * S[8 * j + i]; } }
        F.OG[row * 512 + h * 128 + vc] = o;
    }
}
__device__ __forceinline__ void p4_gla_out(Frame& F) {
    for (int t = F.gw; t < T; t += F.NGW) {
        const int c0 = F.lane * 8;
        const f32x4* op = (const f32x4*)(F.OG + (size_t)t * 512 + c0); const f32x4 a = op[0], b = op[1];
        float ss = (a.x * a.x + a.y * a.y) + (a.z * a.z + a.w * a.w) + (b.x * b.x + b.y * b.y) + (b.z * b.z + b.w * b.w);
        ss += __shfl_xor(ss, 1); ss += __shfl_xor(ss, 2); ss += __shfl_xor(ss, 4); ss += __shfl_xor(ss, 8);
        const float inv = 1.0f / sqrtf(ss * (1.0f / GDV) + RMS_EPS);
        const f32x4* gp = (const f32x4*)(F.gnorm_g + c0); const f32x4 g0 = gp[0], g1 = gp[1];
        const v4u grw = *(const v4u*)(F.PROJ + (size_t)t * NPROJ + COL_GR + c0);
        const float gr[8] = {bflo(grw.x), bfhi(grw.x), bflo(grw.y), bfhi(grw.y), bflo(grw.z), bfhi(grw.z), bflo(grw.w), bfhi(grw.w)};
        const float ov[8] = {a.x, a.y, a.z, a.w, b.x, b.y, b.z, b.w}; const float gg[8] = {g0.x, g0.y, g0.z, g0.w, g1.x, g1.y, g1.z, g1.w};
        float r[8];
#pragma unroll
        for (int i = 0; i < 8; ++i) { const float sl = gr[i] / (1.0f + __expf(-gr[i])); r[i] = ov[i] * inv * gg[i] * sl; }
        v4u w; w.x = pk2(r[0], r[1]); w.y = pk2(r[2], r[3]); w.z = pk2(r[4], r[5]); w.w = pk2(r[6], r[7]);
        *(v4u*)(F.OMIX + (size_t)t * D + 512 + c0) = w;
    }
}
__device__ __forceinline__ void p5_outproj_base(Frame& F) {
    const int r = F.lane & 31, h = F.lane >> 5;
    constexpr int NT = D / 32, MT = T / 32;
    for (int it = F.gw; it < MT * NT; it += F.NGW) {
        const int mt = it / NT, nt = it % NT;
        const f32x16 acc = tile32(F.OMIX + (size_t)(mt * 32 + r) * D, F.WoutT + (size_t)(nt * 32 + r) * D, D, h);
#pragma unroll
        for (int i = 0; i < 16; ++i) { const size_t idx = (size_t)(mt * 32 + crow(i, h)) * D + nt * 32 + r; F.X1[idx] = F.x[idx] + acc[i]; }
    }
}
__device__ __forceinline__ void p6_route(Frame& F) {
    for (int t = F.gw; t < T; t += F.NGW) {
        const GAS f32x4* xr = (const GAS f32x4*)(F.X1 + (size_t)t * D) + F.lane; const GAS f32x4* gr = (const GAS f32x4*)F.ln2_g + F.lane;
        f32x4 v[4]; float s = 0.f;
#pragma unroll
        for (int j = 0; j < 4; ++j) { v[j] = xr[64 * j]; s += (v[j].x * v[j].x + v[j].y * v[j].y) + (v[j].z * v[j].z + v[j].w * v[j].w); }
        const float inv = 1.0f / sqrtf(wave_sum(s) * (1.f / D) + RMS_EPS);
        GAS unsigned long long* o8 = (GAS unsigned long long*)(F.H2 + (size_t)t * D) + F.lane;
#pragma unroll
        for (int j = 0; j < 4; ++j) { const f32x4 gg = gr[64 * j]; v[j].x = v[j].x * inv * gg.x; v[j].y = v[j].y * inv * gg.y; v[j].z = v[j].z * inv * gg.z; v[j].w = v[j].w * inv * gg.w;
            o8[64 * j] = (unsigned long long)pk2(v[j].x, v[j].y) | ((unsigned long long)pk2(v[j].z, v[j].w) << 32); }
        float lg[NGRP], le[NE];
#pragma unroll
        for (int c = 0; c < NGRP; ++c) lg[c] = 0.f;
#pragma unroll
        for (int c = 0; c < NE; ++c) le[c] = 0.f;
#pragma unroll 1
        for (int jq = 0; jq < 16; ++jq) { const int j = jq >> 2, q = jq & 3;
            const f32x4 vj = j == 0 ? v[0] : (j == 1 ? v[1] : (j == 2 ? v[2] : v[3]));
            const float hv = q == 0 ? vj.x : (q == 1 ? vj.y : (q == 2 ? vj.z : vj.w));
            const int k = 4 * (64 * j + F.lane) + q;
            const f32x4 wg = *(const f32x4*)(F.w_group + (size_t)k * NGRP);
            lg[0] += hv * wg.x; lg[1] += hv * wg.y; lg[2] += hv * wg.z; lg[3] += hv * wg.w;
            const f32x4* we = (const f32x4*)(F.w_expert + (size_t)k * NE);
#pragma unroll
            for (int c4 = 0; c4 < NE / 4; ++c4) { const f32x4 w = we[c4]; le[4 * c4] += hv * w.x; le[4 * c4 + 1] += hv * w.y; le[4 * c4 + 2] += hv * w.z; le[4 * c4 + 3] += hv * w.w; } }
#pragma unroll
        for (int c = 0; c < NGRP; ++c) lg[c] = wave_sum(lg[c]) + F.b_group[c];
#pragma unroll
        for (int c = 0; c < NE; ++c) le[c] = wave_sum(le[c]) + F.b_expert[c];
        int gi = 0; float gm = lg[0];
#pragma unroll
        for (int c = 1; c < NGRP; ++c) if (lg[c] > gm) { gm = lg[c]; gi = c; }
        float gs = 0.f;
#pragma unroll
        for (int c = 0; c < NGRP; ++c) gs += __expf(lg[c] - gm);
        const float gp = 1.0f / gs;
        float sel[EPG];
#pragma unroll
        for (int i = 0; i < EPG; ++i) { sel[i] = le[i];
#pragma unroll
            for (int g = 1; g < NGRP; ++g) sel[i] = (gi == g) ? le[g * EPG + i] : sel[i]; }
        int i1 = 0; float m1 = sel[0];
#pragma unroll
        for (int i = 1; i < EPG; ++i) if (sel[i] > m1) { m1 = sel[i]; i1 = i; }
        int i2 = -1; float m2 = -3.0e38f;
#pragma unroll
        for (int i = 0; i < EPG; ++i) if (i != i1 && sel[i] > m2) { m2 = sel[i]; i2 = i; }
        const float e21 = __expf(m2 - m1); const float w1 = 1.0f / (1.0f + e21), w2 = e21 * w1;
        if (F.lane == 0) {
            const int e1 = gi * EPG + i1, e2 = gi * EPG + i2;
            const int r1 = (int)__hip_atomic_fetch_add(F.cnt + e1, 1u, RLX_AGENT), r2 = (int)__hip_atomic_fetch_add(F.cnt + e2, 1u, RLX_AGENT);
            F.toklist[e1 * CAP + r1] = t; F.toklist[e2 * CAP + r2] = t;
            *(int4*)(F.tokinfo + 8 * t) = make_int4(e1, r1, e2, r2);
            *(int4*)(F.tokinfo + 8 * t + 4) = make_int4(__float_as_int(gp * w1), __float_as_int(gp * w2), 0, 0);
        }
    }
}

typedef float f32x1;
__device__ __forceinline__ void p6_route_fast(Frame& F, unsigned* cntp) {
    const int lane = F.lane, r = lane & 31, hh = lane >> 5;
    const int grp = F.wave >> 2, kq = F.wave & 3;
    LAS float* part = (LAS float*)(F.lds + RING_OFF);
    LAS unsigned* lcnt = (LAS unsigned*)(F.lds + RING_OFF + 49152); LAS unsigned* lbase = lcnt + 32;
    if (F.tid < NE) lcnt[F.tid] = 0u;
    __syncthreads();
    for (int blk0 = F.vcu * 2; blk0 < T / 32; blk0 += F.G * 2) {
        const int blk = blk0 + grp; const bool valid = blk < T / 32;
        const size_t trow = (size_t)(valid ? blk : 0) * 32 + r;
        f32x16 ae;
#pragma unroll
        for (int i = 0; i < 16; ++i) ae[i] = 0.f;
        float ssq = 0.f; float gl4[NGRP] = {0.f, 0.f, 0.f, 0.f};
        const float* xp = F.X1 + trow * D + kq * 256 + 4 * hh;
        const float* bep = F.WrT + (size_t)r * D + kq * 256 + 4 * hh; const float* bgp = F.WrT + (size_t)32 * D + kq * 256 + 4 * hh;
        f32x4 cx[4], ce[4], cg[4][NGRP], nx[4], ne_[4], ng[4][NGRP];
#define RT_LOAD(X, E, G, off) do { _Pragma("unroll") for (int j = 0; j < 4; ++j) { X[j] = *(const f32x4*)(xp + (off) + 8 * j); E[j] = *(const f32x4*)(bep + (off) + 8 * j); \
            _Pragma("unroll") for (int c = 0; c < NGRP; ++c) G[j][c] = *(const f32x4*)(bgp + (size_t)c * D + (off) + 8 * j); } } while (0)
        RT_LOAD(nx, ne_, ng, 0);
#pragma unroll 1
        for (int mg = 0; mg < 8; ++mg) {
#pragma unroll
            for (int j = 0; j < 4; ++j) { cx[j] = nx[j]; ce[j] = ne_[j];
#pragma unroll
                for (int c = 0; c < NGRP; ++c) cg[j][c] = ng[j][c]; }
            const int mn = (mg < 7 ? mg + 1 : mg) * 32;
            RT_LOAD(nx, ne_, ng, mn);
#pragma unroll
            for (int j = 0; j < 4; ++j) { const f32x4 xv = cx[j];
                ssq += (xv.x * xv.x + xv.y * xv.y) + (xv.z * xv.z + xv.w * xv.w);
#pragma unroll
                for (int c = 0; c < NGRP; ++c) gl4[c] += (xv.x * cg[j][c].x + xv.y * cg[j][c].y) + (xv.z * cg[j][c].z + xv.w * cg[j][c].w);
#pragma unroll
                for (int q = 0; q < 4; ++q) ae = __builtin_amdgcn_mfma_f32_32x32x2f32(xv[q], ce[j][q], ae, 0, 0, 0); }
        }
#undef RT_LOAD
        ssq += __shfl_xor(ssq, 32);
#pragma unroll
        for (int c = 0; c < NGRP; ++c) gl4[c] += __shfl_xor(gl4[c], 32);
        LAS float* pe = part + (size_t)((grp * 4 + kq) * 32) * 40;
#pragma unroll
        for (int i = 0; i < 16; ++i) { const int tk = crow(i, hh); pe[tk * 40 + r] = ae[i]; }
        if (hh == 0) { pe[r * 40 + 36] = ssq;
#pragma unroll
            for (int c = 0; c < NGRP; ++c) pe[r * 40 + 32 + c] = gl4[c]; }
        __syncthreads();
        const bool router = (kq == 0 && lane < 32 && valid);
        int e1 = 0, e2 = 0, lr1 = 0, lr2 = 0; float gt1 = 0.f, gt2 = 0.f, tinv = 0.f;
        if (router) {
            const LAS float* p0 = part + (size_t)(grp * 4 * 32 + lane) * 40;
            const float ss = (p0[36] + p0[1280 + 36]) + (p0[2560 + 36] + p0[3840 + 36]);
            const float inv = 1.0f / sqrtf(ss * (1.f / D) + RMS_EPS);
            float lg[NGRP];
#pragma unroll
            for (int c = 0; c < NGRP; ++c) lg[c] = ((p0[32 + c] + p0[1280 + 32 + c]) + (p0[2560 + 32 + c] + p0[3840 + 32 + c])) * inv + F.b_group[c];
            int gi = 0; float gm = lg[0];
#pragma unroll
            for (int c = 1; c < NGRP; ++c) if (lg[c] > gm) { gm = lg[c]; gi = c; }
            float gs = 0.f;
#pragma unroll
            for (int c = 0; c < NGRP; ++c) gs += __expf(lg[c] - gm);
            const float gp = 1.0f / gs;
            float sel[EPG];
#pragma unroll
            for (int i = 0; i < EPG; ++i) { const int c = gi * EPG + i; sel[i] = ((p0[c] + p0[1280 + c]) + (p0[2560 + c] + p0[3840 + c])) * inv + F.b_expert[c]; }
            int i1 = 0; float m1 = sel[0];
#pragma unroll
            for (int i = 1; i < EPG; ++i) if (sel[i] > m1) { m1 = sel[i]; i1 = i; }
            int i2 = -1; float m2 = -3.0e38f;
#pragma unroll
            for (int i = 0; i < EPG; ++i) if (i != i1 && sel[i] > m2) { m2 = sel[i]; i2 = i; }
            const float e21 = __expf(m2 - m1); const float w1 = 1.0f / (1.0f + e21), w2 = e21 * w1;
            e1 = gi * EPG + i1; e2 = gi * EPG + i2; gt1 = gp * w1; gt2 = gp * w2; tinv = inv;
            lr1 = (int)__hip_atomic_fetch_add(lcnt + e1, 1u, __ATOMIC_RELAXED, __HIP_MEMORY_SCOPE_WORKGROUP); lr2 = (int)__hip_atomic_fetch_add(lcnt + e2, 1u, __ATOMIC_RELAXED, __HIP_MEMORY_SCOPE_WORKGROUP);
        }
        __syncthreads();
        if (F.tid < NE) { const unsigned n = lcnt[F.tid]; if (n) lbase[F.tid] = __hip_atomic_fetch_add(cntp + CNT_STRIDE * F.tid, n, RLX_AGENT); }
        __syncthreads();
        if (router) {
            const int t = blk * 32 + lane; const int r1 = (int)lbase[e1] + lr1, r2 = (int)lbase[e2] + lr2;
            F.toklist[e1 * CAP + r1] = t; F.toklist[e2 * CAP + r2] = t; F.invlist[e1 * CAP + r1] = tinv; F.invlist[e2 * CAP + r2] = tinv;
            *(int4*)(F.tokinfo + 8 * t) = make_int4(e1, r1, e2, r2);
            *(int4*)(F.tokinfo + 8 * t + 4) = make_int4(__float_as_int(gt1), __float_as_int(gt2), 0, 0);
        }
        __syncthreads();
        if (F.tid < NE) lcnt[F.tid] = 0u;
        __syncthreads();
    }
}

__device__ __forceinline__ void load_emap(Frame& F, int& cnt_l, int& pst_l, int& cend32_l) {
    const int e = F.lane & 31;
    cnt_l = (int)__hip_atomic_load(F.cnt + CNT_STRIDE * e, RLX_AGENT);
    int p = (cnt_l + 255) & ~255, c = (cnt_l + 31) >> 5;
#pragma unroll
    for (int o = 1; o < 32; o <<= 1) { const int pp = __shfl_up(p, o), cc = __shfl_up(c, o); if (e >= o) { p += pp; c += cc; } }
    pst_l = p - ((cnt_l + 255) & ~255); cend32_l = c;
}
__device__ __forceinline__ void p7_gateup_base(Frame& F) {
    const int r = F.lane & 31, h = F.lane >> 5;
    int cnt_l, pst_l, cend_l; load_emap(F, cnt_l, pst_l, cend_l);
    const int total = __shfl(cend_l, 31) * (DFF / 32);
    for (int it = F.gw; it < total; it += F.NGW) {
        const int g = it / (DFF / 32), nt = it % (DFF / 32);
        const int e = __popcll(__ballot(F.lane < 32 && cend_l <= g));
        const int base = e > 0 ? __shfl(cend_l, e - 1) : 0;
        const int mt = g - base; const int n_e = __shfl(cnt_l, e); const int ps = __shfl(pst_l, e);
        const int idx = mt * 32 + r; const int tok = idx < n_e ? F.toklist[e * CAP + idx] : 0;
        const int hc = nt * 32 + r; const size_t brow = (size_t)e * 1024 + (size_t)(hc / 128) * 256 + (hc % 128);
        const f32x16 ag = tile32(F.H2 + (size_t)tok * D, F.WguT + brow * D, D, h);
        const f32x16 au = tile32(F.H2 + (size_t)tok * D, F.WguT + (brow + 128) * D, D, h);
#pragma unroll
        for (int i = 0; i < 16; ++i) { const int rr = mt * 32 + crow(i, h);
            if (rr < n_e) { const float gv = ag[i]; const float hv = gv / (1.0f + __expf(-gv)) * au[i]; F.HBUF[(size_t)(ps + rr) * DFF + hc] = (bf16)f2bf(hv); } }
    }
}
__device__ __forceinline__ void p8_down_base(Frame& F) {
    const int r = F.lane & 31, h = F.lane >> 5;
    int cnt_l, pst_l, cend_l; load_emap(F, cnt_l, pst_l, cend_l);
    const int total = __shfl(cend_l, 31) * (D / 32);
    for (int it = F.gw; it < total; it += F.NGW) {
        const int g = it / (D / 32), nt = it % (D / 32);
        const int e = __popcll(__ballot(F.lane < 32 && cend_l <= g));
        const int base = e > 0 ? __shfl(cend_l, e - 1) : 0;
        const int mt = g - base; const int n_e = __shfl(cnt_l, e); const int ps = __shfl(pst_l, e);
        int idx = mt * 32 + r; if (idx >= n_e) idx = n_e - 1;
        const f32x16 acc = tile32(F.HBUF + (size_t)(ps + idx) * DFF, F.WdT + ((size_t)e * 1024 + nt * 32 + r) * DFF, DFF, h);
#pragma unroll
        for (int i = 0; i < 16; ++i) { const int rr = mt * 32 + crow(i, h);
            if (rr < n_e) F.Y[(size_t)(ps + rr) * D + nt * 32 + r] = (bf16)f2bf(acc[i]); }
    }
}
__device__ __forceinline__ void p9_final(Frame& F, const bool do_store) {
    const int lane = F.lane;
    int cnt_l, pst_l, cend_l; load_emap(F, cnt_l, pst_l, cend_l);
    const int nrow = (T - F.gw + F.NGW - 1) / F.NGW;
    for (int i0 = 0; i0 < nrow; i0 += 32) {
        int4 ti = make_int4(0, 0, 0, 0), tg = make_int4(0, 0, 0, 0);
        { const int i = i0 + (lane & 31); if (i < nrow) { const int t = F.gw + i * F.NGW; ti = *(const int4*)(F.tokinfo + 8 * t); tg = *(const int4*)(F.tokinfo + 8 * t + 4); } }
        const int s1l = __shfl(pst_l, ti.x) + ti.y, s2l = __shfl(pst_l, ti.z) + ti.w;
        const int nloc = (nrow - i0) < 32 ? (nrow - i0) : 32;
        for (int ii = 0; ii < nloc; ii += 2) {
            const bool two = (ii + 1) < nloc;
            f32x4 v[2][4]; v2u ya[2][4], yb[2][4]; float g1[2], g2[2]; GAS f32x4* xr[2];
#pragma unroll
            for (int u = 0; u < 2; ++u) { const int iu = (u == 1 && !two) ? ii : ii + u;
                const int t = F.gw + (i0 + iu) * F.NGW;
                const int s1 = __shfl(s1l, iu), s2 = __shfl(s2l, iu); g1[u] = __int_as_float(__shfl(tg.x, iu)); g2[u] = __int_as_float(__shfl(tg.y, iu));
                xr[u] = (GAS f32x4*)(F.X1 + (size_t)t * D) + lane;
                const GAS v2u* y1 = (const GAS v2u*)(F.Y + (size_t)s1 * D) + lane; const GAS v2u* y2 = (const GAS v2u*)(F.Y + (size_t)s2 * D) + lane;
#pragma unroll
                for (int j = 0; j < 4; ++j) { v[u][j] = xr[u][64 * j]; ya[u][j] = y1[64 * j]; yb[u][j] = y2[64 * j]; } }
#pragma unroll
            for (int u = 0; u < 2; ++u) {
                if (u == 1 && !two) break;
                float s = 0.f;
#pragma unroll
                for (int j = 0; j < 4; ++j) { const v2u a = ya[u][j], b = yb[u][j];
                    v[u][j].x += g1[u] * bflo(a.x) + g2[u] * bflo(b.x); v[u][j].y += g1[u] * bfhi(a.x) + g2[u] * bfhi(b.x); v[u][j].z += g1[u] * bflo(a.y) + g2[u] * bflo(b.y); v[u][j].w += g1[u] * bfhi(a.y) + g2[u] * bfhi(b.y);
                    s += (v[u][j].x * v[u][j].x + v[u][j].y * v[u][j].y) + (v[u][j].z * v[u][j].z + v[u][j].w * v[u][j].w); }
                const float inv = 1.0f / sqrtf(wave_sum(s) * (1.f / D) + RMS_EPS);
                const GAS f32x4* gr = (const GAS f32x4*)F.lnf_g + lane;
#pragma unroll
                for (int j = 0; j < 4; ++j) { const f32x4 gg = gr[64 * j]; f32x4 o; o.x = v[u][j].x * inv * gg.x; o.y = v[u][j].y * inv * gg.y; o.z = v[u][j].z * inv * gg.z; o.w = v[u][j].w * inv * gg.w; if (do_store) xr[u][64 * j] = o; else asm volatile("" :: "v"(o.x), "v"(o.y), "v"(o.z), "v"(o.w)); }
            }
        }
    }
}

__device__ __forceinline__ void load_emap256(Frame& F, int& cnt_l, int& pst_l, int& cend_l) {
    const int e = F.lane & 31;
    cnt_l = (int)__hip_atomic_load(F.cnt + CNT_STRIDE * e, RLX_AGENT);
    int c = (cnt_l + 255) >> 8;
#pragma unroll
    for (int o = 1; o < 32; o <<= 1) { const int cc = __shfl_up(c, o); if (e >= o) c += cc; }
    cend_l = c; pst_l = (c - ((cnt_l + 255) >> 8)) * 256;
}
constexpr int NCONV = 102;
__device__ __forceinline__ void p1_phase(Frame& F) {
    const int ngemm = F.G > NCONV ? F.G - NCONV : F.G;
    if ((int)blockIdx.x < ngemm) {
        pg8::Gemm g{F.XN, F.WinT, T, NPROJ, D}; pg8::StaticOrder S; S.init(T, NPROJ, ngemm, (int)blockIdx.x);
        pg8::EpiProj E{F.PROJ};
        pg8::gemm_phase<pg8::EpiProj, pg8::StaticOrder, true, false>(F.lds + RING_OFF, g, S, E);
    }
    if (F.G <= NCONV || (int)blockIdx.x >= ngemm) {
        const int cw = (F.G <= NCONV ? (int)blockIdx.x : (int)blockIdx.x - ngemm) * NWAVES + F.wave, ncw = (F.G <= NCONV ? F.G : NCONV) * NWAVES;
        p1_loga(F, cw, ncw);
        p0_transpose_range(F, P0_DENSE_ITEMS, P0_EXPERT_ITEMS, cw, ncw);
    }
}
__device__ __forceinline__ void p5_outproj_pg8(Frame& F) {
    pg8::Gemm g{F.OMIX, F.WoutT, T, D, D}; pg8::StaticOrder S; S.init(T, D, F.G, (int)blockIdx.x);
    pg8::EpiResid E{F.x, F.X1, F.ln2_g, F.H2};
    pg8::gemm_phase<pg8::EpiResid, pg8::StaticOrder, false, false>(F.lds + RING_OFF, g, S, E);
}
constexpr int EMAP_OFF = LDSCTL_OFF + 1024;
__device__ __forceinline__ void moe_order_init(Frame& F, pg8::MoeOrder& S) {
    LAS int* tab = (LAS int*)(F.lds + EMAP_OFF);
    if (F.wave == 0) { int cnt_l, pst_l, cend_l; load_emap256(F, cnt_l, pst_l, cend_l); if (F.lane < 32) { tab[F.lane] = cnt_l; tab[32 + F.lane] = pst_l; tab[64 + F.lane] = cend_l; } }
    __syncthreads();
    S.G = F.G; S.c = (int)blockIdx.x; S.toklist = F.toklist; S.tab = tab; S.MT = __builtin_amdgcn_readfirstlane(tab[64 + 31]); S.nwg = S.MT * 4;
}
__device__ __forceinline__ void p7_gateup_pg8(Frame& F) {
    pg8::MoeOrder S; moe_order_init(F, S);
    pg8::Gemm g{F.H2, F.WguT, 0, 0, D}; pg8::EpiGateUp E{F.HBUF, F.invlist};
    pg8::gemm_phase<pg8::EpiGateUp, pg8::MoeOrder, true, true>(F.lds + RING_OFF, g, S, E);
}
__device__ __forceinline__ void p8_down_pg8(Frame& F) {
    pg8::MoeOrder S; moe_order_init(F, S);
    pg8::Gemm g{F.HBUF, F.WdT, 0, 0, DFF}; pg8::EpiY E{F.Y};
    pg8::gemm_phase<pg8::EpiY, pg8::MoeOrder, true, false>(F.lds + RING_OFF, g, S, E);
}

#ifndef REPEAT_PHASE
#define REPEAT_PHASE -1
#endif
#ifndef USE_GLAFAST
#define USE_GLAFAST 1
#endif
#ifndef USE_SBFAST
#define USE_SBFAST 1
#endif
#ifndef USE_PG8
#define USE_PG8 15
#endif
constexpr int NPHASE = 10;
struct Args { const float* in[16]; float* out; unsigned char* ws; int ph_lo, ph_hi, li, pad; };
__global__ void __launch_bounds__(NWAVES * 64, 2) mk_fwd(Args args) {
    extern __shared__ __attribute__((aligned(16))) unsigned char lds[];
    Frame F;
    F.lds = (LAS unsigned char*)lds;
    F.MISC = (volatile LAS unsigned*)(F.lds + MISC_OFF);
    F.tid = threadIdx.x; F.lane = F.tid & 63; F.wave = __builtin_amdgcn_readfirstlane(F.tid >> 6);
    F.G = gridDim.x; { const int bx = blockIdx.x; F.vcu = (F.G % 8 == 0) ? (bx % 8) * (F.G / 8) + bx / 8 : bx; }
    F.gw = F.vcu * NWAVES + F.wave; F.NGW = F.G * NWAVES;
    unsigned char* ws = args.ws; F.ws = ws;
    F.ctl = (gu32*)(ws + WS_CTL);
    F.x = args.in[0]; F.ln1_g = args.in[1]; F.w_in = args.in[2]; F.gate_w2 = args.in[3]; F.gate_b = args.in[4]; F.gnorm_g = args.in[5]; F.w_out = args.in[6]; F.ln2_g = args.in[7];
    F.w_group = args.in[8]; F.b_group = args.in[9]; F.w_expert = args.in[10]; F.b_expert = args.in[11]; F.ew_gate = args.in[12]; F.ew_up = args.in[13]; F.ew_down = args.in[14]; F.lnf_g = args.in[15];
    F.out = args.out;
    F.WinT = (bf16*)(ws + WS_WIN); F.WoutT = (bf16*)(ws + WS_WOUT); F.WguT = (bf16*)(ws + WS_WGU); F.WdT = (bf16*)(ws + WS_WD);
    F.XN = (bf16*)(ws + WS_R1); F.OMIX = (bf16*)(ws + WS_R1); F.H2 = (bf16*)(ws + WS_R2);
    F.PROJ = (bf16*)(ws + WS_R2); F.HBUF = (bf16*)(ws + WS_R2 + 32 * MiB); F.Y = (bf16*)(ws + WS_Y);
    F.GLR = (float*)(ws + WS_GLR); F.LOGA = (float*)((unsigned char*)args.out + DO_LOGA); F.OG = (float*)((unsigned char*)args.out + DO_OG); F.X1 = args.out; F.DS = F.OG; F.DEC = (float*)(ws + WS_DEC); F.WrT = (float*)(ws + WS_WRT); F.ST = (bf16*)((unsigned char*)args.out + DO_ST);
    F.toklist = (int*)(ws + WS_TOKLIST); F.gatelist = (float*)(ws + WS_GATELIST); F.invlist = (float*)(ws + WS_GATELIST); F.tokinfo = (int*)(ws + WS_TOKINFO); F.cnt = (unsigned*)(ws + WS_CTL) + CW_CNT;
    for (int u = F.tid; u < (LDS_BYTES - LDSCTL_OFF) / 4; u += NWAVES * 64) ((LAS unsigned*)(F.lds + LDSCTL_OFF))[u] = 0u;
    __syncthreads();
    XcdBarrier bar = xcd_barrier_post((unsigned*)(F.ctl + CW_BAR) + args.li * XCD_BAR_WORDS, F.MISC + 8);
    const int lo = args.ph_lo, hi = args.ph_hi;
#define IN(k) (lo <= (k) && (k) < hi)
#define SEAM(k) do { if (IN(k) && IN((k) + 1)) xcd_barrier(bar); } while (0)
#define STEP(code, body) do { body; if (REPEAT_PHASE == (code)) { xcd_barrier(bar); body; } } while (0)
    if (IN(0)) { STEP(0, p0_prologue(F)); } SEAM(0);
    if (IN(1)) { STEP(10, p1_phase(F)); } SEAM(1);
    if (IN(2)) { STEP(20, p2_sb_fast(F)); STEP(21, gla_pass_a(F)); } SEAM(2);
    if (IN(3)) { STEP(30, gla_pass_b(F)); } SEAM(3);
    if (IN(4)) { STEP(40, gla_pass_c(F)); } SEAM(4);
    if (IN(5)) { STEP(50, p5_outproj_pg8(F)); } SEAM(5);
    if (IN(6)) { if (REPEAT_PHASE == 60) { p6_route_fast(F, F.cnt + 1024); xcd_barrier(bar); } p6_route_fast(F, F.cnt); } SEAM(6);
    if (IN(7)) { STEP(70, p7_gateup_pg8(F)); } SEAM(7);
    if (IN(8)) { STEP(80, p8_down_pg8(F)); } SEAM(8);
    if (IN(9)) { if (REPEAT_PHASE == 90) { p9_final(F, false); xcd_barrier(bar); } if (REPEAT_PHASE == 99) { for (int i = 0; i < 10; ++i) xcd_barrier(bar); } p9_final(F, true); }
#undef STEP
#undef IN
#undef SEAM
}

#ifndef MK_ONE_LAUNCH
#define MK_ONE_LAUNCH 1
#endif
extern "C" void kernel_launch(void* const* d_in, const int* in_sizes, int n_in, void* d_out, int out_size, void* d_ws, size_t ws_size, hipStream_t stream) {
    static int grid = 0;
    if (grid == 0) {
        if (n_in != 16 || in_sizes[0] != T * D || out_size != T * D || ws_size < WS_END) {
            fprintf(stderr, "kernel_launch: unexpected shapes / workspace (n_in %d, in0 %d, out %d, ws %zu, need %zu); nothing launched\n", n_in, n_in > 0 ? in_sizes[0] : -1, out_size, ws_size, (size_t)WS_END); grid = -1; return; }
        int dev = 0, cus = 0, per_cu = 0;
        if (hipGetDevice(&dev) != hipSuccess || hipDeviceGetAttribute(&cus, hipDeviceAttributeMultiprocessorCount, dev) != hipSuccess) { grid = -1; return; }
        if (hipFuncSetAttribute((const void*)mk_fwd, hipFuncAttributeMaxDynamicSharedMemorySize, LDS_BYTES) != hipSuccess) { fprintf(stderr, "kernel_launch: hipFuncSetAttribute failed\n"); grid = -1; return; }
        if (hipOccupancyMaxActiveBlocksPerMultiprocessor(&per_cu, (const void*)mk_fwd, NWAVES * 64, LDS_BYTES) != hipSuccess || per_cu < 1) { fprintf(stderr, "kernel_launch: occupancy query says %d\n", per_cu); per_cu = 1; }
        (void)hipGetLastError();
        grid = cus;
    }
    if (grid < 0) return;
    (void)hipMemsetAsync((char*)d_ws + WS_CTL, 0, CTL_ZERO_BYTES, stream);
    Args a{};
    for (int i = 0; i < 16; ++i) a.in[i] = (const float*)d_in[i];
    a.out = (float*)d_out; a.ws = (unsigned char*)d_ws;
#if MK_ONE_LAUNCH
    a.ph_lo = 0; a.ph_hi = NPHASE; a.li = 0;
    { void* kargs[] = {&a}; hipError_t e = hipLaunchCooperativeKernel((const void*)mk_fwd, dim3(grid), dim3(NWAVES * 64), kargs, LDS_BYTES, stream);
      if (e != hipSuccess) fprintf(stderr, "kernel_launch: cooperative launch failed: %s\n", hipGetErrorString(e)); }
#else
    for (int p = 0; p < NPHASE; ++p) { a.ph_lo = p; a.ph_hi = p + 1; a.li = 0; hipLaunchKernelGGL(mk_fwd, dim3(grid), dim3(NWAVES * 64), LDS_BYTES, stream, a); }
#endif
}
```
